# Optimizing an MI355X kernel written in HIP

```python
import jax, jax.numpy as jnp
from jax import lax
import numpy as np

D_MODEL = 1024
BATCH = 2
SEQ = 8192
DEPTH = 1

D_MIX = D_MODEL
HEAD_DIM = 64
D_RWKV = D_MIX // 2
D_NSA = D_MIX - D_RWKV
RWKV_HEADS = D_RWKV // HEAD_DIM
NSA_Q_HEADS = D_NSA // HEAD_DIM
NSA_KV_HEADS = 2
NSA_GROUP = NSA_Q_HEADS // NSA_KV_HEADS
D_KV = NSA_KV_HEADS * HEAD_DIM
LORA_W = 64
LORA_A = 64
LORA_G = 128
RWKV_SIZES = (D_RWKV, D_RWKV, D_RWKV, LORA_W, LORA_A, LORA_G)
N_RWKV_COLS = sum(RWKV_SIZES)
CMP_BLOCK = 32
CMP_STRIDE = 16
CMP_HIDDEN = 256
SEL_BLOCK = 64
SEL_TOPK = 16
WINDOW = 512
Q_BLOCK = 128
NSA_SIZES = (D_NSA, D_KV, D_KV, D_KV, D_KV, D_KV, D_KV, 3 * NSA_Q_HEADS)
N_NSA_COLS = sum(NSA_SIZES)
N_IN = N_RWKV_COLS + N_NSA_COLS
D_FF = -(-8 * D_MODEL // (3 * 256)) * 256
NORM_EPS = 1e-6
GN_EPS = 64e-5
NEG = -1e30
BIG = 1e30

kernel_name = 'hybrid_rwkv7_nsa_block'


def _split(z, sizes):
    return jnp.split(z, [int(c) for c in np.cumsum(sizes)[:-1]], axis=-1)


def rms_norm(x, g):
    xf = x.astype(jnp.float32)
    y = xf * lax.rsqrt(jnp.mean(xf * xf, axis=-1, keepdims=True) + NORM_EPS)
    return (y * g).astype(x.dtype)


def alibi_slopes(n_heads):
    return 2.0 ** (-8.0 * jnp.arange(1, n_heads + 1, dtype=jnp.float32) / n_heads)


def swiglu(x, w_gate, w_up, w_down):
    return (jax.nn.silu(x @ w_gate) * (x @ w_up)) @ w_down


def rwkv7_time_mix(p, mu, w0, w2, a0, a2, g2, k_k, k_a, r_k, lnx_w, lnx_b):
    B, T, _ = p.shape
    H, N = RWKV_HEADS, HEAD_DIM
    p = p.astype(jnp.float32)
    p_prev = jnp.pad(p, ((0, 0), (1, 0), (0, 0)))[:, :-1]
    p = p + mu * (p_prev - p)
    r, k, v, dw, da, dg = _split(p, RWKV_SIZES)
    w_log = -jax.nn.softplus(-(w0 + jnp.tanh(dw) @ w2)) - 0.5
    decay = jnp.exp(-jnp.exp(w_log))
    a = jax.nn.sigmoid(a0 + da @ a2)
    g = jax.nn.sigmoid(dg) @ g2
    heads = lambda z: z.reshape(B, T, H, N)
    kk = heads(k * k_k)
    kk = kk / jnp.maximum(jnp.sqrt(jnp.sum(kk * kk, axis=-1, keepdims=True)), 1e-12)
    k = k * (1.0 + (a - 1.0) * k_a)
    r, k, v, decay, a = map(heads, (r, k, v, decay, a))
    xs = tuple(jnp.moveaxis(z, 1, 0) for z in (r, decay, k, v, -kk, kk * a))

    def step(S, inp):
        r_t, w_t, k_t, v_t, a_t, b_t = inp
        sa = jnp.einsum('bhvk,bhk->bhv', S, a_t)
        S = S * w_t[:, :, None, :] + sa[..., None] * b_t[:, :, None, :] + v_t[..., None] * k_t[:, :, None, :]
        return S, jnp.einsum('bhvk,bhk->bhv', S, r_t)

    S0 = jnp.zeros((B, H, N, N), jnp.float32)
    _, y = lax.scan(step, S0, xs)
    y = jnp.moveaxis(y, 0, 1)
    mean = jnp.mean(y, axis=-1, keepdims=True)
    var = jnp.mean(jnp.square(y - mean), axis=-1, keepdims=True)
    y = ((y - mean) * lax.rsqrt(var + GN_EPS)).reshape(B, T, D_RWKV) * lnx_w + lnx_b
    bonus = jnp.sum(r * k * r_k, axis=-1, keepdims=True) * v
    return (y + bonus.reshape(B, T, D_RWKV)) * g


def nsa_attention(p, pe_k, pe_v, ck1, ck2, cv1, cv2):
    B, T, _ = p.shape
    Hk, G, dk = NSA_KV_HEADS, NSA_GROUP, HEAD_DIM
    p = p.astype(jnp.float32)
    q, kc, vc, ks, vs, kw, vw, gl = _split(p, NSA_SIZES)
    q = q.reshape(B, T, Hk, G, dk) * (dk ** -0.5)
    gates = jax.nn.sigmoid(gl).reshape(B, T, Hk, G, 3)
    kv_heads = lambda z: z.reshape(B, T, Hk, dk)

    n_cmp = (T - CMP_BLOCK) // CMP_STRIDE + 1
    cmp_idx = np.arange(n_cmp)[:, None] * CMP_STRIDE + np.arange(CMP_BLOCK)[None, :]

    def compress(z, pe, w1, w2):
        blk = kv_heads(z)[:, cmp_idx] + pe[None, None, :, None, :]
        blk = jnp.transpose(blk, (0, 3, 1, 2, 4)).reshape(B, Hk, n_cmp, CMP_BLOCK * dk)
        return jax.nn.gelu(blk @ w1) @ w2

    k_cmp = compress(kc, pe_k, ck1, ck2)
    v_cmp = compress(vc, pe_v, cv1, cv2)
    cmp_start = np.arange(n_cmp) * CMP_STRIDE
    cmp_end = jnp.asarray(cmp_start + CMP_BLOCK - 1)

    n_sel = T // SEL_BLOCK
    top_k = min(SEL_TOPK, n_sel)
    sel_start = np.arange(n_sel) * SEL_BLOCK
    ov = np.clip(np.minimum(cmp_start[:, None] + CMP_BLOCK, sel_start[None, :] + SEL_BLOCK)
                 - np.maximum(cmp_start[:, None], sel_start[None, :]), 0, None) / CMP_STRIDE
    ov = jnp.asarray(ov, jnp.float32)
    k_sel = kv_heads(ks).reshape(B, n_sel, SEL_BLOCK, Hk, dk).transpose(0, 3, 1, 2, 4)
    v_sel = kv_heads(vs).reshape(B, n_sel, SEL_BLOCK, Hk, dk).transpose(0, 3, 1, 2, 4)

    pad = ((0, 0), (WINDOW, 0), (0, 0), (0, 0))
    k_win = jnp.pad(kv_heads(kw), pad)
    v_win = jnp.pad(kv_heads(vw), pad)

    slopes = alibi_slopes(NSA_Q_HEADS).reshape(Hk, G)
    b_ix = jnp.arange(B)[:, None, None, None]
    h_ix = jnp.arange(Hk)[None, :, None, None]
    blk_ids = jnp.arange(n_sel)

    def query_block(qi):
        q0 = qi * Q_BLOCK
        t = q0 + jnp.arange(Q_BLOCK)
        qb = lax.dynamic_slice_in_dim(q, q0, Q_BLOCK, 1)
        gb = lax.dynamic_slice_in_dim(gates, q0, Q_BLOCK, 1)

        s = jnp.einsum('bqhgd,bhcd->bhgqc', qb, k_cmp)
        s = s - slopes[None, :, :, None, None] * jnp.abs(t[:, None] - cmp_end[None, :])
        ok_c = cmp_end[None, :] <= t[:, None]
        p_c = jax.nn.softmax(jnp.where(ok_c, s, NEG), axis=-1) * jnp.any(ok_c, axis=-1)[:, None]
        o_c = jnp.einsum('bhgqc,bhcd->bqhgd', p_c, v_cmp)

        imp = jnp.einsum('bhgqc,cn->bhqn', p_c, ov)
        cur = t // SEL_BLOCK
        valid = blk_ids[None, :] <= cur[:, None]
        forced = (blk_ids[None, :] == 0) | (blk_ids[None, :] == cur[:, None]) | (blk_ids[None, :] == cur[:, None] - 1)
        imp = jnp.where(valid, jnp.where(forced, BIG, imp), NEG)
        top_v, top_i = lax.top_k(imp, top_k)
        kg = k_sel[b_ix, h_ix, top_i]
        vg = v_sel[b_ix, h_ix, top_i]
        pos = top_i[..., None] * SEL_BLOCK + jnp.arange(SEL_BLOCK)
        s = jnp.einsum('bqhgd,bhqnjd->bhgqnj', qb, kg)
        s = s - slopes[None, :, :, None, None, None] * jnp.abs(t[:, None, None] - pos)[:, :, None]
        ok_s = ((top_v > 0.5 * NEG)[..., None] & (pos <= t[:, None, None]))[:, :, None]
        s = jnp.where(ok_s, s, NEG).reshape(B, Hk, G, Q_BLOCK, top_k * SEL_BLOCK)
        p_s = jax.nn.softmax(s, axis=-1)
        o_s = jnp.einsum('bhgqm,bhqmd->bqhgd', p_s, vg.reshape(B, Hk, Q_BLOCK, top_k * SEL_BLOCK, dk))

        kwb = lax.dynamic_slice_in_dim(k_win, q0, Q_BLOCK + WINDOW, 1)
        vwb = lax.dynamic_slice_in_dim(v_win, q0, Q_BLOCK + WINDOW, 1)
        pos_w = q0 - WINDOW + jnp.arange(Q_BLOCK + WINDOW)
        dist = t[:, None] - pos_w[None, :]
        s = jnp.einsum('bqhgd,bkhd->bhgqk', qb, kwb) - slopes[None, :, :, None, None] * jnp.abs(dist)
        ok_w = (pos_w[None, :] >= 0) & (dist >= 0) & (dist < WINDOW)
        p_w = jax.nn.softmax(jnp.where(ok_w, s, NEG), axis=-1)
        o_w = jnp.einsum('bhgqk,bkhd->bqhgd', p_w, vwb)

        return gb[..., 0:1] * o_c + gb[..., 1:2] * o_s + gb[..., 2:3] * o_w

    out = lax.map(query_block, jnp.arange(T // Q_BLOCK))
    return jnp.moveaxis(out, 0, 1).reshape(B, T, D_NSA)


def setup_inputs(seed: int = 0) -> dict:
    key = jax.random.key(seed)
    ks = jax.random.split(key, 26)
    f32 = jnp.float32
    L = DEPTH

    def nrm(k, shape, scale):
        return jax.random.normal(k, shape, f32) * scale

    def gain(k, shape):
        return 1.0 + 0.02 * jax.random.normal(k, shape, f32)

    return {
        'x': nrm(ks[0], (BATCH, SEQ, D_MODEL), 1.0),
        'norm1_g': gain(ks[1], (L, D_MODEL)),
        'w_in': nrm(ks[2], (L, D_MODEL, N_IN), D_MODEL ** -0.5),
        'mu_shift': jax.random.uniform(ks[3], (L, N_RWKV_COLS), f32),
        'rwkv_w0': jax.random.uniform(ks[4], (L, D_RWKV), f32, -4.0, 1.0),
        'rwkv_w2': nrm(ks[5], (L, LORA_W, D_RWKV), 0.1),
        'rwkv_a0': nrm(ks[6], (L, D_RWKV), 0.5),
        'rwkv_a2': nrm(ks[7], (L, LORA_A, D_RWKV), 0.1),
        'rwkv_g2': nrm(ks[8], (L, LORA_G, D_RWKV), LORA_G ** -0.5),
        'rwkv_k_k': 0.85 + 0.05 * jax.random.normal(ks[9], (L, D_RWKV), f32),
        'rwkv_k_a': gain(ks[10], (L, D_RWKV)),
        'rwkv_r_k': nrm(ks[11], (L, RWKV_HEADS, HEAD_DIM), 0.1),
        'rwkv_lnx_w': gain(ks[12], (L, D_RWKV)),
        'rwkv_lnx_b': nrm(ks[13], (L, D_RWKV), 0.01),
        'nsa_pe_k': nrm(ks[14], (L, CMP_BLOCK, HEAD_DIM), 0.1),
        'nsa_pe_v': nrm(ks[15], (L, CMP_BLOCK, HEAD_DIM), 0.1),
        'nsa_cmp_k_w1': nrm(ks[16], (L, CMP_BLOCK * HEAD_DIM, CMP_HIDDEN), (CMP_BLOCK * HEAD_DIM) ** -0.5),
        'nsa_cmp_k_w2': nrm(ks[17], (L, CMP_HIDDEN, HEAD_DIM), CMP_HIDDEN ** -0.5),
        'nsa_cmp_v_w1': nrm(ks[18], (L, CMP_BLOCK * HEAD_DIM, CMP_HIDDEN), (CMP_BLOCK * HEAD_DIM) ** -0.5),
        'nsa_cmp_v_w2': nrm(ks[19], (L, CMP_HIDDEN, HEAD_DIM), CMP_HIDDEN ** -0.5),
        'w_out': nrm(ks[20], (L, D_MIX, D_MODEL), D_MIX ** -0.5),
        'norm2_g': gain(ks[21], (L, D_MODEL)),
        'ffn_w_gate': nrm(ks[22], (L, D_MODEL, D_FF), D_MODEL ** -0.5),
        'ffn_w_up': nrm(ks[23], (L, D_MODEL, D_FF), D_MODEL ** -0.5),
        'ffn_w_down': nrm(ks[24], (L, D_FF, D_MODEL), D_FF ** -0.5),
        'norm_f_g': gain(ks[25], (D_MODEL,)),
    }


def reference(x, norm1_g, w_in, mu_shift, rwkv_w0, rwkv_w2, rwkv_a0, rwkv_a2, rwkv_g2,
              rwkv_k_k, rwkv_k_a, rwkv_r_k, rwkv_lnx_w, rwkv_lnx_b, nsa_pe_k, nsa_pe_v,
              nsa_cmp_k_w1, nsa_cmp_k_w2, nsa_cmp_v_w1, nsa_cmp_v_w2, w_out, norm2_g,
              ffn_w_gate, ffn_w_up, ffn_w_down, norm_f_g):
    h = x
    for i in range(DEPTH):
        u = rms_norm(h, norm1_g[i])
        p_rwkv, p_nsa = jnp.split(u @ w_in[i], [N_RWKV_COLS], axis=-1)
        y_rwkv = rwkv7_time_mix(p_rwkv, mu_shift[i], rwkv_w0[i], rwkv_w2[i], rwkv_a0[i], rwkv_a2[i],
                                rwkv_g2[i], rwkv_k_k[i], rwkv_k_a[i], rwkv_r_k[i],
                                rwkv_lnx_w[i], rwkv_lnx_b[i])
        y_nsa = nsa_attention(p_nsa, nsa_pe_k[i], nsa_pe_v[i], nsa_cmp_k_w1[i], nsa_cmp_k_w2[i],
                              nsa_cmp_v_w1[i], nsa_cmp_v_w2[i])
        y = jnp.concatenate([y_rwkv, y_nsa], axis=-1).astype(h.dtype)
        h = h + y @ w_out[i]
        h = h + swiglu(rms_norm(h, norm2_g[i]), ffn_w_gate[i], ffn_w_up[i], ffn_w_down[i])
    return rms_norm(h, norm_f_g)
```

```cpp
#include <hip/hip_runtime.h>
#include <cstdio>
#include <cstdint>
namespace pg8 {
#define PG8_LAS __attribute__((address_space(3)))
typedef unsigned short bf16_t;
typedef short bf16x8 __attribute__((ext_vector_type(8)));
typedef float f32x4 __attribute__((ext_vector_type(4)));
typedef unsigned u32x4 __attribute__((ext_vector_type(4)));
constexpr int BM = 256, BK = 64, HALF = 128, HTB = HALF * BK * 2  , STAGE_BYTES = 8 * HTB, NXCD = 8, WGM = 8;

__host__ __device__ __forceinline__ int lds_byte(int r, int c) { const int st = (r >> 4) * 2 + (c >> 5), rr = r & 15, cc = c & 31, ob = rr * 64 + cc * 2; return st * 1024 + (ob ^ (((ob >> 9) & 1) << 5)); }
__host__ __device__ __forceinline__ void stage_rc(int b, int& R, int& C) { const int st = b / 1024, sb = b % 1024, swz = sb ^ (((sb >> 9) & 1) << 5); R = (st >> 1) * 16 + swz / 64; C = (st & 1) * 32 + (swz % 64) / 2; }
__host__ __device__ __forceinline__ int perm32(int rho) { const int n = rho >> 4, i = rho & 15; return 8 * (i >> 2) + 4 * n + (i & 3); }

struct Unit { int pm, pn; };
struct Gemm { const bf16_t* A; const bf16_t* Bt; int M, N, K; };

struct StaticOrder {
    int nM, nN, nwg, G, c;
    __host__ __device__ void init(int M, int N, int G_, int c_) { nM = M / BM; nN = N / BM; nwg = nM * nN; G = G_; c = c_; }
    __host__ __device__ bool next(int i, Unit& u) const {
        const long L = (long)i * G + c; if (L >= nwg) return false;
        int wgid = (int)L; { const int q = nwg / NXCD, r = nwg % NXCD, xcd = wgid % NXCD, off = wgid / NXCD; wgid = (xcd < r ? xcd * (q + 1) : r * (q + 1) + (xcd - r) * q) + off; }
        const int nig = WGM * nN, gid = wgid / nig, fm = gid * WGM, gsz = (nM - fm) < WGM ? (nM - fm) : WGM;
        u.pm = fm + ((wgid % nig) % gsz); u.pn = (wgid % nig) / gsz; return true;
    }
    __device__ __forceinline__ void a_ready(const Unit&) const {}
    __device__ __forceinline__ void done(const Unit&) const {}
};

__device__ __forceinline__ unsigned cvt_pk_bf16(float lo, float hi) { unsigned r; asm volatile("v_cvt_pk_bf16_f32 %0, %1, %2" : "=v"(r) : "v"(lo), "v"(hi)); return r; }
typedef float f32x2 __attribute__((ext_vector_type(2)));
__device__ __forceinline__ f32x2 gelu_pk(f32x2 v) {
    const f32x2 av = __builtin_elementwise_abs(v), d = av * 0.2316418882f + 1.0f;
    f32x2 t; t.x = __builtin_amdgcn_rcpf(d.x); t.y = __builtin_amdgcn_rcpf(d.y);
    f32x2 q = t * 0.5307027145f + (-0.7265760135f); q = q * t + 0.7107068705f; q = q * t + (-0.142248368f); q = q * t + 0.127414796f; q = q * t;
    const f32x2 s = (v * v) * (-0.72134752044f);
    f32x2 e; e.x = __builtin_amdgcn_exp2f(s.x); e.y = __builtin_amdgcn_exp2f(s.y);
    const f32x2 m = v * (q * e), r = v - m;
    f32x2 o; o.x = v.x < 0.f ? m.x : r.x; o.y = v.y < 0.f ? m.y : r.y; return o;
}

template <int ACT  > struct EpiBf16 {
    static constexpr bool PERM = true, AFTER_DRAIN = false; static_assert(ACT == 0 || ACT == 1, "EpiBf16: ACT is 0 (none) or 1 (gelu_pk)");
    bf16_t* O; int ldc; const float* bias; int split_cols; size_t split_stride; float scale0;
    __device__ __forceinline__ void operator()(const f32x4 (&acc)[2][2][4][2], const Unit& u, int wr, int wc, int fr, int fq) const {
        const int row0 = u.pm * BM + wr * 64 + fr; int colt = u.pn * BM; bf16_t* base = O;
        float sc = 1.f; if (split_cols) { const int t = colt / split_cols; base += (size_t)t * split_stride; colt -= t * split_cols; if (t == 0) sc = scale0; }
        const int col0 = colt + wc * 32 + 8 * fq, bcol0 = u.pn * BM + wc * 32 + 8 * fq;
        f32x4 bv[2][2];
#pragma unroll
        for (int bj = 0; bj < 2; ++bj)
#pragma unroll
            for (int n = 0; n < 2; ++n) bv[bj][n] = bias ? *(const f32x4*)(bias + bcol0 + bj * HALF + 4 * n) : (f32x4){0.f, 0.f, 0.f, 0.f};
#pragma unroll
        for (int ai = 0; ai < 2; ++ai)
#pragma unroll
            for (int m = 0; m < 4; ++m) { bf16_t* rowp = base + (size_t)(row0 + ai * HALF + m * 16) * ldc + col0;
#pragma unroll
                for (int bj = 0; bj < 2; ++bj) { f32x4 v0 = acc[ai][bj][m][0] + bv[bj][0], v1 = acc[ai][bj][m][1] + bv[bj][1];
                    if (ACT == 1) { f32x2 a = gelu_pk((f32x2){v0[0], v0[1]}), b = gelu_pk((f32x2){v0[2], v0[3]}), c = gelu_pk((f32x2){v1[0], v1[1]}), d = gelu_pk((f32x2){v1[2], v1[3]});
                        v0 = (f32x4){a.x, a.y, b.x, b.y}; v1 = (f32x4){c.x, c.y, d.x, d.y}; }
                    v0 = v0 * sc; v1 = v1 * sc; u32x4 w; w.x = cvt_pk_bf16(v0[0], v0[1]); w.y = cvt_pk_bf16(v0[2], v0[3]); w.z = cvt_pk_bf16(v1[0], v1[1]); w.w = cvt_pk_bf16(v1[2], v1[3]);
                    *(u32x4*)(rowp + bj * HALF) = w; } }
    }
};

struct EpiRowScaleBf16 {
    static constexpr bool PERM = true, AFTER_DRAIN = false;
    bf16_t* O; int ldc; const float* rs;
    __device__ __forceinline__ void operator()(const f32x4 (&acc)[2][2][4][2], const Unit& u, int wr, int wc, int fr, int fq) const {
        const int row0 = u.pm * BM + wr * 64 + fr; const int col0 = u.pn * BM + wc * 32 + 8 * fq;
#pragma unroll
        for (int ai = 0; ai < 2; ++ai)
#pragma unroll
            for (int m = 0; m < 4; ++m) { const int row = row0 + ai * HALF + m * 16; const float s = rs[row]; bf16_t* rowp = O + (size_t)row * ldc + col0;
#pragma unroll
                for (int bj = 0; bj < 2; ++bj) { const f32x4 v0 = acc[ai][bj][m][0] * s, v1 = acc[ai][bj][m][1] * s;
                    u32x4 w; w.x = cvt_pk_bf16(v0[0], v0[1]); w.y = cvt_pk_bf16(v0[2], v0[3]); w.z = cvt_pk_bf16(v1[0], v1[1]); w.w = cvt_pk_bf16(v1[2], v1[3]);
                    *(u32x4*)(rowp + bj * HALF) = w; } }
    }
};
struct EpiResid {
    static constexpr bool PERM = true, AFTER_DRAIN = false;
    const float* base; float* out; bf16_t* ob; float* ssq; int ldc;
    __device__ __forceinline__ void operator()(const f32x4 (&acc)[2][2][4][2], const Unit& u, int wr, int wc, int fr, int fq) const {
        const int row0 = u.pm * BM + wr * 64 + fr; const int col0 = u.pn * BM + wc * 32 + 8 * fq;
#pragma unroll
        for (int ai = 0; ai < 2; ++ai)
#pragma unroll
            for (int m = 0; m < 4; ++m) { const int row = row0 + ai * HALF + m * 16; const size_t off = (size_t)row * ldc + col0; float ss = 0.f;
#pragma unroll
                for (int bj = 0; bj < 2; ++bj) {
                    const f32x4 b0 = *(const f32x4*)(base + off + bj * HALF), b1 = *(const f32x4*)(base + off + bj * HALF + 4);
                    const f32x4 v0 = acc[ai][bj][m][0] + b0, v1 = acc[ai][bj][m][1] + b1;
                    *(f32x4*)(out + off + bj * HALF) = v0; *(f32x4*)(out + off + bj * HALF + 4) = v1;
                    ss += (v0[0] * v0[0] + v0[1] * v0[1]) + (v0[2] * v0[2] + v0[3] * v0[3]) + (v1[0] * v1[0] + v1[1] * v1[1]) + (v1[2] * v1[2] + v1[3] * v1[3]);
                    if (ob) { u32x4 w; w.x = cvt_pk_bf16(v0[0], v0[1]); w.y = cvt_pk_bf16(v0[2], v0[3]); w.z = cvt_pk_bf16(v1[0], v1[1]); w.w = cvt_pk_bf16(v1[2], v1[3]);
                        *(u32x4*)(ob + off + bj * HALF) = w; } }
                ss += __shfl_xor(ss, 16); ss += __shfl_xor(ss, 32);
                if (fq == 0) atomicAdd(ssq + row, ss); }
    }
};
struct EpiSwiGLU {
    static constexpr bool PERM = true, AFTER_DRAIN = false;
    bf16_t* O; int ldc; const float* ssq; float eps;
    __device__ __forceinline__ void operator()(const f32x4 (&acc)[2][2][4][2], const Unit& u, int wr, int wc, int fr, int fq) const {
        const int row0 = u.pm * BM + wr * 64 + fr; const int col0 = u.pn * HALF + wc * 32 + 8 * fq;
#pragma unroll
        for (int ai = 0; ai < 2; ++ai)
#pragma unroll
            for (int m = 0; m < 4; ++m) { const int row = row0 + ai * HALF + m * 16; const float s = 1.0f / sqrtf(ssq[row] * (1.0f / 1024.0f) + eps);
                float a[8];
#pragma unroll
                for (int n = 0; n < 2; ++n)
#pragma unroll
                    for (int j = 0; j < 4; ++j) { const float g = acc[ai][0][m][n][j] * s, up = acc[ai][1][m][n][j] * s; a[n * 4 + j] = g / (1.0f + __expf(-g)) * up; }
                u32x4 w; w.x = cvt_pk_bf16(a[0], a[1]); w.y = cvt_pk_bf16(a[2], a[3]); w.z = cvt_pk_bf16(a[4], a[5]); w.w = cvt_pk_bf16(a[6], a[7]);
                *(u32x4*)(O + (size_t)row * ldc + col0) = w; }
    }
};
template <class Epi, class Sched, bool ALIGN_EPI = false, bool SP2 = false>
__device__ __forceinline__ void gemm_phase(PG8_LAS unsigned char* lds, const Gemm g, const Sched& S, const Epi& E) {
    const int tid = threadIdx.x, wid = __builtin_amdgcn_readfirstlane(tid >> 6), lane = tid & 63, wr = wid >> 2, wc = wid & 3, fr = lane & 15, fq = lane >> 4;
    const int K = g.K, nt = K / BK;
    unsigned voffA[2], voffB[2];
#pragma unroll
    for (int i = 0; i < 2; ++i) { int R, C; stage_rc(tid * 16 + i * 8192, R, C); const int Rb = Epi::PERM ? ((R & ~31) + perm32(R & 31)) : R;
        voffA[i] = (unsigned)(R * K + C) * 2u; voffB[i] = (unsigned)(Rb * K + C) * 2u; }
    const size_t kstep = (size_t)(BK * 2);
    const size_t hstep = (size_t)HALF * K * 2;
    const size_t tstep = 2 * hstep;
    const unsigned ldsw = (unsigned)wid * 1024u;
    const int aoff = lds_byte(wr * 64 + fr, fq * 8), boff = lds_byte(wc * 32 + fr, fq * 8);
#define PG8_SA(b, h) (((b) * 2 + (h)) * HTB)
#define PG8_SB(b, h) ((4 + (b) * 2 + (h)) * HTB)
#define PG8_STAGE(bufoff, gbase, voff) do { _Pragma("unroll") for (int _i = 0; _i < 2; ++_i) \
        __builtin_amdgcn_global_load_lds((const unsigned*)((const char*)(gbase) + (voff)[_i]), (PG8_LAS unsigned*)(lds + (bufoff) + ldsw + _i * 8192), 16, 0, 0); } while (0)
#define PG8_LDA(dst, b, h) do { _Pragma("unroll") for (int m = 0; m < 4; ++m) _Pragma("unroll") for (int k = 0; k < 2; ++k) dst[m][k] = *(const PG8_LAS bf16x8*)(lds + PG8_SA(b, h) + aoff + m * 2048 + k * 1024); } while (0)
#define PG8_LDB(dst, b, h) do { _Pragma("unroll") for (int n = 0; n < 2; ++n) _Pragma("unroll") for (int k = 0; k < 2; ++k) dst[n][k] = *(const PG8_LAS bf16x8*)(lds + PG8_SB(b, h) + boff + n * 2048 + k * 1024); } while (0)
#define PG8_MMA(ai, bj, At, Bt) do { __builtin_amdgcn_s_setprio(1); _Pragma("unroll") for (int m = 0; m < 4; ++m) _Pragma("unroll") for (int n = 0; n < 2; ++n) _Pragma("unroll") for (int k = 0; k < 2; ++k) \
        acc[ai][bj][m][n] = __builtin_amdgcn_mfma_f32_16x16x32_bf16(Bt[n][k], At[m][k], acc[ai][bj][m][n], 0, 0, 0); __builtin_amdgcn_s_setprio(0); } while (0)
#define PG8_WAIT_V(n) asm volatile("s_waitcnt vmcnt(" #n ")" ::: "memory")
#define PG8_WAIT_L(n) asm volatile("s_waitcnt lgkmcnt(" #n ")" ::: "memory")
#define PG8_BAR __builtin_amdgcn_s_barrier()
#define PG8_SCHED __builtin_amdgcn_sched_barrier(0)
    Unit cur, nxt; int ui = 0;
    if (!S.next(0, cur)) return;
    f32x4 acc[2][2][4][2];
#pragma unroll
    for (int a = 0; a < 2; ++a)
#pragma unroll
        for (int b = 0; b < 2; ++b)
#pragma unroll
            for (int m = 0; m < 4; ++m)
#pragma unroll
                for (int n = 0; n < 2; ++n) acc[a][b][m][n] = (f32x4){0.f, 0.f, 0.f, 0.f};
    bf16x8 At[4][2], B0[2][2], B1[2][2];
    const char* cA = (const char*)g.A + (size_t)cur.pm * tstep; const char* cB = (const char*)g.Bt + (size_t)cur.pn * tstep;
    S.a_ready(cur);
    if constexpr (SP2) {
        PG8_STAGE(PG8_SB(0, 0), cB, voffB); PG8_STAGE(PG8_SB(0, 1), cB + hstep, voffB); PG8_STAGE(PG8_SA(0, 0), cA, voffA); PG8_STAGE(PG8_SA(0, 1), cA + hstep, voffA);
        if (wr == 1) PG8_BAR;
        PG8_WAIT_V(2); PG8_BAR;
        PG8_STAGE(PG8_SB(1, 0), cB + kstep, voffB); PG8_STAGE(PG8_SA(1, 0), cA + kstep, voffA); PG8_STAGE(PG8_SB(1, 1), cB + hstep + kstep, voffB);
        PG8_WAIT_V(6); PG8_BAR;
    } else {
        PG8_STAGE(PG8_SB(0, 0), cB, voffB); PG8_STAGE(PG8_SA(0, 0), cA, voffA); PG8_STAGE(PG8_SB(0, 1), cB + hstep, voffB); PG8_STAGE(PG8_SA(0, 1), cA + hstep, voffA);
        if (wr == 1) PG8_BAR;
        PG8_WAIT_V(4); PG8_BAR;
        PG8_STAGE(PG8_SB(1, 0), cB + kstep, voffB); PG8_STAGE(PG8_SA(1, 0), cA + kstep, voffA); PG8_STAGE(PG8_SB(1, 1), cB + hstep + kstep, voffB);
        PG8_WAIT_V(6); PG8_BAR;
    }
    for (;;) {
        const bool has_next = S.next(ui + 1, nxt);
        const char* nA = has_next ? (const char*)g.A + (size_t)nxt.pm * tstep : cA; const char* nB = has_next ? (const char*)g.Bt + (size_t)nxt.pn * tstep : cB;
        for (int t = 0; t < nt; t += 2) {
            const bool last = (t == nt - 2);
            const char* a1 = cA + (size_t)(t + 1) * kstep;
            const char* a2 = last ? nA : cA + (size_t)(t + 2) * kstep; const char* b2 = last ? nB : cB + (size_t)(t + 2) * kstep;
            const char* a3 = a2 + kstep; const char* b3 = b2 + kstep;
            if (last && has_next) S.a_ready(nxt);
            if constexpr (SP2) {
            PG8_LDB(B0, 0, 0); PG8_LDB(B1, 0, 1); PG8_SCHED; PG8_LDA(At, 0, 0); PG8_STAGE(PG8_SA(1, 1), a1 + hstep, voffA);
            PG8_WAIT_V(8); PG8_WAIT_L(0); PG8_BAR; PG8_MMA(0, 0, At, B0); PG8_MMA(0, 1, At, B1); PG8_BAR; PG8_SCHED;
            PG8_LDA(At, 0, 1); PG8_STAGE(PG8_SB(0, 0), b2, voffB); PG8_STAGE(PG8_SB(0, 1), b2 + hstep, voffB); PG8_STAGE(PG8_SA(0, 0), a2, voffA);
            PG8_WAIT_V(8); PG8_WAIT_L(0); PG8_BAR; PG8_MMA(1, 0, At, B0); PG8_MMA(1, 1, At, B1); PG8_BAR; PG8_SCHED;
            PG8_LDB(B0, 1, 0); PG8_LDB(B1, 1, 1); PG8_SCHED; PG8_LDA(At, 1, 0); PG8_STAGE(PG8_SA(0, 1), a2 + hstep, voffA);
            PG8_WAIT_V(8); PG8_WAIT_L(0); PG8_BAR; PG8_MMA(0, 0, At, B0); PG8_MMA(0, 1, At, B1); PG8_BAR; PG8_SCHED;
            PG8_LDA(At, 1, 1); PG8_STAGE(PG8_SB(1, 0), b3, voffB); PG8_STAGE(PG8_SB(1, 1), b3 + hstep, voffB); PG8_STAGE(PG8_SA(1, 0), a3, voffA);
            PG8_WAIT_V(8); PG8_WAIT_L(0); PG8_BAR; PG8_MMA(1, 0, At, B0); PG8_MMA(1, 1, At, B1); PG8_BAR; PG8_SCHED;
            } else {
            PG8_LDB(B0, 0, 0); PG8_SCHED; PG8_LDA(At, 0, 0); PG8_STAGE(PG8_SA(1, 1), a1 + hstep, voffA);
            PG8_WAIT_L(8); PG8_BAR; PG8_WAIT_L(0); PG8_MMA(0, 0, At, B0); PG8_BAR; PG8_SCHED;
            PG8_LDB(B1, 0, 1); PG8_STAGE(PG8_SB(0, 0), b2, voffB);
            PG8_BAR; PG8_WAIT_L(0); PG8_MMA(0, 1, At, B1); PG8_BAR;
            PG8_LDA(At, 0, 1); PG8_STAGE(PG8_SA(0, 0), a2, voffA);
            PG8_BAR; PG8_WAIT_L(0); PG8_MMA(1, 0, At, B0); PG8_BAR; PG8_SCHED;
            PG8_STAGE(PG8_SB(0, 1), b2 + hstep, voffB);
            PG8_WAIT_V(6); PG8_BAR; PG8_MMA(1, 1, At, B1); PG8_BAR;
            PG8_LDB(B0, 1, 0); PG8_SCHED; PG8_LDA(At, 1, 0); PG8_STAGE(PG8_SA(0, 1), a2 + hstep, voffA);
            PG8_WAIT_L(8); PG8_BAR; PG8_WAIT_L(0); PG8_MMA(0, 0, At, B0); PG8_BAR; PG8_SCHED;
            PG8_LDB(B1, 1, 1); PG8_STAGE(PG8_SB(1, 0), b3, voffB);
            PG8_BAR; PG8_WAIT_L(0); PG8_MMA(0, 1, At, B1); PG8_BAR;
            PG8_LDA(At, 1, 1); PG8_STAGE(PG8_SA(1, 0), a3, voffA);
            PG8_BAR; PG8_WAIT_L(0); PG8_MMA(1, 0, At, B0); PG8_BAR; PG8_SCHED;
            PG8_STAGE(PG8_SB(1, 1), b3 + hstep, voffB);
            PG8_WAIT_V(6); PG8_BAR; PG8_MMA(1, 1, At, B1); PG8_BAR;
            }
        }
        if constexpr (ALIGN_EPI) { if (wr == 0) PG8_BAR; }
        if constexpr (!Epi::AFTER_DRAIN) { E(acc, cur, wr, wc, fr, fq); S.done(cur); }
        if (!has_next) break;
#pragma unroll
        for (int a = 0; a < 2; ++a)
#pragma unroll
            for (int b = 0; b < 2; ++b)
#pragma unroll
                for (int m = 0; m < 4; ++m)
#pragma unroll
                    for (int n = 0; n < 2; ++n) acc[a][b][m][n] = (f32x4){0.f, 0.f, 0.f, 0.f};
        cur = nxt; cA = nA; cB = nB; ++ui;
        if constexpr (ALIGN_EPI) { if (wr == 1) PG8_BAR; }
    }
    PG8_WAIT_V(0);
    if constexpr (!ALIGN_EPI) { if (wr == 0) PG8_BAR; }
    PG8_BAR;
    if constexpr (Epi::AFTER_DRAIN) { E.fused(acc, cur, wr, wc, fr, fq, lds, wid, lane); S.done(cur); }
#undef PG8_SA
#undef PG8_SB
#undef PG8_STAGE
#undef PG8_LDA
#undef PG8_LDB
#undef PG8_MMA
#undef PG8_WAIT_V
#undef PG8_WAIT_L
#undef PG8_BAR
#undef PG8_SCHED
}
}

#ifndef PG8_SP2
#define PG8_SP2 true
#endif
#ifndef PG8_ALIGN
#define PG8_ALIGN true
#endif

constexpr int NWAVES = 8;
constexpr int BATCH = 2, T = 8192, D = 1024, M = BATCH * T;
constexpr int NIN = 3096, NMAIN = 3072, DFF = 2816, NGU = 2 * DFF;
constexpr int C_R = 0, C_K = 512, C_V = 1024, C_DW = 1536, C_DA = 1600, C_DG = 1664, C_Q = 1792, C_KC = 2304, C_VC = 2432, C_KS = 2560, C_VS = 2688, C_KW = 2816, C_VW = 2944, C_GL = 3072;
constexpr int NCMP = 511, NCMPP = 512;
constexpr float NORM_EPS = 1e-6f, GN_EPS = 64e-5f, NEGV = -1e30f, BIGV = 1e30f;

constexpr size_t MiB = 1u << 20;
constexpr size_t WS_CTL = 0, CTL_ZERO_BYTES = 1 * MiB;
constexpr size_t WS_WIN = 2 * MiB;
constexpr size_t WS_WOUT = 9 * MiB;
constexpr size_t WS_WGU = 11 * MiB;
constexpr size_t WS_WD = 22 * MiB;
constexpr size_t WS_RSTD1 = 28 * MiB;
constexpr size_t WS_GATES = 28 * MiB + 256 * 1024;
constexpr size_t WS_CMP = 30 * MiB;
constexpr size_t WS_XB = 32 * MiB;
constexpr size_t WS_PB = 64 * MiB;
constexpr size_t WS_HB = 160 * MiB;
constexpr size_t WS_G = 192 * MiB;
constexpr size_t WS_END = 256 * MiB;
constexpr int CW_BAR = 4096;
constexpr int CW_SSQ2 = 65536;
constexpr int CW_SSQ3 = 65536 + 16384;
constexpr int CW_QUEUE = 2048;
static_assert((CW_SSQ3 + 16384) * 4 <= (int)CTL_ZERO_BYTES, "ctl");

constexpr int RING_OFF = 0, RING_BYTES = 131072;
constexpr int LDSCTL_OFF = RING_BYTES, MISC_OFF = LDSCTL_OFF + 320;
constexpr int LDS_BYTES = 147456;
#define GAS __attribute__((address_space(1)))
#define LAS __attribute__((address_space(3)))
typedef unsigned short bf16;
typedef unsigned v4u __attribute__((ext_vector_type(4)));
typedef float f32x4 __attribute__((ext_vector_type(4)));
typedef short bf16x8 __attribute__((ext_vector_type(8)));
typedef GAS unsigned gu32;
typedef GAS unsigned long long gu64;
#define RLX_AGENT __ATOMIC_RELAXED, __HIP_MEMORY_SCOPE_AGENT
#define LDS_WAIT() asm volatile("s_waitcnt lgkmcnt(0)" ::: "memory")
#define VM_WAIT() asm volatile("s_waitcnt vmcnt(0)" ::: "memory")
__device__ __forceinline__ unsigned long long rt() { return __builtin_amdgcn_s_memrealtime(); }
__device__ __forceinline__ unsigned f2bf(float f) { unsigned u = __builtin_bit_cast(unsigned, f); return (u + 0x7fffu + ((u >> 16) & 1u)) >> 16; }
__device__ __forceinline__ unsigned pk2(float lo, float hi) { return f2bf(lo) | (f2bf(hi) << 16); }

#define XB_TMO      128
#define XB_XCNT(j)  (256  + 64 * (j))
#define XB_XSUB(j)  (1280 + 64 * (j))
#define XB_XGEN(j)  (2304 + 64 * (j))
#define XB_TOP      3328
#define XB_TOPGEN   3392
#define XCD_BAR_WORDS 3456
#define XB_SPIN_CAP (1u << 18)

__device__ __forceinline__ unsigned xb_ld(unsigned* p)              { return __hip_atomic_load(p, __ATOMIC_RELAXED, __HIP_MEMORY_SCOPE_AGENT); }
__device__ __forceinline__ unsigned xb_add(unsigned* p, unsigned v) { return __hip_atomic_fetch_add(p, v, __ATOMIC_RELAXED, __HIP_MEMORY_SCOPE_AGENT); }
__device__ __forceinline__ unsigned xb_xcc_id() { return (unsigned)__builtin_amdgcn_s_getreg((3 << 11) | 20) & 0xFu; }
#define XB_SPIN(cond, bar) do { unsigned _sp = 0; while (cond) { __builtin_amdgcn_s_sleep(1); \
    if ((++_sp & 255u) == 0u) { if (xb_ld(&(bar)[XB_TMO])) break; if (_sp > XB_SPIN_CAP) { atomicAdd(&(bar)[XB_TMO], 1u); break; } } } } while (0)

struct XcdBarrier {
    unsigned* bar; unsigned x;
    volatile LAS unsigned* st;
};

__device__ __forceinline__ XcdBarrier xcd_barrier_post(unsigned* bar, volatile LAS unsigned* st) {
    XcdBarrier b; b.bar = bar; b.x = xb_xcc_id(); b.st = st;
    if (threadIdx.x == 0) (void)xb_add(&bar[XB_XCNT(b.x)], 1u);
    return b;
}
__device__ __forceinline__ void xcd_barrier_complete(unsigned* bar, unsigned x, unsigned& nloc, unsigned& nx) {
    const unsigned G = gridDim.x * gridDim.y * gridDim.z;
    unsigned sum, cnt, mine, sp = 0u;
    for (;;) {
        sum = 0u; cnt = 0u; mine = 0u;
#pragma unroll
        for (unsigned j = 0; j < 16; ++j) { const unsigned c = xb_ld(&bar[XB_XCNT(j)]); sum += c; cnt += (c > 0u) ? 1u : 0u; mine = (j == x) ? c : mine; }
        if (sum == G) break;
        __builtin_amdgcn_s_sleep(1);
        if ((++sp & 255u) == 0u) { if (xb_ld(&bar[XB_TMO])) break; if (sp > XB_SPIN_CAP) { atomicAdd(&bar[XB_TMO], 1u); break; } }
    }
    nloc = mine > 0u ? mine : 1u; nx = cnt > 0u ? cnt : 1u;
}

__device__ __forceinline__ void xcd_barrier(const XcdBarrier& b) {
    asm volatile("s_waitcnt vmcnt(0)" ::: "memory");
    __syncthreads();
    if (threadIdx.x == 0) {
        unsigned* bar = b.bar;
        __builtin_amdgcn_s_waitcnt(0);
        unsigned nloc = b.st[0], nx = b.st[1];
        if (nloc == 0u) { xcd_barrier_complete(bar, b.x, nloc, nx); b.st[0] = nloc; b.st[1] = nx; }
        const unsigned old = xb_add(&bar[XB_XSUB(b.x)], 1u);
        const unsigned gen = old / nloc;
        if (old + 1u == (gen + 1u) * nloc) {
            __builtin_amdgcn_fence(__ATOMIC_RELEASE, "agent");
            asm volatile("s_waitcnt vmcnt(0)" ::: "memory");
            const unsigned og = xb_add(&bar[XB_TOP], 1u);
            const unsigned tg = og / nx;
            if (og + 1u == (tg + 1u) * nx) xb_add(&bar[XB_TOPGEN], 1u);
            else XB_SPIN(xb_ld(&bar[XB_TOPGEN]) == tg, bar);
            __builtin_amdgcn_fence(__ATOMIC_ACQUIRE, "agent");
            xb_add(&bar[XB_XGEN(b.x)], 1u);
            asm volatile("s_waitcnt vmcnt(0)" ::: "memory");
        } else {
            XB_SPIN(xb_ld(&bar[XB_XGEN(b.x)]) == gen, bar);
            __builtin_amdgcn_fence(__ATOMIC_ACQUIRE, "agent");
            asm volatile("s_waitcnt vmcnt(0)" ::: "memory");
        }
    }
    __syncthreads();
}


struct Frame {
    LAS unsigned char* lds;
    volatile LAS unsigned* MISC;
    gu32* ctl;
    int tid, lane, wave;
    int vcu, G;
    const float* in[26];
    float* out; unsigned char* ws;
};
__device__ __forceinline__ float wave_sum(float v) {
#pragma unroll
    for (int o = 1; o < 64; o <<= 1) v += __shfl_xor(v, o);
    return v;
}
__device__ __forceinline__ float wave_max(float v) {
#pragma unroll
    for (int o = 1; o < 64; o <<= 1) v = fmaxf(v, __shfl_xor(v, o));
    return v;
}
__device__ __forceinline__ float bf2f(bf16 b) { return __builtin_bit_cast(float, (unsigned)b << 16); }
__device__ __forceinline__ float sigmoidf_(float x) { return 1.0f / (1.0f + expf(-x)); }
__device__ __forceinline__ float softplusf_(float z) { return z > 20.f ? z : log1pf(expf(z)); }
__device__ __forceinline__ float gelu_tanhf_(float x) { const float u = 0.7978845608028654f * (x + 0.044715f * x * x * x); return 0.5f * x * (1.0f + tanhf(u)); }

template <int MODE  >
__device__ __forceinline__ void p0_transpose_item(const float* W, int K, int N, const float* gain, bf16* WT, LAS float* scr, int item, int lane) {
    const int nblk = (N + 31) / 32, kb = item / nblk, nb = item % nblk, k0 = 64 * kb, n0 = 32 * nb;
#pragma unroll 8
    for (int i = 0; i < 32; ++i) { const int kk = 2 * i + (lane >> 5); const int n = n0 + (lane & 31);
        float v = 0.f; if (n < N) { v = W[(size_t)(k0 + kk) * N + n]; if (gain) v *= gain[k0 + kk]; }
        scr[kk * 33 + (lane & 31)] = v; }
    LDS_WAIT(); asm volatile("" ::: "memory");
    const int c = lane & 7;
    int rb = n0; if (MODE == 1) rb = 256 * (n0 / 128) + (n0 % 128); if (MODE == 2) rb = 256 * (n0 / 128) + 128 + (n0 % 128);
#pragma unroll
    for (int j = 0; j < 4; ++j) { const int n = (lane >> 3) + 8 * j; const LAS float* s = scr + (8 * c) * 33 + n;
        v4u o; o.x = pk2(s[0 * 33], s[1 * 33]); o.y = pk2(s[2 * 33], s[3 * 33]); o.z = pk2(s[4 * 33], s[5 * 33]); o.w = pk2(s[6 * 33], s[7 * 33]);
        *(GAS v4u*)(WT + (size_t)(rb + n) * K + k0 + 8 * c) = o; }
    LDS_WAIT(); asm volatile("" ::: "memory");
}
__device__ __forceinline__ void p0_prologue(Frame& F) {
    LAS float* scr = (LAS float*)(F.lds + RING_OFF + F.wave * 16384);
    const int gw = F.vcu * NWAVES + F.wave, NGW = F.G * NWAVES;
    constexpr int I_IN = (D / 64) * ((NIN + 31) / 32), I_OUT = (D / 64) * (D / 32), I_G = (D / 64) * (DFF / 32), I_D = (DFF / 64) * (D / 32);
    constexpr int NITEMS = I_IN + I_OUT + 2 * I_G + I_D;
    bf16* Win_t = (bf16*)(F.ws + WS_WIN); bf16* Wout_t = (bf16*)(F.ws + WS_WOUT); bf16* Wgu_t = (bf16*)(F.ws + WS_WGU); bf16* Wd_t = (bf16*)(F.ws + WS_WD);
    for (int it = gw; it < NITEMS; it += NGW) {
        int r = it;
        if (r < I_IN) { p0_transpose_item<0>(F.in[2], D, NIN, F.in[1], Win_t, scr, r, F.lane); continue; } r -= I_IN;
        if (r < I_OUT) { p0_transpose_item<0>(F.in[20], D, D, nullptr, Wout_t, scr, r, F.lane); continue; } r -= I_OUT;
        if (r < I_G) { p0_transpose_item<1>(F.in[22], D, DFF, F.in[21], Wgu_t, scr, r, F.lane); continue; } r -= I_G;
        if (r < I_G) { p0_transpose_item<2>(F.in[23], D, DFF, F.in[21], Wgu_t, scr, r, F.lane); continue; } r -= I_G;
        p0_transpose_item<0>(F.in[24], DFF, D, nullptr, Wd_t, scr, r, F.lane);
    }
    bf16* XB = (bf16*)(F.ws + WS_XB); float* rstd1 = (float*)(F.ws + WS_RSTD1);
    for (int m = gw; m < M; m += NGW) {
        const GAS f32x4* xr = (const GAS f32x4*)(F.in[0] + (size_t)m * D) + F.lane;
        f32x4 v[4]; float s = 0.f;
#pragma unroll
        for (int j = 0; j < 4; ++j) { v[j] = xr[64 * j]; s += (v[j].x * v[j].x + v[j].y * v[j].y) + (v[j].z * v[j].z + v[j].w * v[j].w); }
        const float tot = wave_sum(s);
        GAS unsigned long long* o8 = (GAS unsigned long long*)(XB + (size_t)m * D) + F.lane;
#pragma unroll
        for (int j = 0; j < 4; ++j) o8[64 * j] = (unsigned long long)pk2(v[j].x, v[j].y) | ((unsigned long long)pk2(v[j].z, v[j].w) << 32);
        if (F.lane == 0) rstd1[m] = 1.0f / sqrtf(tot * (1.0f / D) + NORM_EPS);
    }
}

__device__ __forceinline__ void p2_gates_naive(Frame& F) {
    const int gw = F.vcu * NWAVES + F.wave, NGW = F.G * NWAVES, lane = F.lane;
    const bf16* XB = (const bf16*)(F.ws + WS_XB); const bf16* Wg = (const bf16*)(F.ws + WS_WIN) + (size_t)C_GL * D; const float* rstd1 = (const float*)(F.ws + WS_RSTD1);
    float* gates = (float*)(F.ws + WS_GATES);
    for (int m = gw; m < M; m += NGW) {
        float xv[16];
        { const bf16x8 a = *(const bf16x8*)(XB + (size_t)m * D + lane * 16), b = *(const bf16x8*)(XB + (size_t)m * D + lane * 16 + 8);
#pragma unroll
          for (int j = 0; j < 8; ++j) { xv[j] = bf2f((bf16)a[j]); xv[8 + j] = bf2f((bf16)b[j]); } }
        const float rs = rstd1[m];
        float mine = 0.f;
        for (int j = 0; j < 24; ++j) {
            const bf16x8 a = *(const bf16x8*)(Wg + (size_t)j * D + lane * 16), b = *(const bf16x8*)(Wg + (size_t)j * D + lane * 16 + 8);
            float s = 0.f;
#pragma unroll
            for (int q = 0; q < 8; ++q) { s += xv[q] * bf2f((bf16)a[q]); s += xv[8 + q] * bf2f((bf16)b[q]); }
            s = wave_sum(s);
            if (lane == j) mine = s;
        }
        if (lane < 24) gates[(size_t)m * 24 + lane] = sigmoidf_(mine * rs);
    }
}
__device__ __forceinline__ void p2_rwkv_prep_naive(Frame& F) {
    LAS float* L = (LAS float*)(F.lds + RING_OFF);
    const bf16* PB = (const bf16*)(F.ws + WS_PB);
    const float* mu = F.in[3]; const float* w0 = F.in[4]; const float* w2 = F.in[5]; const float* a0 = F.in[6]; const float* a2 = F.in[7]; const float* g2 = F.in[8];
    float* wdec = F.out; float* asig = F.out + (size_t)M * 512; float* gg = (float*)(F.ws + WS_G);
    const int c = F.tid;
    for (int it = F.vcu; it < M / 16; it += F.G) {
        const int r0 = it * 16;
        for (int idx = F.tid; idx < 16 * 256; idx += NWAVES * 64) {
            const int tok = idx >> 8, j = idx & 255; const int row = r0 + tok; const int col = C_DW + j;
            const float p = bf2f(PB[(size_t)row * NMAIN + col]);
            const float pp = ((row % T) == 0) ? 0.f : bf2f(PB[(size_t)(row - 1) * NMAIN + col]);
            const float ps = p + mu[col] * (pp - p);
            L[tok * 256 + j] = (j < 64) ? tanhf(ps) : (j < 128 ? ps : sigmoidf_(ps));
        }
        __syncthreads();
        float aw[16], aa[16], ag[16];
#pragma unroll
        for (int k = 0; k < 16; ++k) { aw[k] = 0.f; aa[k] = 0.f; ag[k] = 0.f; }
        for (int j = 0; j < 64; ++j) { const float w = w2[j * 512 + c], a = a2[j * 512 + c];
#pragma unroll
            for (int k = 0; k < 16; ++k) { aw[k] += L[k * 256 + j] * w; aa[k] += L[k * 256 + 64 + j] * a; } }
        for (int j = 0; j < 128; ++j) { const float g = g2[j * 512 + c];
#pragma unroll
            for (int k = 0; k < 16; ++k) ag[k] += L[k * 256 + 128 + j] * g; }
        const float w0c = w0[c], a0c = a0[c];
#pragma unroll
        for (int k = 0; k < 16; ++k) { const size_t o = (size_t)(r0 + k) * 512 + c;
            const float wl = -softplusf_(-(w0c + aw[k])) - 0.5f;
            wdec[o] = expf(-expf(wl)); asig[o] = sigmoidf_(a0c + aa[k]); gg[o] = ag[k]; }
        __syncthreads();
    }
}
__device__ __forceinline__ void p2_compress_naive(Frame& F) {
    LAS float* X = (LAS float*)(F.lds + RING_OFF);
    LAS float* PE = X + 144 * 64;
    LAS float* HID = PE + 2048;
    const bf16* PB = (const bf16*)(F.ws + WS_PB); float* CMP = (float*)(F.ws + WS_CMP);
    for (int it = F.vcu; it < 2 * 2 * 2 * 64; it += F.G) {
        const int kv = it >> 8, b = (it >> 7) & 1, hk = (it >> 6) & 1, c0 = (it & 63) * 8;
        const float* pe = kv ? F.in[15] : F.in[14]; const float* W1 = kv ? F.in[18] : F.in[16]; const float* W2 = kv ? F.in[19] : F.in[17];
        const int col = (kv ? C_VC : C_KC) + hk * 64;
        for (int idx = F.tid; idx < 144 * 64; idx += NWAVES * 64) { const int tok = idx >> 6, d = idx & 63; const int t = 16 * c0 + tok;
            X[idx] = (t < T) ? bf2f(PB[(size_t)(b * T + t) * NMAIN + col + d]) : 0.f; }
        for (int idx = F.tid; idx < 2048; idx += NWAVES * 64) PE[idx] = pe[idx];
        __syncthreads();
        { const int n = F.tid & 255, half = F.tid >> 8; float acc[4] = {0.f, 0.f, 0.f, 0.f};
          for (int k = 0; k < 2048; ++k) { const float w = W1[(size_t)k * 256 + n]; const int l = k >> 6, d = k & 63; const float pev = PE[k];
#pragma unroll
              for (int jj = 0; jj < 4; ++jj) acc[jj] += (X[((4 * half + jj) * 16 + l) * 64 + d] + pev) * w; }
#pragma unroll
          for (int jj = 0; jj < 4; ++jj) HID[(4 * half + jj) * 256 + n] = gelu_tanhf_(acc[jj]); }
        __syncthreads();
        { const int blk = F.tid >> 6, j = F.tid & 63; float s = 0.f;
          for (int n = 0; n < 256; ++n) s += HID[blk * 256 + n] * W2[n * 64 + j];
          const int c = c0 + blk; if (c < NCMP) CMP[((size_t)((kv * 2 + b) * 2 + hk) * NCMPP + c) * 64 + j] = s; }
        __syncthreads();
    }
}
__device__ __forceinline__ void p3_rwkv_scan_naive(Frame& F, int b, int h) {
    const bf16* PB = (const bf16*)(F.ws + WS_PB); const float* wdec = F.out; const float* asig = F.out + (size_t)M * 512; float* yraw = (float*)(F.ws + WS_HB);
    const float* mu = F.in[3]; const float* k_k = F.in[9]; const float* k_a = F.in[10];
    const int lane = F.lane, vl = lane >> 3, kq = lane & 7, v = F.wave * 8 + vl, ch0 = h * 64 + kq * 8;
    float S[8], mur[8], muk[8], kkp[8], kap[8], pr[8], pk[8];
#pragma unroll
    for (int j = 0; j < 8; ++j) { S[j] = 0.f; mur[j] = mu[C_R + ch0 + j]; muk[j] = mu[C_K + ch0 + j]; kkp[j] = k_k[ch0 + j]; kap[j] = k_a[ch0 + j]; pr[j] = 0.f; pk[j] = 0.f; }
    const float muv = mu[C_V + h * 64 + v]; float pv = 0.f;
    const size_t row0 = (size_t)b * T;
    bf16x8 nr = *(const bf16x8*)(PB + row0 * NMAIN + C_R + ch0), nk = *(const bf16x8*)(PB + row0 * NMAIN + C_K + ch0);
    bf16 nv = PB[row0 * NMAIN + C_V + h * 64 + v];
    f32x4 nw0 = *(const f32x4*)(wdec + row0 * 512 + ch0), nw1 = *(const f32x4*)(wdec + row0 * 512 + ch0 + 4);
    f32x4 na0 = *(const f32x4*)(asig + row0 * 512 + ch0), na1 = *(const f32x4*)(asig + row0 * 512 + ch0 + 4);
    for (int t = 0; t < T; ++t) {
        const size_t row = row0 + t;
        const bf16x8 cr8 = nr, ck8 = nk; const bf16 cvb = nv; const f32x4 w0 = nw0, w1 = nw1, a0 = na0, a1 = na1;
        if (t + 1 < T) { const size_t rn = row + 1;
            nr = *(const bf16x8*)(PB + rn * NMAIN + C_R + ch0); nk = *(const bf16x8*)(PB + rn * NMAIN + C_K + ch0); nv = PB[rn * NMAIN + C_V + h * 64 + v];
            nw0 = *(const f32x4*)(wdec + rn * 512 + ch0); nw1 = *(const f32x4*)(wdec + rn * 512 + ch0 + 4);
            na0 = *(const f32x4*)(asig + rn * 512 + ch0); na1 = *(const f32x4*)(asig + rn * 512 + ch0 + 4); }
        float r[8], k[8], kk[8], wd[8], as[8];
        float ss = 0.f;
#pragma unroll
        for (int j = 0; j < 8; ++j) { const float cr = bf2f((bf16)cr8[j]), ck = bf2f((bf16)ck8[j]);
            r[j] = cr + mur[j] * (pr[j] - cr); k[j] = ck + muk[j] * (pk[j] - ck); pr[j] = cr; pk[j] = ck;
            wd[j] = j < 4 ? w0[j] : w1[j - 4]; as[j] = j < 4 ? a0[j] : a1[j - 4];
            kk[j] = k[j] * kkp[j]; ss += kk[j] * kk[j]; }
        const float cv = bf2f(cvb); const float vv = cv + muv * (pv - cv); pv = cv;
        ss += __shfl_xor(ss, 1); ss += __shfl_xor(ss, 2); ss += __shfl_xor(ss, 4);
        const float inv = 1.0f / fmaxf(sqrtf(ss), 1e-12f);
        float sa = 0.f;
#pragma unroll
        for (int j = 0; j < 8; ++j) { kk[j] *= inv; sa += S[j] * (-kk[j]); }
        sa += __shfl_xor(sa, 1); sa += __shfl_xor(sa, 2); sa += __shfl_xor(sa, 4);
        float y = 0.f;
#pragma unroll
        for (int j = 0; j < 8; ++j) { const float km = k[j] * (1.0f + (as[j] - 1.0f) * kap[j]);
            S[j] = S[j] * wd[j] + sa * (kk[j] * as[j]) + vv * km; y += S[j] * r[j]; }
        y += __shfl_xor(y, 1); y += __shfl_xor(y, 2); y += __shfl_xor(y, 4);
        if (kq == 0) yraw[row * 512 + h * 64 + v] = y;
    }
}
__device__ __forceinline__ void p3b_rwkv_out_naive(Frame& F) {
    const int gw = F.vcu * NWAVES + F.wave, NGW = F.G * NWAVES, lane = F.lane;
    const bf16* PB = (const bf16*)(F.ws + WS_PB); const float* asig = F.out + (size_t)M * 512; const float* yraw = (const float*)(F.ws + WS_HB); const float* gg = (const float*)(F.ws + WS_G);
    bf16* Y = (bf16*)(F.ws + WS_XB);
    const float* mu = F.in[3]; const float* k_a = F.in[10]; const float* r_k = F.in[11]; const float* lnw = F.in[12]; const float* lnb = F.in[13];
    for (int it = gw; it < M * 8; it += NGW) {
        const int row = it >> 3, h = it & 7, ch = h * 64 + lane;
        const float yv = yraw[(size_t)row * 512 + ch];
        const float mean = wave_sum(yv) * (1.0f / 64.0f); const float d = yv - mean; const float var = wave_sum(d * d) * (1.0f / 64.0f);
        const float yn = d * (1.0f / sqrtf(var + GN_EPS)) * lnw[ch] + lnb[ch];
        const bool first = (row % T) == 0;
        const float cr = bf2f(PB[(size_t)row * NMAIN + C_R + ch]), ck = bf2f(PB[(size_t)row * NMAIN + C_K + ch]), cv = bf2f(PB[(size_t)row * NMAIN + C_V + ch]);
        const float qr = first ? 0.f : bf2f(PB[(size_t)(row - 1) * NMAIN + C_R + ch]), qk = first ? 0.f : bf2f(PB[(size_t)(row - 1) * NMAIN + C_K + ch]), qv = first ? 0.f : bf2f(PB[(size_t)(row - 1) * NMAIN + C_V + ch]);
        const float r = cr + mu[C_R + ch] * (qr - cr), k = ck + mu[C_K + ch] * (qk - ck), vv = cv + mu[C_V + ch] * (qv - cv);
        const float as = asig[(size_t)row * 512 + ch]; const float km = k * (1.0f + (as - 1.0f) * k_a[ch]);
        const float bonus = wave_sum(r * km * r_k[ch]) * vv;
        const float o = (yn + bonus) * gg[(size_t)row * 512 + ch];
        Y[(size_t)row * D + ch] = (bf16)f2bf(o);
    }
}
__device__ __forceinline__ float dot64_lds_bf16row(const LAS float* qs, const bf16* krow) {
    float s = 0.f;
#pragma unroll
    for (int i = 0; i < 8; ++i) { const bf16x8 kv = *(const bf16x8*)(krow + 8 * i); const f32x4 q0 = *(const LAS f32x4*)(qs + 8 * i), q1 = *(const LAS f32x4*)(qs + 8 * i + 4);
        s += q0[0] * bf2f((bf16)kv[0]) + q0[1] * bf2f((bf16)kv[1]) + q0[2] * bf2f((bf16)kv[2]) + q0[3] * bf2f((bf16)kv[3]);
        s += q1[0] * bf2f((bf16)kv[4]) + q1[1] * bf2f((bf16)kv[5]) + q1[2] * bf2f((bf16)kv[6]) + q1[3] * bf2f((bf16)kv[7]); }
    return s;
}
__device__ __forceinline__ float dot64_lds_f32row(const LAS float* qs, const float* krow) {
    float s = 0.f;
#pragma unroll
    for (int i = 0; i < 16; ++i) { const f32x4 kv = *(const f32x4*)(krow + 4 * i); const f32x4 q = *(const LAS f32x4*)(qs + 4 * i); s += q[0] * kv[0] + q[1] * kv[1] + q[2] * kv[2] + q[3] * kv[3]; }
    return s;
}
#define WAVE_LDS_FENCE() asm volatile("s_waitcnt lgkmcnt(0)" ::: "memory")
__device__ __forceinline__ void nsa_token_naive(Frame& F, int b, int hk, int t, LAS float* wl) {
    LAS float* qs = wl; LAS float* pbuf = wl + 64; LAS float* ocb = wl + 64 + 1024; LAS int* seli = (LAS int*)(wl + 64 + 1024 + 256);
    const int lane = F.lane; const size_t row = (size_t)b * T + t; const int cur = t >> 6;
    const bf16* PB = (const bf16*)(F.ws + WS_PB); const float* CMPK = (const float*)(F.ws + WS_CMP) + (size_t)((0 * 2 + b) * 2 + hk) * NCMPP * 64;
    const float* CMPV = (const float*)(F.ws + WS_CMP) + (size_t)((1 * 2 + b) * 2 + hk) * NCMPP * 64;
    const float* gates = (const float*)(F.ws + WS_GATES); bf16* Y = (bf16*)(F.ws + WS_XB);
    const int nvc = t >= 31 ? ((t - 31) >> 4) + 1 : 0;
    float imp0 = 0.f, imp1 = 0.f;
    for (int g = 0; g < 4; ++g) {
        const int h = hk * 4 + g; const float slope = exp2f(-(float)(h + 1));
        WAVE_LDS_FENCE();
        qs[lane] = bf2f(PB[row * NMAIN + C_Q + h * 64 + lane]) * 0.125f;
        WAVE_LDS_FENCE();
        float o = 0.f;
        if (nvc > 0) {
            float m = -INFINITY;
            for (int c = lane; c < nvc; c += 64) { const float s = dot64_lds_f32row(qs, CMPK + (size_t)c * 64) - slope * (float)(t - (16 * c + 31)); pbuf[c] = s; m = fmaxf(m, s); }
            m = wave_max(m); float l = 0.f;
            for (int c = lane; c < nvc; c += 64) { const float e = expf(pbuf[c] - m); pbuf[c] = e; l += e; }
            l = wave_sum(l); const float inv = 1.0f / l;
            for (int c = lane; c < nvc; c += 64) pbuf[c] *= inv;
            WAVE_LDS_FENCE();
#pragma unroll
            for (int hh = 0; hh < 2; ++hh) { const int n = lane + 64 * hh; float s = 0.f;
#pragma unroll
                for (int j = -1; j < 4; ++j) { const int c = 4 * n + j; if (c >= 0 && c < nvc) s += pbuf[c] * ((j == -1 || j == 3) ? 1.f : 2.f); }
                if (hh == 0) imp0 += s; else imp1 += s; }
            for (int c = 0; c < nvc; ++c) o += pbuf[c] * CMPV[(size_t)c * 64 + lane];
        }
        ocb[g * 64 + lane] = o;
    }
    {
        float v0 = (lane > cur) ? NEGV : ((lane == 0 || lane == cur || lane == cur - 1) ? BIGV : imp0);
        const int n1 = lane + 64;
        float v1 = (n1 > cur) ? NEGV : ((n1 == cur || n1 == cur - 1) ? BIGV : imp1);
        for (int it = 0; it < 16; ++it) {
            const float m = wave_max(fmaxf(v0, v1));
            const unsigned long long b0 = __ballot(v0 == m);
            int idx;
            if (b0) { idx = __builtin_ctzll(b0); if (lane == idx) v0 = -INFINITY; }
            else { const unsigned long long b1 = __ballot(v1 == m); idx = 64 + __builtin_ctzll(b1); if (lane == idx - 64) v1 = -INFINITY; }
            if (lane == 0) seli[it] = (m > 0.5f * NEGV) ? idx : -1;
        }
        WAVE_LDS_FENCE();
    }
    for (int g = 0; g < 4; ++g) {
        const int h = hk * 4 + g; const float slope = exp2f(-(float)(h + 1));
        WAVE_LDS_FENCE();
        qs[lane] = bf2f(PB[row * NMAIN + C_Q + h * 64 + lane]) * 0.125f;
        WAVE_LDS_FENCE();
        float os = 0.f;
        {
            float m = -INFINITY;
            for (int sl = 0; sl < 16; ++sl) { const int idx = seli[sl]; float s = -INFINITY;
                if (idx >= 0) { const int pos = idx * 64 + lane; if (pos <= t) s = dot64_lds_bf16row(qs, PB + ((size_t)b * T + pos) * NMAIN + C_KS + hk * 64) - slope * (float)(t - pos); }
                pbuf[sl * 64 + lane] = s; m = fmaxf(m, s); }
            m = wave_max(m); float l = 0.f;
            for (int sl = 0; sl < 16; ++sl) { const float e = expf(pbuf[sl * 64 + lane] - m); pbuf[sl * 64 + lane] = e; l += e; }
            l = wave_sum(l); const float inv = 1.0f / l;
            WAVE_LDS_FENCE();
            for (int sl = 0; sl < 16; ++sl) { const int idx = seli[sl]; if (idx < 0) continue;
                for (int j = 0; j < 64; ++j) { const int pos = idx * 64 + j; if (pos > t) break; os += pbuf[sl * 64 + j] * bf2f(PB[((size_t)b * T + pos) * NMAIN + C_VS + hk * 64 + lane]); } }
            os *= inv;
        }
        WAVE_LDS_FENCE();
        float ow = 0.f;
        {
            float m = -INFINITY;
            for (int i = lane; i < 512; i += 64) { const int pos = t - 511 + i; float s = -INFINITY;
                if (pos >= 0) s = dot64_lds_bf16row(qs, PB + ((size_t)b * T + pos) * NMAIN + C_KW + hk * 64) - slope * (float)(t - pos);
                pbuf[i] = s; m = fmaxf(m, s); }
            m = wave_max(m); float l = 0.f;
            for (int i = lane; i < 512; i += 64) { const float e = expf(pbuf[i] - m); pbuf[i] = e; l += e; }
            l = wave_sum(l); const float inv = 1.0f / l;
            WAVE_LDS_FENCE();
            for (int i = 0; i < 512; ++i) { const int pos = t - 511 + i; if (pos < 0) continue; ow += pbuf[i] * bf2f(PB[((size_t)b * T + pos) * NMAIN + C_VW + hk * 64 + lane]); }
            ow *= inv;
        }
        const float g0 = gates[row * 24 + h * 3 + 0], g1 = gates[row * 24 + h * 3 + 1], g2 = gates[row * 24 + h * 3 + 2];
        Y[row * D + 512 + h * 64 + lane] = (bf16)f2bf(g0 * ocb[g * 64 + lane] + g1 * os + g2 * ow);
    }
}
__device__ __forceinline__ void p3_nsa_naive(Frame& F, int first_wg, int nwg) {
    LAS float* wl = (LAS float*)(F.lds + RING_OFF) + F.wave * 2048;
    const int me = (int)blockIdx.x - first_wg; if (me < 0) return;
    for (int it = me; it < 4 * (T / 8); it += nwg) {
        const int bh = it / (T / 8), tg = it % (T / 8); const int b = bh >> 1, hk = bh & 1;
        nsa_token_naive(F, b, hk, tg * 8 + F.wave, wl);
    }
}
__device__ __forceinline__ void p7_final_norm(Frame& F) {
    const int gw = F.vcu * NWAVES + F.wave, NGW = F.G * NWAVES;
    const float* ssq3 = (const float*)(F.ctl + CW_SSQ3); const float* gf = F.in[25];
    f32x4 gv[4];
#pragma unroll
    for (int j = 0; j < 4; ++j) gv[j] = *((const f32x4*)gf + F.lane + 64 * j);
    for (int m = gw; m < M; m += NGW) {
        const float rs = 1.0f / sqrtf(ssq3[m] * (1.0f / D) + NORM_EPS);
        f32x4* xr = (f32x4*)(F.out + (size_t)m * D) + F.lane;
#pragma unroll
        for (int j = 0; j < 4; ++j) { f32x4 v = xr[64 * j]; v = v * rs * gv[j]; xr[64 * j] = v; }
    }
}

struct Args { const float* in[26]; float* out; unsigned char* ws; };
__global__ void __launch_bounds__(NWAVES * 64, 2) hybrid_fwd(Args args) {
    extern __shared__ __attribute__((aligned(16))) unsigned char lds[];
    Frame F;
    F.lds = (LAS unsigned char*)lds;
    F.MISC = (volatile LAS unsigned*)(F.lds + MISC_OFF);
    F.tid = threadIdx.x; F.lane = F.tid & 63; F.wave = __builtin_amdgcn_readfirstlane(F.tid >> 6);
    F.G = gridDim.x; { const int bx = blockIdx.x; F.vcu = (F.G % 8 == 0) ? (bx % 8) * (F.G / 8) + bx / 8 : bx; }
    F.ws = args.ws; F.out = args.out; F.ctl = (gu32*)(args.ws + WS_CTL);
#pragma unroll
    for (int i = 0; i < 26; ++i) F.in[i] = args.in[i];
    for (int u = F.tid; u < (LDS_BYTES - LDSCTL_OFF) / 4; u += NWAVES * 64) ((LAS unsigned*)(F.lds + LDSCTL_OFF))[u] = 0u;
    __syncthreads();
    XcdBarrier bar = xcd_barrier_post((unsigned*)(F.ctl + CW_BAR), F.MISC + 8);
#define GRID_BAR() xcd_barrier(bar)

    bf16* Win_t = (bf16*)(F.ws + WS_WIN); bf16* Wout_t = (bf16*)(F.ws + WS_WOUT); bf16* Wgu_t = (bf16*)(F.ws + WS_WGU); bf16* Wd_t = (bf16*)(F.ws + WS_WD);
    bf16* XB = (bf16*)(F.ws + WS_XB); bf16* PB = (bf16*)(F.ws + WS_PB); bf16* HB = (bf16*)(F.ws + WS_HB); bf16* ACT = (bf16*)(F.ws + WS_PB);
    float* rstd1 = (float*)(F.ws + WS_RSTD1); float* ssq2 = (float*)(F.ctl + CW_SSQ2); float* ssq3 = (float*)(F.ctl + CW_SSQ3);

    p0_prologue(F);
    GRID_BAR();
    {
        pg8::Gemm g{XB, Win_t, M, NMAIN, D}; pg8::StaticOrder S; S.init(M, NMAIN, F.G, (int)blockIdx.x);
        pg8::EpiRowScaleBf16 E{PB, NMAIN, rstd1};
        pg8::gemm_phase<pg8::EpiRowScaleBf16, pg8::StaticOrder, true, true>(F.lds + RING_OFF, g, S, E);
    }
    GRID_BAR();
    p2_gates_naive(F);
    p2_rwkv_prep_naive(F);
    p2_compress_naive(F);
    GRID_BAR();
    if (blockIdx.x < 16) p3_rwkv_scan_naive(F, (int)blockIdx.x >> 3, (int)blockIdx.x & 7);
    else p3_nsa_naive(F, 16, (int)F.G - 16);
    GRID_BAR();
    p3b_rwkv_out_naive(F);
    GRID_BAR();
    {
        pg8::Gemm g{XB, Wout_t, M, D, D}; pg8::StaticOrder S; S.init(M, D, F.G, (int)blockIdx.x);
        pg8::EpiResid E{F.in[0], F.out, HB, ssq2, D};
        pg8::gemm_phase<pg8::EpiResid, pg8::StaticOrder, true, true>(F.lds + RING_OFF, g, S, E);
    }
    GRID_BAR();
    {
        pg8::Gemm g{HB, Wgu_t, M, NGU, D}; pg8::StaticOrder S; S.init(M, NGU, F.G, (int)blockIdx.x);
        pg8::EpiSwiGLU E{ACT, DFF, ssq2, NORM_EPS};
        pg8::gemm_phase<pg8::EpiSwiGLU, pg8::StaticOrder, true, true>(F.lds + RING_OFF, g, S, E);
    }
    GRID_BAR();
    {
        pg8::Gemm g{ACT, Wd_t, M, D, DFF}; pg8::StaticOrder S; S.init(M, D, F.G, (int)blockIdx.x);
        pg8::EpiResid E{F.out, F.out, nullptr, ssq3, D};
        pg8::gemm_phase<pg8::EpiResid, pg8::StaticOrder, true, true>(F.lds + RING_OFF, g, S, E);
    }
    GRID_BAR();
    p7_final_norm(F);
#undef GRID_BAR
}

extern "C" void kernel_launch(void* const* d_in, const int* in_sizes, int n_in, void* d_out, int out_size, void* d_ws, size_t ws_size, hipStream_t stream) {
    static int grid = 0;
    if (grid == 0) {
        if (n_in != 26 || in_sizes[0] != M * D || out_size != M * D || ws_size < WS_END) { fprintf(stderr, "kernel_launch: unexpected shapes (n_in %d, in0 %d, out %d, ws %zu); nothing launched\n", n_in, n_in > 0 ? in_sizes[0] : -1, out_size, ws_size); grid = -1; return; }
        int dev = 0, cus = 0, per_cu = 0;
        if (hipGetDevice(&dev) != hipSuccess || hipDeviceGetAttribute(&cus, hipDeviceAttributeMultiprocessorCount, dev) != hipSuccess) { fprintf(stderr, "kernel_launch: device query failed\n"); grid = -1; return; }
        if (hipFuncSetAttribute((const void*)hybrid_fwd, hipFuncAttributeMaxDynamicSharedMemorySize, LDS_BYTES) != hipSuccess) { fprintf(stderr, "kernel_launch: hipFuncSetAttribute failed\n"); grid = -1; return; }
        if (hipOccupancyMaxActiveBlocksPerMultiprocessor(&per_cu, (const void*)hybrid_fwd, NWAVES * 64, LDS_BYTES) != hipSuccess || per_cu < 1)
            fprintf(stderr, "kernel_launch: note: occupancy query reports %d workgroups per CU\n", per_cu);
        (void)hipGetLastError();
        grid = cus;
    }
    if (grid < 0) return;
    if (hipMemsetAsync((char*)d_ws + WS_CTL, 0, CTL_ZERO_BYTES, stream) != hipSuccess) { fprintf(stderr, "kernel_launch: hipMemsetAsync failed\n"); return; }
    Args a{};
    for (int i = 0; i < 26; ++i) a.in[i] = (const float*)d_in[i];
    a.out = (float*)d_out; a.ws = (unsigned char*)d_ws;
    hipLaunchKernelGGL(hybrid_fwd, dim3(grid), dim3(NWAVES * 64), LDS_BYTES, stream, a);
    const hipError_t le = hipPeekAtLastError();
    if (le != hipSuccess) fprintf(stderr, "kernel_launch: launch failed: %s\n", hipGetErrorName(le));
}
```

```cpp
#include <hip/hip_runtime.h>
#include <cstdio>
#include <cstdint>
namespace pg8 {
#define PG8_LAS __attribute__((address_space(3)))
typedef unsigned short bf16_t;
typedef short bf16x8 __attribute__((ext_vector_type(8)));
typedef float f32x4 __attribute__((ext_vector_type(4)));
typedef unsigned u32x4 __attribute__((ext_vector_type(4)));
constexpr int BM = 256, BK = 64, HALF = 128, HTB = HALF * BK * 2  , STAGE_BYTES = 8 * HTB, NXCD = 8, WGM = 8;

__host__ __device__ __forceinline__ int lds_byte(int r, int c) { const int st = (r >> 4) * 2 + (c >> 5), rr = r & 15, cc = c & 31, ob = rr * 64 + cc * 2; return st * 1024 + (ob ^ (((ob >> 9) & 1) << 5)); }
__host__ __device__ __forceinline__ void stage_rc(int b, int& R, int& C) { const int st = b / 1024, sb = b % 1024, swz = sb ^ (((sb >> 9) & 1) << 5); R = (st >> 1) * 16 + swz / 64; C = (st & 1) * 32 + (swz % 64) / 2; }
__host__ __device__ __forceinline__ int perm32(int rho) { const int n = rho >> 4, i = rho & 15; return 8 * (i >> 2) + 4 * n + (i & 3); }

struct Unit { int pm, pn; };
struct Gemm { const bf16_t* A; const bf16_t* Bt; int M, N, K; };

struct StaticOrder {
    int nM, nN, nwg, G, c;
    __host__ __device__ void init(int M, int N, int G_, int c_) { nM = M / BM; nN = N / BM; nwg = nM * nN; G = G_; c = c_; }
    __host__ __device__ bool next(int i, Unit& u) const {
        const long L = (long)i * G + c; if (L >= nwg) return false;
        int wgid = (int)L; { const int q = nwg / NXCD, r = nwg % NXCD, xcd = wgid % NXCD, off = wgid / NXCD; wgid = (xcd < r ? xcd * (q + 1) : r * (q + 1) + (xcd - r) * q) + off; }
        const int nig = WGM * nN, gid = wgid / nig, fm = gid * WGM, gsz = (nM - fm) < WGM ? (nM - fm) : WGM;
        u.pm = fm + ((wgid % nig) % gsz); u.pn = (wgid % nig) / gsz; return true;
    }
    __device__ __forceinline__ void a_ready(const Unit&) const {}
    __device__ __forceinline__ void done(const Unit&) const {}
};

__device__ __forceinline__ unsigned cvt_pk_bf16(float lo, float hi) { unsigned r; asm volatile("v_cvt_pk_bf16_f32 %0, %1, %2" : "=v"(r) : "v"(lo), "v"(hi)); return r; }
typedef float f32x2 __attribute__((ext_vector_type(2)));
__device__ __forceinline__ f32x2 gelu_pk(f32x2 v) {
    const f32x2 av = __builtin_elementwise_abs(v), d = av * 0.2316418882f + 1.0f;
    f32x2 t; t.x = __builtin_amdgcn_rcpf(d.x); t.y = __builtin_amdgcn_rcpf(d.y);
    f32x2 q = t * 0.5307027145f + (-0.7265760135f); q = q * t + 0.7107068705f; q = q * t + (-0.142248368f); q = q * t + 0.127414796f; q = q * t;
    const f32x2 s = (v * v) * (-0.72134752044f);
    f32x2 e; e.x = __builtin_amdgcn_exp2f(s.x); e.y = __builtin_amdgcn_exp2f(s.y);
    const f32x2 m = v * (q * e), r = v - m;
    f32x2 o; o.x = v.x < 0.f ? m.x : r.x; o.y = v.y < 0.f ? m.y : r.y; return o;
}

template <int ACT  > struct EpiBf16 {
    static constexpr bool PERM = true, AFTER_DRAIN = false; static_assert(ACT == 0 || ACT == 1, "EpiBf16: ACT is 0 (none) or 1 (gelu_pk)");
    bf16_t* O; int ldc; const float* bias; int split_cols; size_t split_stride; float scale0;
    __device__ __forceinline__ void operator()(const f32x4 (&acc)[2][2][4][2], const Unit& u, int wr, int wc, int fr, int fq) const {
        const int row0 = u.pm * BM + wr * 64 + fr; int colt = u.pn * BM; bf16_t* base = O;
        float sc = 1.f; if (split_cols) { const int t = colt / split_cols; base += (size_t)t * split_stride; colt -= t * split_cols; if (t == 0) sc = scale0; }
        const int col0 = colt + wc * 32 + 8 * fq, bcol0 = u.pn * BM + wc * 32 + 8 * fq;
        f32x4 bv[2][2];
#pragma unroll
        for (int bj = 0; bj < 2; ++bj)
#pragma unroll
            for (int n = 0; n < 2; ++n) bv[bj][n] = bias ? *(const f32x4*)(bias + bcol0 + bj * HALF + 4 * n) : (f32x4){0.f, 0.f, 0.f, 0.f};
#pragma unroll
        for (int ai = 0; ai < 2; ++ai)
#pragma unroll
            for (int m = 0; m < 4; ++m) { bf16_t* rowp = base + (size_t)(row0 + ai * HALF + m * 16) * ldc + col0;
#pragma unroll
                for (int bj = 0; bj < 2; ++bj) { f32x4 v0 = acc[ai][bj][m][0] + bv[bj][0], v1 = acc[ai][bj][m][1] + bv[bj][1];
                    if (ACT == 1) { f32x2 a = gelu_pk((f32x2){v0[0], v0[1]}), b = gelu_pk((f32x2){v0[2], v0[3]}), c = gelu_pk((f32x2){v1[0], v1[1]}), d = gelu_pk((f32x2){v1[2], v1[3]});
                        v0 = (f32x4){a.x, a.y, b.x, b.y}; v1 = (f32x4){c.x, c.y, d.x, d.y}; }
                    v0 = v0 * sc; v1 = v1 * sc; u32x4 w; w.x = cvt_pk_bf16(v0[0], v0[1]); w.y = cvt_pk_bf16(v0[2], v0[3]); w.z = cvt_pk_bf16(v1[0], v1[1]); w.w = cvt_pk_bf16(v1[2], v1[3]);
                    *(u32x4*)(rowp + bj * HALF) = w; } }
    }
};

struct EpiRowScaleBf16 {
    static constexpr bool PERM = true, AFTER_DRAIN = false;
    bf16_t* O; int ldc; const float* rs;
    __device__ __forceinline__ void operator()(const f32x4 (&acc)[2][2][4][2], const Unit& u, int wr, int wc, int fr, int fq) const {
        const int row0 = u.pm * BM + wr * 64 + fr; const int col0 = u.pn * BM + wc * 32 + 8 * fq;
#pragma unroll
        for (int ai = 0; ai < 2; ++ai)
#pragma unroll
            for (int m = 0; m < 4; ++m) { const int row = row0 + ai * HALF + m * 16; const float s = rs[row]; bf16_t* rowp = O + (size_t)row * ldc + col0;
#pragma unroll
                for (int bj = 0; bj < 2; ++bj) { const f32x4 v0 = acc[ai][bj][m][0] * s, v1 = acc[ai][bj][m][1] * s;
                    u32x4 w; w.x = cvt_pk_bf16(v0[0], v0[1]); w.y = cvt_pk_bf16(v0[2], v0[3]); w.z = cvt_pk_bf16(v1[0], v1[1]); w.w = cvt_pk_bf16(v1[2], v1[3]);
                    *(u32x4*)(rowp + bj * HALF) = w; } }
    }
};
struct EpiResid {
    static constexpr bool PERM = true, AFTER_DRAIN = false;
    const float* base; float* out; bf16_t* ob; float* ssq; int ldc;
    __device__ __forceinline__ void operator()(const f32x4 (&acc)[2][2][4][2], const Unit& u, int wr, int wc, int fr, int fq) const {
        const int row0 = u.pm * BM + wr * 64 + fr; const int col0 = u.pn * BM + wc * 32 + 8 * fq;
#pragma unroll
        for (int ai = 0; ai < 2; ++ai)
#pragma unroll
            for (int m = 0; m < 4; ++m) { const int row = row0 + ai * HALF + m * 16; const size_t off = (size_t)row * ldc + col0; float ss = 0.f;
#pragma unroll
                for (int bj = 0; bj < 2; ++bj) {
                    const f32x4 b0 = *(const f32x4*)(base + off + bj * HALF), b1 = *(const f32x4*)(base + off + bj * HALF + 4);
                    const f32x4 v0 = acc[ai][bj][m][0] + b0, v1 = acc[ai][bj][m][1] + b1;
                    *(f32x4*)(out + off + bj * HALF) = v0; *(f32x4*)(out + off + bj * HALF + 4) = v1;
                    ss += (v0[0] * v0[0] + v0[1] * v0[1]) + (v0[2] * v0[2] + v0[3] * v0[3]) + (v1[0] * v1[0] + v1[1] * v1[1]) + (v1[2] * v1[2] + v1[3] * v1[3]);
                    if (ob) { u32x4 w; w.x = cvt_pk_bf16(v0[0], v0[1]); w.y = cvt_pk_bf16(v0[2], v0[3]); w.z = cvt_pk_bf16(v1[0], v1[1]); w.w = cvt_pk_bf16(v1[2], v1[3]);
                        *(u32x4*)(ob + off + bj * HALF) = w; } }
                ss += __shfl_xor(ss, 16); ss += __shfl_xor(ss, 32);
                if (fq == 0) atomicAdd(ssq + row, ss); }
    }
};
struct EpiSwiGLU {
    static constexpr bool PERM = true, AFTER_DRAIN = false;
    bf16_t* O; int ldc; const float* ssq; float eps;
    __device__ __forceinline__ void operator()(const f32x4 (&acc)[2][2][4][2], const Unit& u, int wr, int wc, int fr, int fq) const {
        const int row0 = u.pm * BM + wr * 64 + fr; const int col0 = u.pn * HALF + wc * 32 + 8 * fq;
#pragma unroll
        for (int ai = 0; ai < 2; ++ai)
#pragma unroll
            for (int m = 0; m < 4; ++m) { const int row = row0 + ai * HALF + m * 16; const float s = 1.0f / sqrtf(ssq[row] * (1.0f / 1024.0f) + eps);
                float a[8];
#pragma unroll
                for (int n = 0; n < 2; ++n)
#pragma unroll
                    for (int j = 0; j < 4; ++j) { const float g = acc[ai][0][m][n][j] * s, up = acc[ai][1][m][n][j] * s; a[n * 4 + j] = g / (1.0f + __expf(-g)) * up; }
                u32x4 w; w.x = cvt_pk_bf16(a[0], a[1]); w.y = cvt_pk_bf16(a[2], a[3]); w.z = cvt_pk_bf16(a[4], a[5]); w.w = cvt_pk_bf16(a[6], a[7]);
                *(u32x4*)(O + (size_t)row * ldc + col0) = w; }
    }
};
template <class Epi, class Sched, bool ALIGN_EPI = false, bool SP2 = false>
__device__ __forceinline__ void gemm_phase(PG8_LAS unsigned char* lds, const Gemm g, const Sched& S, const Epi& E) {
    const int tid = threadIdx.x, wid = __builtin_amdgcn_readfirstlane(tid >> 6), lane = tid & 63, wr = wid >> 2, wc = wid & 3, fr = lane & 15, fq = lane >> 4;
    const int K = g.K, nt = K / BK;
    unsigned voffA[2], voffB[2];
#pragma unroll
    for (int i = 0; i < 2; ++i) { int R, C; stage_rc(tid * 16 + i * 8192, R, C); const int Rb = Epi::PERM ? ((R & ~31) + perm32(R & 31)) : R;
        voffA[i] = (unsigned)(R * K + C) * 2u; voffB[i] = (unsigned)(Rb * K + C) * 2u; }
    const size_t kstep = (size_t)(BK * 2);
    const size_t hstep = (size_t)HALF * K * 2;
    const size_t tstep = 2 * hstep;
    const unsigned ldsw = (unsigned)wid * 1024u;
    const int aoff = lds_byte(wr * 64 + fr, fq * 8), boff = lds_byte(wc * 32 + fr, fq * 8);
#define PG8_SA(b, h) (((b) * 2 + (h)) * HTB)
#define PG8_SB(b, h) ((4 + (b) * 2 + (h)) * HTB)
#define PG8_STAGE(bufoff, gbase, voff) do { _Pragma("unroll") for (int _i = 0; _i < 2; ++_i) \
        __builtin_amdgcn_global_load_lds((const unsigned*)((const char*)(gbase) + (voff)[_i]), (PG8_LAS unsigned*)(lds + (bufoff) + ldsw + _i * 8192), 16, 0, 0); } while (0)
#define PG8_LDA(dst, b, h) do { _Pragma("unroll") for (int m = 0; m < 4; ++m) _Pragma("unroll") for (int k = 0; k < 2; ++k) dst[m][k] = *(const PG8_LAS bf16x8*)(lds + PG8_SA(b, h) + aoff + m * 2048 + k * 1024); } while (0)
#define PG8_LDB(dst, b, h) do { _Pragma("unroll") for (int n = 0; n < 2; ++n) _Pragma("unroll") for (int k = 0; k < 2; ++k) dst[n][k] = *(const PG8_LAS bf16x8*)(lds + PG8_SB(b, h) + boff + n * 2048 + k * 1024); } while (0)
#define PG8_MMA(ai, bj, At, Bt) do { __builtin_amdgcn_s_setprio(1); _Pragma("unroll") for (int m = 0; m < 4; ++m) _Pragma("unroll") for (int n = 0; n < 2; ++n) _Pragma("unroll") for (int k = 0; k < 2; ++k) \
        acc[ai][bj][m][n] = __builtin_amdgcn_mfma_f32_16x16x32_bf16(Bt[n][k], At[m][k], acc[ai][bj][m][n], 0, 0, 0); __builtin_amdgcn_s_setprio(0); } while (0)
#define PG8_WAIT_V(n) asm volatile("s_waitcnt vmcnt(" #n ")" ::: "memory")
#define PG8_WAIT_L(n) asm volatile("s_waitcnt lgkmcnt(" #n ")" ::: "memory")
#define PG8_BAR __builtin_amdgcn_s_barrier()
#define PG8_SCHED __builtin_amdgcn_sched_barrier(0)
    Unit cur, nxt; int ui = 0;
    if (!S.next(0, cur)) return;
    f32x4 acc[2][2][4][2];
#pragma unroll
    for (int a = 0; a < 2; ++a)
#pragma unroll
        for (int b = 0; b < 2; ++b)
#pragma unroll
            for (int m = 0; m < 4; ++m)
#pragma unroll
                for (int n = 0; n < 2; ++n) acc[a][b][m][n] = (f32x4){0.f, 0.f, 0.f, 0.f};
    bf16x8 At[4][2], B0[2][2], B1[2][2];
    const char* cA = (const char*)g.A + (size_t)cur.pm * tstep; const char* cB = (const char*)g.Bt + (size_t)cur.pn * tstep;
    S.a_ready(cur);
    if constexpr (SP2) {
        PG8_STAGE(PG8_SB(0, 0), cB, voffB); PG8_STAGE(PG8_SB(0, 1), cB + hstep, voffB); PG8_STAGE(PG8_SA(0, 0), cA, voffA); PG8_STAGE(PG8_SA(0, 1), cA + hstep, voffA);
        if (wr == 1) PG8_BAR;
        PG8_WAIT_V(2); PG8_BAR;
        PG8_STAGE(PG8_SB(1, 0), cB + kstep, voffB); PG8_STAGE(PG8_SA(1, 0), cA + kstep, voffA); PG8_STAGE(PG8_SB(1, 1), cB + hstep + kstep, voffB);
        PG8_WAIT_V(6); PG8_BAR;
    } else {
        PG8_STAGE(PG8_SB(0, 0), cB, voffB); PG8_STAGE(PG8_SA(0, 0), cA, voffA); PG8_STAGE(PG8_SB(0, 1), cB + hstep, voffB); PG8_STAGE(PG8_SA(0, 1), cA + hstep, voffA);
        if (wr == 1) PG8_BAR;
        PG8_WAIT_V(4); PG8_BAR;
        PG8_STAGE(PG8_SB(1, 0), cB + kstep, voffB); PG8_STAGE(PG8_SA(1, 0), cA + kstep, voffA); PG8_STAGE(PG8_SB(1, 1), cB + hstep + kstep, voffB);
        PG8_WAIT_V(6); PG8_BAR;
    }
    for (;;) {
        const bool has_next = S.next(ui + 1, nxt);
        const char* nA = has_next ? (const char*)g.A + (size_t)nxt.pm * tstep : cA; const char* nB = has_next ? (const char*)g.Bt + (size_t)nxt.pn * tstep : cB;
        for (int t = 0; t < nt; t += 2) {
            const bool last = (t == nt - 2);
            const char* a1 = cA + (size_t)(t + 1) * kstep;
            const char* a2 = last ? nA : cA + (size_t)(t + 2) * kstep; const char* b2 = last ? nB : cB + (size_t)(t + 2) * kstep;
            const char* a3 = a2 + kstep; const char* b3 = b2 + kstep;
            if (last && has_next) S.a_ready(nxt);
            if constexpr (SP2) {
            PG8_LDB(B0, 0, 0); PG8_LDB(B1, 0, 1); PG8_SCHED; PG8_LDA(At, 0, 0); PG8_STAGE(PG8_SA(1, 1), a1 + hstep, voffA);
            PG8_WAIT_V(8); PG8_WAIT_L(0); PG8_BAR; PG8_MMA(0, 0, At, B0); PG8_MMA(0, 1, At, B1); PG8_BAR; PG8_SCHED;
            PG8_LDA(At, 0, 1); PG8_STAGE(PG8_SB(0, 0), b2, voffB); PG8_STAGE(PG8_SB(0, 1), b2 + hstep, voffB); PG8_STAGE(PG8_SA(0, 0), a2, voffA);
            PG8_WAIT_V(8); PG8_WAIT_L(0); PG8_BAR; PG8_MMA(1, 0, At, B0); PG8_MMA(1, 1, At, B1); PG8_BAR; PG8_SCHED;
            PG8_LDB(B0, 1, 0); PG8_LDB(B1, 1, 1); PG8_SCHED; PG8_LDA(At, 1, 0); PG8_STAGE(PG8_SA(0, 1), a2 + hstep, voffA);
            PG8_WAIT_V(8); PG8_WAIT_L(0); PG8_BAR; PG8_MMA(0, 0, At, B0); PG8_MMA(0, 1, At, B1); PG8_BAR; PG8_SCHED;
            PG8_LDA(At, 1, 1); PG8_STAGE(PG8_SB(1, 0), b3, voffB); PG8_STAGE(PG8_SB(1, 1), b3 + hstep, voffB); PG8_STAGE(PG8_SA(1, 0), a3, voffA);
            PG8_WAIT_V(8); PG8_WAIT_L(0); PG8_BAR; PG8_MMA(1, 0, At, B0); PG8_MMA(1, 1, At, B1); PG8_BAR; PG8_SCHED;
            } else {
            PG8_LDB(B0, 0, 0); PG8_SCHED; PG8_LDA(At, 0, 0); PG8_STAGE(PG8_SA(1, 1), a1 + hstep, voffA);
            PG8_WAIT_L(8); PG8_BAR; PG8_WAIT_L(0); PG8_MMA(0, 0, At, B0); PG8_BAR; PG8_SCHED;
            PG8_LDB(B1, 0, 1); PG8_STAGE(PG8_SB(0, 0), b2, voffB);
            PG8_BAR; PG8_WAIT_L(0); PG8_MMA(0, 1, At, B1); PG8_BAR;
            PG8_LDA(At, 0, 1); PG8_STAGE(PG8_SA(0, 0), a2, voffA);
            PG8_BAR; PG8_WAIT_L(0); PG8_MMA(1, 0, At, B0); PG8_BAR; PG8_SCHED;
            PG8_STAGE(PG8_SB(0, 1), b2 + hstep, voffB);
            PG8_WAIT_V(6); PG8_BAR; PG8_MMA(1, 1, At, B1); PG8_BAR;
            PG8_LDB(B0, 1, 0); PG8_SCHED; PG8_LDA(At, 1, 0); PG8_STAGE(PG8_SA(0, 1), a2 + hstep, voffA);
            PG8_WAIT_L(8); PG8_BAR; PG8_WAIT_L(0); PG8_MMA(0, 0, At, B0); PG8_BAR; PG8_SCHED;
            PG8_LDB(B1, 1, 1); PG8_STAGE(PG8_SB(1, 0), b3, voffB);
            PG8_BAR; PG8_WAIT_L(0); PG8_MMA(0, 1, At, B1); PG8_BAR;
            PG8_LDA(At, 1, 1); PG8_STAGE(PG8_SA(1, 0), a3, voffA);
            PG8_BAR; PG8_WAIT_L(0); PG8_MMA(1, 0, At, B0); PG8_BAR; PG8_SCHED;
            PG8_STAGE(PG8_SB(1, 1), b3 + hstep, voffB);
            PG8_WAIT_V(6); PG8_BAR; PG8_MMA(1, 1, At, B1); PG8_BAR;
            }
        }
        if constexpr (ALIGN_EPI) { if (wr == 0) PG8_BAR; }
        if constexpr (!Epi::AFTER_DRAIN) { E(acc, cur, wr, wc, fr, fq); S.done(cur); }
        if (!has_next) break;
#pragma unroll
        for (int a = 0; a < 2; ++a)
#pragma unroll
            for (int b = 0; b < 2; ++b)
#pragma unroll
                for (int m = 0; m < 4; ++m)
#pragma unroll
                    for (int n = 0; n < 2; ++n) acc[a][b][m][n] = (f32x4){0.f, 0.f, 0.f, 0.f};
        cur = nxt; cA = nA; cB = nB; ++ui;
        if constexpr (ALIGN_EPI) { if (wr == 1) PG8_BAR; }
    }
    PG8_WAIT_V(0);
    if constexpr (!ALIGN_EPI) { if (wr == 0) PG8_BAR; }
    PG8_BAR;
    if constexpr (Epi::AFTER_DRAIN) { E.fused(acc, cur, wr, wc, fr, fq, lds, wid, lane); S.done(cur); }
#undef PG8_SA
#undef PG8_SB
#undef PG8_STAGE
#undef PG8_LDA
#undef PG8_LDB
#undef PG8_MMA
#undef PG8_WAIT_V
#undef PG8_WAIT_L
#undef PG8_BAR
#undef PG8_SCHED
}
}

#ifndef PG8_SP2
#define PG8_SP2 true
#endif
#ifndef PG8_ALIGN
#define PG8_ALIGN true
#endif

constexpr int NWAVES = 8;
constexpr int BATCH = 2, T = 8192, D = 1024, M = BATCH * T;
constexpr int NIN = 3096, NMAIN = 3072, DFF = 2816, NGU = 2 * DFF;
constexpr int C_R = 0, C_K = 512, C_V = 1024, C_DW = 1536, C_DA = 1600, C_DG = 1664, C_Q = 1792, C_KC = 2304, C_VC = 2432, C_KS = 2560, C_VS = 2688, C_KW = 2816, C_VW = 2944, C_GL = 3072;
constexpr int NCMP = 511, NCMPP = 512;
constexpr float NORM_EPS = 1e-6f, GN_EPS = 64e-5f, NEGV = -1e30f, BIGV = 1e30f;

constexpr size_t MiB = 1u << 20;
constexpr size_t WS_CTL = 0, CTL_ZERO_BYTES = 1 * MiB;
constexpr size_t WS_WIN = 2 * MiB;
constexpr size_t WS_WOUT = 9 * MiB;
constexpr size_t WS_WGU = 11 * MiB;
constexpr size_t WS_WD = 22 * MiB;
constexpr size_t WS_RSTD1 = 28 * MiB;
constexpr size_t WS_GATES = 28 * MiB + 256 * 1024;
constexpr size_t WS_CMP = 30 * MiB;
constexpr size_t WS_LORA = 31 * MiB;
constexpr size_t WS_XB = 32 * MiB;
constexpr size_t WS_PB = 64 * MiB;
constexpr size_t WS_HB = 160 * MiB;
constexpr size_t WS_G = 192 * MiB;
constexpr size_t WS_VS = 224 * MiB;
constexpr size_t WS_BONUS = 240 * MiB;
constexpr size_t WS_END = 256 * MiB;
constexpr int CW_BAR = 4096;
constexpr int CW_SSQ2 = 65536;
constexpr int CW_SSQ3 = 65536 + 16384;
constexpr int CW_QUEUE = 2048;
static_assert((CW_SSQ3 + 16384) * 4 <= (int)CTL_ZERO_BYTES, "ctl");

constexpr int RING_OFF = 0, RING_BYTES = 131072;
constexpr int LDSCTL_OFF = RING_BYTES, MISC_OFF = LDSCTL_OFF + 320;
constexpr int LDS_BYTES = 147456;
#define GAS __attribute__((address_space(1)))
#define LAS __attribute__((address_space(3)))
typedef unsigned short bf16;
typedef unsigned v4u __attribute__((ext_vector_type(4)));
typedef float f32x4 __attribute__((ext_vector_type(4)));
typedef short bf16x8 __attribute__((ext_vector_type(8)));
typedef GAS unsigned gu32;
typedef GAS unsigned long long gu64;
#define RLX_AGENT __ATOMIC_RELAXED, __HIP_MEMORY_SCOPE_AGENT
#define LDS_WAIT() asm volatile("s_waitcnt lgkmcnt(0)" ::: "memory")
#define VM_WAIT() asm volatile("s_waitcnt vmcnt(0)" ::: "memory")
__device__ __forceinline__ unsigned long long rt() { return __builtin_amdgcn_s_memrealtime(); }
__device__ __forceinline__ unsigned f2bf(float f) { unsigned u = __builtin_bit_cast(unsigned, f); return (u + 0x7fffu + ((u >> 16) & 1u)) >> 16; }
__device__ __forceinline__ unsigned pk2(float lo, float hi) { return f2bf(lo) | (f2bf(hi) << 16); }

#define XB_TMO      128
#define XB_XCNT(j)  (256  + 64 * (j))
#define XB_XSUB(j)  (1280 + 64 * (j))
#define XB_XGEN(j)  (2304 + 64 * (j))
#define XB_TOP      3328
#define XB_TOPGEN   3392
#define XCD_BAR_WORDS 3456
#define XB_SPIN_CAP (1u << 18)

__device__ __forceinline__ unsigned xb_ld(unsigned* p)              { return __hip_atomic_load(p, __ATOMIC_RELAXED, __HIP_MEMORY_SCOPE_AGENT); }
__device__ __forceinline__ unsigned xb_add(unsigned* p, unsigned v) { return __hip_atomic_fetch_add(p, v, __ATOMIC_RELAXED, __HIP_MEMORY_SCOPE_AGENT); }
__device__ __forceinline__ unsigned xb_xcc_id() { return (unsigned)__builtin_amdgcn_s_getreg((3 << 11) | 20) & 0xFu; }
#define XB_SPIN(cond, bar) do { unsigned _sp = 0; while (cond) { __builtin_amdgcn_s_sleep(1); \
    if ((++_sp & 255u) == 0u) { if (xb_ld(&(bar)[XB_TMO])) break; if (_sp > XB_SPIN_CAP) { atomicAdd(&(bar)[XB_TMO], 1u); break; } } } } while (0)

struct XcdBarrier {
    unsigned* bar; unsigned x;
    volatile LAS unsigned* st;
};

__device__ __forceinline__ XcdBarrier xcd_barrier_post(unsigned* bar, volatile LAS unsigned* st) {
    XcdBarrier b; b.bar = bar; b.x = xb_xcc_id(); b.st = st;
    if (threadIdx.x == 0) (void)xb_add(&bar[XB_XCNT(b.x)], 1u);
    return b;
}
__device__ __forceinline__ void xcd_barrier_complete(unsigned* bar, unsigned x, unsigned& nloc, unsigned& nx) {
    const unsigned G = gridDim.x * gridDim.y * gridDim.z;
    unsigned sum, cnt, mine, sp = 0u;
    for (;;) {
        sum = 0u; cnt = 0u; mine = 0u;
#pragma unroll
        for (unsigned j = 0; j < 16; ++j) { const unsigned c = xb_ld(&bar[XB_XCNT(j)]); sum += c; cnt += (c > 0u) ? 1u : 0u; mine = (j == x) ? c : mine; }
        if (sum == G) break;
        __builtin_amdgcn_s_sleep(1);
        if ((++sp & 255u) == 0u) { if (xb_ld(&bar[XB_TMO])) break; if (sp > XB_SPIN_CAP) { atomicAdd(&bar[XB_TMO], 1u); break; } }
    }
    nloc = mine > 0u ? mine : 1u; nx = cnt > 0u ? cnt : 1u;
}

__device__ __forceinline__ void xcd_barrier(const XcdBarrier& b) {
    asm volatile("s_waitcnt vmcnt(0)" ::: "memory");
    __syncthreads();
    if (threadIdx.x == 0) {
        unsigned* bar = b.bar;
        __builtin_amdgcn_s_waitcnt(0);
        unsigned nloc = b.st[0], nx = b.st[1];
        if (nloc == 0u) { xcd_barrier_complete(bar, b.x, nloc, nx); b.st[0] = nloc; b.st[1] = nx; }
        const unsigned old = xb_add(&bar[XB_XSUB(b.x)], 1u);
        const unsigned gen = old / nloc;
        if (old + 1u == (gen + 1u) * nloc) {
            __builtin_amdgcn_fence(__ATOMIC_RELEASE, "agent");
            asm volatile("s_waitcnt vmcnt(0)" ::: "memory");
            const unsigned og = xb_add(&bar[XB_TOP], 1u);
            const unsigned tg = og / nx;
            if (og + 1u == (tg + 1u) * nx) xb_add(&bar[XB_TOPGEN], 1u);
            else XB_SPIN(xb_ld(&bar[XB_TOPGEN]) == tg, bar);
            __builtin_amdgcn_fence(__ATOMIC_ACQUIRE, "agent");
            xb_add(&bar[XB_XGEN(b.x)], 1u);
            asm volatile("s_waitcnt vmcnt(0)" ::: "memory");
        } else {
            XB_SPIN(xb_ld(&bar[XB_XGEN(b.x)]) == gen, bar);
            __builtin_amdgcn_fence(__ATOMIC_ACQUIRE, "agent");
            asm volatile("s_waitcnt vmcnt(0)" ::: "memory");
        }
    }
    __syncthreads();
}


struct Frame {
    LAS unsigned char* lds;
    volatile LAS unsigned* MISC;
    gu32* ctl;
    int tid, lane, wave;
    int vcu, G;
    const float* in[26];
    float* out; unsigned char* ws;
};
__device__ __forceinline__ float wave_sum(float v) {
#pragma unroll
    for (int o = 1; o < 64; o <<= 1) v += __shfl_xor(v, o);
    return v;
}
__device__ __forceinline__ float wave_max(float v) {
#pragma unroll
    for (int o = 1; o < 64; o <<= 1) v = fmaxf(v, __shfl_xor(v, o));
    return v;
}
__device__ __forceinline__ float bf2f(bf16 b) { return __builtin_bit_cast(float, (unsigned)b << 16); }
__device__ __forceinline__ float sigmoidf_(float x) { return 1.0f / (1.0f + expf(-x)); }
__device__ __forceinline__ float softplusf_(float z) { return z > 20.f ? z : log1pf(expf(z)); }
__device__ __forceinline__ float gelu_tanhf_(float x) { const float u = 0.7978845608028654f * (x + 0.044715f * x * x * x); return 0.5f * x * (1.0f + tanhf(u)); }

template <int MODE  >
__device__ __forceinline__ void p0_transpose_item(const float* W, int K, int N, const float* gain, bf16* WT, LAS float* scr, int item, int lane) {
    const int nblk = (N + 31) / 32, kb = item / nblk, nb = item % nblk, k0 = 64 * kb, n0 = 32 * nb;
#pragma unroll 8
    for (int i = 0; i < 32; ++i) { const int kk = 2 * i + (lane >> 5); const int n = n0 + (lane & 31);
        float v = 0.f; if (n < N) { v = W[(size_t)(k0 + kk) * N + n]; if (gain) v *= gain[k0 + kk]; }
        scr[kk * 33 + (lane & 31)] = v; }
    LDS_WAIT(); asm volatile("" ::: "memory");
    const int c = lane & 7;
    int rb = n0; if (MODE == 1) rb = 256 * (n0 / 128) + (n0 % 128); if (MODE == 2) rb = 256 * (n0 / 128) + 128 + (n0 % 128);
#pragma unroll
    for (int j = 0; j < 4; ++j) { const int n = (lane >> 3) + 8 * j; const LAS float* s = scr + (8 * c) * 33 + n;
        v4u o; o.x = pk2(s[0 * 33], s[1 * 33]); o.y = pk2(s[2 * 33], s[3 * 33]); o.z = pk2(s[4 * 33], s[5 * 33]); o.w = pk2(s[6 * 33], s[7 * 33]);
        *(GAS v4u*)(WT + (size_t)(rb + n) * K + k0 + 8 * c) = o; }
    LDS_WAIT(); asm volatile("" ::: "memory");
}
__device__ __forceinline__ void p0_prologue(Frame& F) {
    LAS float* scr = (LAS float*)(F.lds + RING_OFF + F.wave * 16384);
    const int gw = F.vcu * NWAVES + F.wave, NGW = F.G * NWAVES;
    constexpr int I_IN = (D / 64) * ((NIN + 31) / 32), I_OUT = (D / 64) * (D / 32), I_G = (D / 64) * (DFF / 32), I_D = (DFF / 64) * (D / 32);
    constexpr int I_L = 16, I_LG = 32;
    constexpr int NITEMS = I_IN + I_OUT + 2 * I_G + I_D + 2 * I_L + I_LG;
    bf16* W2T = (bf16*)(F.ws + WS_LORA); bf16* A2T = W2T + 512 * 64; bf16* G2T = A2T + 512 * 64;
    bf16* Win_t = (bf16*)(F.ws + WS_WIN); bf16* Wout_t = (bf16*)(F.ws + WS_WOUT); bf16* Wgu_t = (bf16*)(F.ws + WS_WGU); bf16* Wd_t = (bf16*)(F.ws + WS_WD);
    for (int it = gw; it < NITEMS; it += NGW) {
        int r = it;
        if (r < I_IN) { p0_transpose_item<0>(F.in[2], D, NIN, F.in[1], Win_t, scr, r, F.lane); continue; } r -= I_IN;
        if (r < I_OUT) { p0_transpose_item<0>(F.in[20], D, D, nullptr, Wout_t, scr, r, F.lane); continue; } r -= I_OUT;
        if (r < I_G) { p0_transpose_item<1>(F.in[22], D, DFF, F.in[21], Wgu_t, scr, r, F.lane); continue; } r -= I_G;
        if (r < I_G) { p0_transpose_item<2>(F.in[23], D, DFF, F.in[21], Wgu_t, scr, r, F.lane); continue; } r -= I_G;
        if (r < I_D) { p0_transpose_item<0>(F.in[24], DFF, D, nullptr, Wd_t, scr, r, F.lane); continue; } r -= I_D;
        if (r < I_L) { p0_transpose_item<0>(F.in[5], 64, 512, nullptr, W2T, scr, r, F.lane); continue; } r -= I_L;
        if (r < I_L) { p0_transpose_item<0>(F.in[7], 64, 512, nullptr, A2T, scr, r, F.lane); continue; } r -= I_L;
        p0_transpose_item<0>(F.in[8], 128, 512, nullptr, G2T, scr, r, F.lane);
    }
    bf16* XB = (bf16*)(F.ws + WS_XB); float* rstd1 = (float*)(F.ws + WS_RSTD1);
    for (int m = gw; m < M; m += NGW) {
        const GAS f32x4* xr = (const GAS f32x4*)(F.in[0] + (size_t)m * D) + F.lane;
        f32x4 v[4]; float s = 0.f;
#pragma unroll
        for (int j = 0; j < 4; ++j) { v[j] = xr[64 * j]; s += (v[j].x * v[j].x + v[j].y * v[j].y) + (v[j].z * v[j].z + v[j].w * v[j].w); }
        const float tot = wave_sum(s);
        GAS unsigned long long* o8 = (GAS unsigned long long*)(XB + (size_t)m * D) + F.lane;
#pragma unroll
        for (int j = 0; j < 4; ++j) o8[64 * j] = (unsigned long long)pk2(v[j].x, v[j].y) | ((unsigned long long)pk2(v[j].z, v[j].w) << 32);
        if (F.lane == 0) rstd1[m] = 1.0f / sqrtf(tot * (1.0f / D) + NORM_EPS);
    }
}

__device__ __forceinline__ void p2_gates_naive(Frame& F) {
    const int gw = F.vcu * NWAVES + F.wave, NGW = F.G * NWAVES, lane = F.lane;
    const bf16* XB = (const bf16*)(F.ws + WS_XB); const bf16* Wg = (const bf16*)(F.ws + WS_WIN) + (size_t)C_GL * D; const float* rstd1 = (const float*)(F.ws + WS_RSTD1);
    float* gates = (float*)(F.ws + WS_GATES);
    for (int m = gw; m < M; m += NGW) {
        float xv[16];
        { const bf16x8 a = *(const bf16x8*)(XB + (size_t)m * D + lane * 16), b = *(const bf16x8*)(XB + (size_t)m * D + lane * 16 + 8);
#pragma unroll
          for (int j = 0; j < 8; ++j) { xv[j] = bf2f((bf16)a[j]); xv[8 + j] = bf2f((bf16)b[j]); } }
        const float rs = rstd1[m];
        float mine = 0.f;
        for (int j = 0; j < 24; ++j) {
            const bf16x8 a = *(const bf16x8*)(Wg + (size_t)j * D + lane * 16), b = *(const bf16x8*)(Wg + (size_t)j * D + lane * 16 + 8);
            float s = 0.f;
#pragma unroll
            for (int q = 0; q < 8; ++q) { s += xv[q] * bf2f((bf16)a[q]); s += xv[8 + q] * bf2f((bf16)b[q]); }
            s = wave_sum(s);
            if (lane == j) mine = s;
        }
        if (lane < 24) gates[(size_t)m * 24 + lane] = sigmoidf_(mine * rs);
    }
}
__device__ __forceinline__ void p2_rwkv_prep_naive(Frame& F) {
    LAS float* L = (LAS float*)(F.lds + RING_OFF);
    const bf16* PB = (const bf16*)(F.ws + WS_PB);
    const float* mu = F.in[3]; const float* w0 = F.in[4]; const float* w2 = F.in[5]; const float* a0 = F.in[6]; const float* a2 = F.in[7]; const float* g2 = F.in[8];
    float* wdec = F.out; float* asig = F.out + (size_t)M * 512; float* gg = (float*)(F.ws + WS_G);
    const int c = F.tid;
    for (int it = F.vcu; it < M / 16; it += F.G) {
        const int r0 = it * 16;
        for (int idx = F.tid; idx < 16 * 256; idx += NWAVES * 64) {
            const int tok = idx >> 8, j = idx & 255; const int row = r0 + tok; const int col = C_DW + j;
            const float p = bf2f(PB[(size_t)row * NMAIN + col]);
            const float pp = ((row % T) == 0) ? 0.f : bf2f(PB[(size_t)(row - 1) * NMAIN + col]);
            const float ps = p + mu[col] * (pp - p);
            L[tok * 256 + j] = (j < 64) ? tanhf(ps) : (j < 128 ? ps : sigmoidf_(ps));
        }
        __syncthreads();
        float aw[16], aa[16], ag[16];
#pragma unroll
        for (int k = 0; k < 16; ++k) { aw[k] = 0.f; aa[k] = 0.f; ag[k] = 0.f; }
        for (int j = 0; j < 64; ++j) { const float w = w2[j * 512 + c], a = a2[j * 512 + c];
#pragma unroll
            for (int k = 0; k < 16; ++k) { aw[k] += L[k * 256 + j] * w; aa[k] += L[k * 256 + 64 + j] * a; } }
        for (int j = 0; j < 128; ++j) { const float g = g2[j * 512 + c];
#pragma unroll
            for (int k = 0; k < 16; ++k) ag[k] += L[k * 256 + 128 + j] * g; }
        const float w0c = w0[c], a0c = a0[c];
#pragma unroll
        for (int k = 0; k < 16; ++k) { const size_t o = (size_t)(r0 + k) * 512 + c;
            const float wl = -softplusf_(-(w0c + aw[k])) - 0.5f;
            wdec[o] = expf(-expf(wl)); asig[o] = sigmoidf_(a0c + aa[k]); gg[o] = ag[k]; }
        __syncthreads();
    }
}
__device__ __forceinline__ void p2_compress_naive(Frame& F) {
    LAS float* X = (LAS float*)(F.lds + RING_OFF);
    LAS float* PE = X + 144 * 64;
    LAS float* HID = PE + 2048;
    const bf16* PB = (const bf16*)(F.ws + WS_PB); float* CMP = (float*)(F.ws + WS_CMP);
    for (int it = F.vcu; it < 2 * 2 * 2 * 64; it += F.G) {
        const int kv = it >> 8, b = (it >> 7) & 1, hk = (it >> 6) & 1, c0 = (it & 63) * 8;
        const float* pe = kv ? F.in[15] : F.in[14]; const float* W1 = kv ? F.in[18] : F.in[16]; const float* W2 = kv ? F.in[19] : F.in[17];
        const int col = (kv ? C_VC : C_KC) + hk * 64;
        for (int idx = F.tid; idx < 144 * 64; idx += NWAVES * 64) { const int tok = idx >> 6, d = idx & 63; const int t = 16 * c0 + tok;
            X[idx] = (t < T) ? bf2f(PB[(size_t)(b * T + t) * NMAIN + col + d]) : 0.f; }
        for (int idx = F.tid; idx < 2048; idx += NWAVES * 64) PE[idx] = pe[idx];
        __syncthreads();
        { const int n = F.tid & 255, half = F.tid >> 8; float acc[4] = {0.f, 0.f, 0.f, 0.f};
          for (int k = 0; k < 2048; ++k) { const float w = W1[(size_t)k * 256 + n]; const int l = k >> 6, d = k & 63; const float pev = PE[k];
#pragma unroll
              for (int jj = 0; jj < 4; ++jj) acc[jj] += (X[((4 * half + jj) * 16 + l) * 64 + d] + pev) * w; }
#pragma unroll
          for (int jj = 0; jj < 4; ++jj) HID[(4 * half + jj) * 256 + n] = gelu_tanhf_(acc[jj]); }
        __syncthreads();
        { const int blk = F.tid >> 6, j = F.tid & 63; float s = 0.f;
          for (int n = 0; n < 256; ++n) s += HID[blk * 256 + n] * W2[n * 64 + j];
          const int c = c0 + blk; if (c < NCMP) CMP[((size_t)((kv * 2 + b) * 2 + hk) * NCMPP + c) * 64 + j] = s; }
        __syncthreads();
    }
}
__device__ __forceinline__ void p3_rwkv_scan_naive(Frame& F, int b, int h) {
    const bf16* PB = (const bf16*)(F.ws + WS_PB); const float* wdec = F.out; const float* asig = F.out + (size_t)M * 512; float* yraw = (float*)(F.ws + WS_HB);
    const float* mu = F.in[3]; const float* k_k = F.in[9]; const float* k_a = F.in[10];
    const int lane = F.lane, vl = lane >> 3, kq = lane & 7, v = F.wave * 8 + vl, ch0 = h * 64 + kq * 8;
    float S[8], mur[8], muk[8], kkp[8], kap[8], pr[8], pk[8];
#pragma unroll
    for (int j = 0; j < 8; ++j) { S[j] = 0.f; mur[j] = mu[C_R + ch0 + j]; muk[j] = mu[C_K + ch0 + j]; kkp[j] = k_k[ch0 + j]; kap[j] = k_a[ch0 + j]; pr[j] = 0.f; pk[j] = 0.f; }
    const float muv = mu[C_V + h * 64 + v]; float pv = 0.f;
    const size_t row0 = (size_t)b * T;
    bf16x8 nr = *(const bf16x8*)(PB + row0 * NMAIN + C_R + ch0), nk = *(const bf16x8*)(PB + row0 * NMAIN + C_K + ch0);
    bf16 nv = PB[row0 * NMAIN + C_V + h * 64 + v];
    f32x4 nw0 = *(const f32x4*)(wdec + row0 * 512 + ch0), nw1 = *(const f32x4*)(wdec + row0 * 512 + ch0 + 4);
    f32x4 na0 = *(const f32x4*)(asig + row0 * 512 + ch0), na1 = *(const f32x4*)(asig + row0 * 512 + ch0 + 4);
    for (int t = 0; t < T; ++t) {
        const size_t row = row0 + t;
        const bf16x8 cr8 = nr, ck8 = nk; const bf16 cvb = nv; const f32x4 w0 = nw0, w1 = nw1, a0 = na0, a1 = na1;
        if (t + 1 < T) { const size_t rn = row + 1;
            nr = *(const bf16x8*)(PB + rn * NMAIN + C_R + ch0); nk = *(const bf16x8*)(PB + rn * NMAIN + C_K + ch0); nv = PB[rn * NMAIN + C_V + h * 64 + v];
            nw0 = *(const f32x4*)(wdec + rn * 512 + ch0); nw1 = *(const f32x4*)(wdec + rn * 512 + ch0 + 4);
            na0 = *(const f32x4*)(asig + rn * 512 + ch0); na1 = *(const f32x4*)(asig + rn * 512 + ch0 + 4); }
        float r[8], k[8], kk[8], wd[8], as[8];
        float ss = 0.f;
#pragma unroll
        for (int j = 0; j < 8; ++j) { const float cr = bf2f((bf16)cr8[j]), ck = bf2f((bf16)ck8[j]);
            r[j] = cr + mur[j] * (pr[j] - cr); k[j] = ck + muk[j] * (pk[j] - ck); pr[j] = cr; pk[j] = ck;
            wd[j] = j < 4 ? w0[j] : w1[j - 4]; as[j] = j < 4 ? a0[j] : a1[j - 4];
            kk[j] = k[j] * kkp[j]; ss += kk[j] * kk[j]; }
        const float cv = bf2f(cvb); const float vv = cv + muv * (pv - cv); pv = cv;
        ss += __shfl_xor(ss, 1); ss += __shfl_xor(ss, 2); ss += __shfl_xor(ss, 4);
        const float inv = 1.0f / fmaxf(sqrtf(ss), 1e-12f);
        float sa = 0.f;
#pragma unroll
        for (int j = 0; j < 8; ++j) { kk[j] *= inv; sa += S[j] * (-kk[j]); }
        sa += __shfl_xor(sa, 1); sa += __shfl_xor(sa, 2); sa += __shfl_xor(sa, 4);
        float y = 0.f;
#pragma unroll
        for (int j = 0; j < 8; ++j) { const float km = k[j] * (1.0f + (as[j] - 1.0f) * kap[j]);
            S[j] = S[j] * wd[j] + sa * (kk[j] * as[j]) + vv * km; y += S[j] * r[j]; }
        y += __shfl_xor(y, 1); y += __shfl_xor(y, 2); y += __shfl_xor(y, 4);
        if (kq == 0) yraw[row * 512 + h * 64 + v] = y;
    }
}
__device__ __forceinline__ void p3b_rwkv_out_naive(Frame& F) {
    const int gw = F.vcu * NWAVES + F.wave, NGW = F.G * NWAVES, lane = F.lane;
    const bf16* PB = (const bf16*)(F.ws + WS_PB); const float* asig = F.out + (size_t)M * 512; const float* yraw = (const float*)(F.ws + WS_HB); const float* gg = (const float*)(F.ws + WS_G);
    bf16* Y = (bf16*)(F.ws + WS_XB);
    const float* mu = F.in[3]; const float* k_a = F.in[10]; const float* r_k = F.in[11]; const float* lnw = F.in[12]; const float* lnb = F.in[13];
    for (int it = gw; it < M * 8; it += NGW) {
        const int row = it >> 3, h = it & 7, ch = h * 64 + lane;
        const float yv = yraw[(size_t)row * 512 + ch];
        const float mean = wave_sum(yv) * (1.0f / 64.0f); const float d = yv - mean; const float var = wave_sum(d * d) * (1.0f / 64.0f);
        const float yn = d * (1.0f / sqrtf(var + GN_EPS)) * lnw[ch] + lnb[ch];
        const bool first = (row % T) == 0;
        const float cr = bf2f(PB[(size_t)row * NMAIN + C_R + ch]), ck = bf2f(PB[(size_t)row * NMAIN + C_K + ch]), cv = bf2f(PB[(size_t)row * NMAIN + C_V + ch]);
        const float qr = first ? 0.f : bf2f(PB[(size_t)(row - 1) * NMAIN + C_R + ch]), qk = first ? 0.f : bf2f(PB[(size_t)(row - 1) * NMAIN + C_K + ch]), qv = first ? 0.f : bf2f(PB[(size_t)(row - 1) * NMAIN + C_V + ch]);
        const float r = cr + mu[C_R + ch] * (qr - cr), k = ck + mu[C_K + ch] * (qk - ck), vv = cv + mu[C_V + ch] * (qv - cv);
        const float as = asig[(size_t)row * 512 + ch]; const float km = k * (1.0f + (as - 1.0f) * k_a[ch]);
        const float bonus = wave_sum(r * km * r_k[ch]) * vv;
        const float o = (yn + bonus) * gg[(size_t)row * 512 + ch];
        Y[(size_t)row * D + ch] = (bf16)f2bf(o);
    }
}
__device__ __forceinline__ float dot64_lds_bf16row(const LAS float* qs, const bf16* krow) {
    float s = 0.f;
#pragma unroll
    for (int i = 0; i < 8; ++i) { const bf16x8 kv = *(const bf16x8*)(krow + 8 * i); const f32x4 q0 = *(const LAS f32x4*)(qs + 8 * i), q1 = *(const LAS f32x4*)(qs + 8 * i + 4);
        s += q0[0] * bf2f((bf16)kv[0]) + q0[1] * bf2f((bf16)kv[1]) + q0[2] * bf2f((bf16)kv[2]) + q0[3] * bf2f((bf16)kv[3]);
        s += q1[0] * bf2f((bf16)kv[4]) + q1[1] * bf2f((bf16)kv[5]) + q1[2] * bf2f((bf16)kv[6]) + q1[3] * bf2f((bf16)kv[7]); }
    return s;
}
__device__ __forceinline__ float dot64_lds_f32row(const LAS float* qs, const float* krow) {
    float s = 0.f;
#pragma unroll
    for (int i = 0; i < 16; ++i) { const f32x4 kv = *(const f32x4*)(krow + 4 * i); const f32x4 q = *(const LAS f32x4*)(qs + 4 * i); s += q[0] * kv[0] + q[1] * kv[1] + q[2] * kv[2] + q[3] * kv[3]; }
    return s;
}
#define WAVE_LDS_FENCE() asm volatile("s_waitcnt lgkmcnt(0)" ::: "memory")
__device__ __forceinline__ void nsa_token_naive(Frame& F, int b, int hk, int t, LAS float* wl) {
    LAS float* qs = wl; LAS float* pbuf = wl + 64; LAS float* ocb = wl + 64 + 1024; LAS int* seli = (LAS int*)(wl + 64 + 1024 + 256);
    const int lane = F.lane; const size_t row = (size_t)b * T + t; const int cur = t >> 6;
    const bf16* PB = (const bf16*)(F.ws + WS_PB); const float* CMPK = (const float*)(F.ws + WS_CMP) + (size_t)((0 * 2 + b) * 2 + hk) * NCMPP * 64;
    const float* CMPV = (const float*)(F.ws + WS_CMP) + (size_t)((1 * 2 + b) * 2 + hk) * NCMPP * 64;
    const float* gates = (const float*)(F.ws + WS_GATES); bf16* Y = (bf16*)(F.ws + WS_XB);
    const int nvc = t >= 31 ? ((t - 31) >> 4) + 1 : 0;
    float imp0 = 0.f, imp1 = 0.f;
    for (int g = 0; g < 4; ++g) {
        const int h = hk * 4 + g; const float slope = exp2f(-(float)(h + 1));
        WAVE_LDS_FENCE();
        qs[lane] = bf2f(PB[row * NMAIN + C_Q + h * 64 + lane]) * 0.125f;
        WAVE_LDS_FENCE();
        float o = 0.f;
        if (nvc > 0) {
            float m = -INFINITY;
            for (int c = lane; c < nvc; c += 64) { const float s = dot64_lds_f32row(qs, CMPK + (size_t)c * 64) - slope * (float)(t - (16 * c + 31)); pbuf[c] = s; m = fmaxf(m, s); }
            m = wave_max(m); float l = 0.f;
            for (int c = lane; c < nvc; c += 64) { const float e = expf(pbuf[c] - m); pbuf[c] = e; l += e; }
            l = wave_sum(l); const float inv = 1.0f / l;
            for (int c = lane; c < nvc; c += 64) pbuf[c] *= inv;
            WAVE_LDS_FENCE();
#pragma unroll
            for (int hh = 0; hh < 2; ++hh) { const int n = lane + 64 * hh; float s = 0.f;
#pragma unroll
                for (int j = -1; j < 4; ++j) { const int c = 4 * n + j; if (c >= 0 && c < nvc) s += pbuf[c] * ((j == -1 || j == 3) ? 1.f : 2.f); }
                if (hh == 0) imp0 += s; else imp1 += s; }
            for (int c = 0; c < nvc; ++c) o += pbuf[c] * CMPV[(size_t)c * 64 + lane];
        }
        ocb[g * 64 + lane] = o;
    }
    {
        float v0 = (lane > cur) ? NEGV : ((lane == 0 || lane == cur || lane == cur - 1) ? BIGV : imp0);
        const int n1 = lane + 64;
        float v1 = (n1 > cur) ? NEGV : ((n1 == cur || n1 == cur - 1) ? BIGV : imp1);
        for (int it = 0; it < 16; ++it) {
            const float m = wave_max(fmaxf(v0, v1));
            const unsigned long long b0 = __ballot(v0 == m);
            int idx;
            if (b0) { idx = __builtin_ctzll(b0); if (lane == idx) v0 = -INFINITY; }
            else { const unsigned long long b1 = __ballot(v1 == m); idx = 64 + __builtin_ctzll(b1); if (lane == idx - 64) v1 = -INFINITY; }
            if (lane == 0) seli[it] = (m > 0.5f * NEGV) ? idx : -1;
        }
        WAVE_LDS_FENCE();
    }
    for (int g = 0; g < 4; ++g) {
        const int h = hk * 4 + g; const float slope = exp2f(-(float)(h + 1));
        WAVE_LDS_FENCE();
        qs[lane] = bf2f(PB[row * NMAIN + C_Q + h * 64 + lane]) * 0.125f;
        WAVE_LDS_FENCE();
        float os = 0.f;
        {
            float m = -INFINITY;
            for (int sl = 0; sl < 16; ++sl) { const int idx = seli[sl]; float s = -INFINITY;
                if (idx >= 0) { const int pos = idx * 64 + lane; if (pos <= t) s = dot64_lds_bf16row(qs, PB + ((size_t)b * T + pos) * NMAIN + C_KS + hk * 64) - slope * (float)(t - pos); }
                pbuf[sl * 64 + lane] = s; m = fmaxf(m, s); }
            m = wave_max(m); float l = 0.f;
            for (int sl = 0; sl < 16; ++sl) { const float e = expf(pbuf[sl * 64 + lane] - m); pbuf[sl * 64 + lane] = e; l += e; }
            l = wave_sum(l); const float inv = 1.0f / l;
            WAVE_LDS_FENCE();
            for (int sl = 0; sl < 16; ++sl) { const int idx = seli[sl]; if (idx < 0) continue;
                for (int j = 0; j < 64; ++j) { const int pos = idx * 64 + j; if (pos > t) break; os += pbuf[sl * 64 + j] * bf2f(PB[((size_t)b * T + pos) * NMAIN + C_VS + hk * 64 + lane]); } }
            os *= inv;
        }
        WAVE_LDS_FENCE();
        float ow = 0.f;
        {
            float m = -INFINITY;
            for (int i = lane; i < 512; i += 64) { const int pos = t - 511 + i; float s = -INFINITY;
                if (pos >= 0) s = dot64_lds_bf16row(qs, PB + ((size_t)b * T + pos) * NMAIN + C_KW + hk * 64) - slope * (float)(t - pos);
                pbuf[i] = s; m = fmaxf(m, s); }
            m = wave_max(m); float l = 0.f;
            for (int i = lane; i < 512; i += 64) { const float e = expf(pbuf[i] - m); pbuf[i] = e; l += e; }
            l = wave_sum(l); const float inv = 1.0f / l;
            WAVE_LDS_FENCE();
            for (int i = 0; i < 512; ++i) { const int pos = t - 511 + i; if (pos < 0) continue; ow += pbuf[i] * bf2f(PB[((size_t)b * T + pos) * NMAIN + C_VW + hk * 64 + lane]); }
            ow *= inv;
        }
        const float g0 = gates[row * 24 + h * 3 + 0], g1 = gates[row * 24 + h * 3 + 1], g2 = gates[row * 24 + h * 3 + 2];
        Y[row * D + 512 + h * 64 + lane] = (bf16)f2bf(g0 * ocb[g * 64 + lane] + g1 * os + g2 * ow);
    }
}
__device__ __forceinline__ void p3_nsa_naive(Frame& F, int first_wg, int nwg) {
    LAS float* wl = (LAS float*)(F.lds + RING_OFF) + F.wave * 2048;
    const int me = (int)blockIdx.x - first_wg; if (me < 0) return;
    for (int it = me; it < 4 * (T / 8); it += nwg) {
        const int bh = it / (T / 8), tg = it % (T / 8); const int b = bh >> 1, hk = bh & 1;
        nsa_token_naive(F, b, hk, tg * 8 + F.wave, wl);
    }
}
__device__ __forceinline__ void p7_final_norm(Frame& F) {
    const int gw = F.vcu * NWAVES + F.wave, NGW = F.G * NWAVES;
    const float* ssq3 = (const float*)(F.ctl + CW_SSQ3); const float* gf = F.in[25];
    f32x4 gv[4];
#pragma unroll
    for (int j = 0; j < 4; ++j) gv[j] = *((const f32x4*)gf + F.lane + 64 * j);
    for (int m = gw; m < M; m += NGW) {
        const float rs = 1.0f / sqrtf(ssq3[m] * (1.0f / D) + NORM_EPS);
        f32x4* xr = (f32x4*)(F.out + (size_t)m * D) + F.lane;
#pragma unroll
        for (int j = 0; j < 4; ++j) { f32x4 v = xr[64 * j]; v = v * rs * gv[j]; xr[64 * j] = v; }
    }
}

typedef float f32x16 __attribute__((ext_vector_type(16)));
typedef float f32x2_t __attribute__((ext_vector_type(2))); typedef __bf16 bf16x2_t __attribute__((ext_vector_type(2)));
__device__ __forceinline__ unsigned cvtpk(float lo, float hi) { f32x2_t v = {lo, hi}; bf16x2_t b = __builtin_convertvector(v, bf16x2_t); return __builtin_bit_cast(unsigned, b); }
typedef unsigned u32x2 __attribute__((ext_vector_type(2)));
constexpr int XTRA_OFF = RING_BYTES + 1024;
#define RSLOT(i) (L + (i) * 8192)
__device__ __forceinline__ bf16x8 rfrag(const LAS unsigned char* S, int R0, int ks, int lane) {
    const int row = R0 + (lane & 15), ch = 4 * ks + (lane >> 4);
    return *(const LAS bf16x8*)(S + row * 128 + ((ch ^ (row & 7)) << 4));
}
__device__ __forceinline__ void mm64(f32x4 (&acc)[2], const LAS unsigned char* X, const LAS unsigned char* Y, int wave, int lane) {
#pragma unroll
    for (int ks = 0; ks < 2; ++ks) { const bf16x8 a = rfrag(X, 16 * (wave >> 1), ks, lane);
#pragma unroll
        for (int j = 0; j < 2; ++j) { const bf16x8 b = rfrag(Y, 16 * (2 * (wave & 1) + j), ks, lane); acc[j] = __builtin_amdgcn_mfma_f32_16x16x32_bf16(a, b, acc[j], 0, 0, 0); } }
}
__device__ __forceinline__ void st_row(LAS unsigned char* O, const f32x4 v, int m0, int n) {
    u32x2 w; w.x = cvtpk(v[0], v[1]); w.y = cvtpk(v[2], v[3]);
    *(LAS u32x2*)(O + n * 128 + ((((m0 >> 3) ^ (n & 7)) << 4) | ((m0 & 7) << 1))) = w;
}
__device__ __forceinline__ void st_tr(LAS unsigned char* O, const f32x4 v, int m0, int n) {
#pragma unroll
    for (int r = 0; r < 4; ++r) { const int m = m0 + r; *(LAS unsigned short*)(O + m * 128 + ((((n >> 3) ^ (m & 7)) << 4) | ((n & 7) << 1))) = (unsigned short)f2bf(v[r]); }
}
__device__ __forceinline__ f32x4 ld_row(const LAS unsigned char* O, int m0, int n) {
    const u32x2 w = *(const LAS u32x2*)(O + n * 128 + ((((m0 >> 3) ^ (n & 7)) << 4) | ((m0 & 7) << 1)));
    f32x4 v; v[0] = __builtin_bit_cast(float, w.x << 16); v[1] = __builtin_bit_cast(float, w.x & 0xffff0000u); v[2] = __builtin_bit_cast(float, w.y << 16); v[3] = __builtin_bit_cast(float, w.y & 0xffff0000u); return v;
}
__device__ __forceinline__ void st_fragmajor(unsigned char* G, const f32x4 v, int m0, int R) {
    const int kk = m0 & 31, s = kk >> 4, jj = (kk >> 3) & 1, hh = (kk >> 2) & 1, lanep = (R & 31) + 32 * hh;
    u32x2 w; w.x = cvtpk(v[0], v[1]); w.y = cvtpk(v[2], v[3]);
    *(u32x2*)(G + ((((R >> 5) * 2 + (m0 >> 5)) * 2 + s) * 64 + lanep) * 16 + jj * 8) = w;
}
__device__ __forceinline__ void st_clayout(unsigned char* G, const f32x4 v, int m0, int n) {
    const int mm = m0 & 31, g = mm >> 3, hh = (mm >> 2) & 1, lanep = (n & 31) + 32 * hh;
    u32x2 w; w.x = cvtpk(v[0], v[1]); w.y = cvtpk(v[2], v[3]);
    *(u32x2*)(G + (((m0 >> 5) * 2 + (n >> 5)) * 64 + lanep) * 32 + g * 8) = w;
}
__device__ __forceinline__ void ld8f(float (&o)[8], const float* p) { const f32x4 a = *(const f32x4*)p, b = *(const f32x4*)(p + 4); o[0] = a[0]; o[1] = a[1]; o[2] = a[2]; o[3] = a[3]; o[4] = b[0]; o[5] = b[1]; o[6] = b[2]; o[7] = b[3]; }
__device__ __forceinline__ void ld8bf(float (&o)[8], const bf16* p) { const bf16x8 a = *(const bf16x8*)p;
#pragma unroll
    for (int j = 0; j < 8; ++j) o[j] = bf2f((bf16)a[j]); }
__device__ __forceinline__ v4u pack8(const float (&x)[8]) { v4u o; o.x = cvtpk(x[0], x[1]); o.y = cvtpk(x[2], x[3]); o.z = cvtpk(x[4], x[5]); o.w = cvtpk(x[6], x[7]); return o; }

__device__ __forceinline__ void p2_rwkv_chunk(Frame& F) {
    LAS unsigned char* L = F.lds + RING_OFF;
    LAS float* WPRE = (LAS float*)RSLOT(12); LAS float* APRE = (LAS float*)RSLOT(14);
    LAS float* SEG = (LAS float*)(F.lds + XTRA_OFF); LAS float* LWC = SEG + 512;
    const int tid = F.tid, lane = F.lane, wave = F.wave;
    const int t = tid >> 3, kq = tid & 7;
    const int mt = wave >> 1, ntb = 2 * (wave & 1), q = lane >> 4, l15 = lane & 15;
    const bf16* PB = (const bf16*)(F.ws + WS_PB);
    const bf16* W2T = (const bf16*)(F.ws + WS_LORA); const bf16* A2T = W2T + 512 * 64; const bf16* G2T = A2T + 512 * 64;
    const float* mu = F.in[3];
    float* GG = (float*)(F.ws + WS_G); bf16* VS = (bf16*)(F.ws + WS_VS); float* BON = (float*)(F.ws + WS_BONUS);
    for (int it = F.vcu; it < BATCH * 8 * (T / 64); it += F.G) {
        const int chunk = it & 127, h = (it >> 7) & 7, b = it >> 10;
        const int row0 = b * T + chunk * 64;
        for (int idx = tid; idx < 64 * 32; idx += NWAVES * 64) {
            const int tok = idx >> 5, c8 = idx & 31; const int row = row0 + tok; const int col = C_DW + 8 * c8;
            float p[8], pp[8], m8[8], o[8]; ld8bf(p, PB + (size_t)row * NMAIN + col); ld8f(m8, mu + col);
            if ((row % T) != 0) ld8bf(pp, PB + (size_t)(row - 1) * NMAIN + col); else {
#pragma unroll
                for (int j = 0; j < 8; ++j) pp[j] = 0.f; }
#pragma unroll
            for (int j = 0; j < 8; ++j) { const float ps = p[j] + m8[j] * (pp[j] - p[j]); o[j] = (c8 < 8) ? tanhf(ps) : (c8 < 16 ? ps : sigmoidf_(ps)); }
            *(LAS v4u*)(RSLOT(8 + (c8 >> 3)) + tok * 128 + (((c8 & 7) ^ (tok & 7)) << 4)) = pack8(o);
        }
        __syncthreads();
        {
            f32x4 accw[2], acca[2], accg[2];
#pragma unroll
            for (int j = 0; j < 2; ++j) { accw[j] = (f32x4){0.f, 0.f, 0.f, 0.f}; acca[j] = accw[j]; accg[j] = accw[j]; }
            const int mr = h * 64 + 16 * mt + l15;
#pragma unroll
            for (int ks = 0; ks < 2; ++ks) { const bf16x8 aw = *(const bf16x8*)(W2T + (size_t)mr * 64 + 32 * ks + 8 * q), aa = *(const bf16x8*)(A2T + (size_t)mr * 64 + 32 * ks + 8 * q);
#pragma unroll
                for (int j = 0; j < 2; ++j) { const bf16x8 b1 = rfrag(RSLOT(8), 16 * (ntb + j), ks, lane), b2 = rfrag(RSLOT(9), 16 * (ntb + j), ks, lane);
                    accw[j] = __builtin_amdgcn_mfma_f32_16x16x32_bf16(aw, b1, accw[j], 0, 0, 0); acca[j] = __builtin_amdgcn_mfma_f32_16x16x32_bf16(aa, b2, acca[j], 0, 0, 0); } }
#pragma unroll
            for (int ks = 0; ks < 4; ++ks) { const bf16x8 ag = *(const bf16x8*)(G2T + (size_t)mr * 128 + 32 * ks + 8 * q);
#pragma unroll
                for (int j = 0; j < 2; ++j) { const bf16x8 b3 = rfrag(RSLOT(10 + (ks >> 1)), 16 * (ntb + j), ks & 1, lane); accg[j] = __builtin_amdgcn_mfma_f32_16x16x32_bf16(ag, b3, accg[j], 0, 0, 0); } }
            const int m0 = 16 * mt + 4 * q;
#pragma unroll
            for (int j = 0; j < 2; ++j) { const int n = 16 * (ntb + j) + l15;
                *(LAS f32x4*)(WPRE + n * 64 + m0) = accw[j]; *(LAS f32x4*)(APRE + n * 64 + m0) = acca[j];
                *(f32x4*)(GG + (size_t)(row0 + n) * 512 + h * 64 + m0) = accg[j]; }
        }
        __syncthreads();
        float r8[8], km8[8], v8[8], a8[8], b8[8], lg8[8];
        {
            const int row = row0 + t, ch = h * 64 + 8 * kq; const bool first = (row % T) == 0;
            const bf16* prow = PB + (size_t)row * NMAIN; const bf16* qrow = PB + (size_t)(first ? row : row - 1) * NMAIN;
            { float c[8], p[8], m[8]; ld8bf(c, prow + C_R + ch); ld8bf(p, qrow + C_R + ch); ld8f(m, mu + C_R + ch);
#pragma unroll
              for (int j = 0; j < 8; ++j) { const float pj = first ? 0.f : p[j]; r8[j] = c[j] + m[j] * (pj - c[j]); } }
            asm volatile("" ::: "memory");
            { float c[8], p[8], m[8]; ld8bf(c, prow + C_V + ch); ld8bf(p, qrow + C_V + ch); ld8f(m, mu + C_V + ch);
#pragma unroll
              for (int j = 0; j < 8; ++j) { const float pj = first ? 0.f : p[j]; v8[j] = c[j] + m[j] * (pj - c[j]); }
              *(v4u*)(VS + (size_t)row * 512 + ch) = pack8(v8); }
            asm volatile("" ::: "memory");
            float kr[8];
            { float c[8], p[8], m[8]; ld8bf(c, prow + C_K + ch); ld8bf(p, qrow + C_K + ch); ld8f(m, mu + C_K + ch);
#pragma unroll
              for (int j = 0; j < 8; ++j) { const float pj = first ? 0.f : p[j]; kr[j] = c[j] + m[j] * (pj - c[j]); } }
            asm volatile("" ::: "memory");
            { float w0v[8]; ld8f(w0v, F.in[4] + ch); const f32x4 x0 = *(const LAS f32x4*)(WPRE + t * 64 + 8 * kq), x1 = *(const LAS f32x4*)(WPRE + t * 64 + 8 * kq + 4);
#pragma unroll
              for (int j = 0; j < 8; ++j) { const float wp = j < 4 ? x0[j & 3] : x1[j & 3]; const float wl = -softplusf_(-(w0v[j] + wp)) - 0.5f; lg8[j] = -expf(wl); }
              *(LAS f32x4*)(WPRE + t * 64 + 8 * kq) = (f32x4){lg8[0], lg8[1], lg8[2], lg8[3]}; *(LAS f32x4*)(WPRE + t * 64 + 8 * kq + 4) = (f32x4){lg8[4], lg8[5], lg8[6], lg8[7]}; }
            asm volatile("" ::: "memory");
            float as8[8];
            { float a0v[8]; ld8f(a0v, F.in[6] + ch); const f32x4 y0 = *(const LAS f32x4*)(APRE + t * 64 + 8 * kq), y1 = *(const LAS f32x4*)(APRE + t * 64 + 8 * kq + 4);
#pragma unroll
              for (int j = 0; j < 8; ++j) { const float ap = j < 4 ? y0[j & 3] : y1[j & 3]; as8[j] = sigmoidf_(a0v[j] + ap); } }
            asm volatile("" ::: "memory");
            float kk[8], ss = 0.f;
            { float kkp[8]; ld8f(kkp, F.in[9] + ch);
#pragma unroll
              for (int j = 0; j < 8; ++j) { kk[j] = kr[j] * kkp[j]; ss += kk[j] * kk[j]; } }
            ss += __shfl_xor(ss, 1); ss += __shfl_xor(ss, 2); ss += __shfl_xor(ss, 4);
            const float inv = 1.0f / fmaxf(sqrtf(ss), 1e-12f); float bon = 0.f;
            { float kap[8], rkp[8]; ld8f(kap, F.in[10] + ch); ld8f(rkp, F.in[11] + ch);
#pragma unroll
              for (int j = 0; j < 8; ++j) { kk[j] *= inv; km8[j] = kr[j] * (1.0f + (as8[j] - 1.0f) * kap[j]); a8[j] = -kk[j]; b8[j] = kk[j] * as8[j]; bon += r8[j] * km8[j] * rkp[j]; } }
            bon += __shfl_xor(bon, 1); bon += __shfl_xor(bon, 2); bon += __shfl_xor(bon, 4);
            if (kq == 0) BON[(size_t)row * 8 + h] = bon;
        }
        __syncthreads();
        {
            const int k = tid & 63, seg = tid >> 6; float c[8], run = 0.f;
#pragma unroll
            for (int i = 0; i < 8; ++i) { run += WPRE[(8 * seg + i) * 64 + k]; c[i] = run; }
            SEG[seg * 64 + k] = run;
            __syncthreads();
            float pre = 0.f;
            for (int s2 = 0; s2 < seg; ++s2) pre += SEG[s2 * 64 + k];
#pragma unroll
            for (int i = 0; i < 8; ++i) WPRE[(8 * seg + i) * 64 + k] = pre + c[i];
            if (seg == 7) LWC[k] = pre + c[7];
        }
        __syncthreads();
        {
            float lw[8], At[8], Bt[8], Kt[8], Rt[8], Bh[8], Kh[8];
            { const f32x4 x0 = *(const LAS f32x4*)(WPRE + t * 64 + 8 * kq), x1 = *(const LAS f32x4*)(WPRE + t * 64 + 8 * kq + 4);
#pragma unroll
              for (int j = 0; j < 4; ++j) { lw[j] = x0[j]; lw[4 + j] = x1[j]; } }
#pragma unroll
            for (int j = 0; j < 8; ++j) { const float lc = LWC[8 * kq + j]; const float eA = expf(lw[j] - lg8[j]), eN = expf(-lw[j]), eP = expf(lw[j]), eC = expf(lc - lw[j]);
                At[j] = a8[j] * eA; Bt[j] = b8[j] * eN; Kt[j] = km8[j] * eN; Rt[j] = r8[j] * eP; Bh[j] = b8[j] * eC; Kh[j] = km8[j] * eC; }
            const int o16 = t * 128 + ((kq ^ (t & 7)) << 4);
            *(LAS v4u*)(RSLOT(0) + o16) = pack8(At); *(LAS v4u*)(RSLOT(1) + o16) = pack8(Bt); *(LAS v4u*)(RSLOT(2) + o16) = pack8(Kt); *(LAS v4u*)(RSLOT(3) + o16) = pack8(Rt);
#pragma unroll
            for (int j = 0; j < 8; ++j) { const int kch = 8 * kq + j; const int o2 = kch * 128 + ((((t >> 3) ^ j) << 4) | ((t & 7) << 1));
                *(LAS unsigned short*)(RSLOT(4) + o2) = (unsigned short)f2bf(At[j]); *(LAS unsigned short*)(RSLOT(5) + o2) = (unsigned short)f2bf(v8[j]);
                *(LAS unsigned short*)(RSLOT(6) + o2) = (unsigned short)f2bf(Bh[j]); *(LAS unsigned short*)(RSLOT(7) + o2) = (unsigned short)f2bf(Kh[j]); }
        }
        __syncthreads();
        const int m0 = 16 * mt + 4 * q;
        {
            f32x4 aN[2], aKa[2], aBr[2], aKr[2];
#pragma unroll
            for (int j = 0; j < 2; ++j) { aN[j] = (f32x4){0.f, 0.f, 0.f, 0.f}; aKa[j] = aN[j]; aBr[j] = aN[j]; aKr[j] = aN[j]; }
#pragma unroll
            for (int ks = 0; ks < 2; ++ks) { const bf16x8 xa = rfrag(RSLOT(0), 16 * mt, ks, lane), xb = rfrag(RSLOT(1), 16 * mt, ks, lane), xk = rfrag(RSLOT(2), 16 * mt, ks, lane);
#pragma unroll
                for (int j = 0; j < 2; ++j) { const bf16x8 yb = rfrag(RSLOT(1), 16 * (ntb + j), ks, lane), yk = rfrag(RSLOT(2), 16 * (ntb + j), ks, lane), yr = rfrag(RSLOT(3), 16 * (ntb + j), ks, lane);
                    aN[j] = __builtin_amdgcn_mfma_f32_16x16x32_bf16(xa, yb, aN[j], 0, 0, 0); aKa[j] = __builtin_amdgcn_mfma_f32_16x16x32_bf16(xa, yk, aKa[j], 0, 0, 0);
                    aBr[j] = __builtin_amdgcn_mfma_f32_16x16x32_bf16(xb, yr, aBr[j], 0, 0, 0); aKr[j] = __builtin_amdgcn_mfma_f32_16x16x32_bf16(xk, yr, aKr[j], 0, 0, 0); } }
#pragma unroll
            for (int j = 0; j < 2; ++j) { const int n = 16 * (ntb + j) + l15; f32x4 vN, vT, vKa, vBr, vKr;
#pragma unroll
                for (int r = 0; r < 4; ++r) { const int m = m0 + r; vN[r] = (n < m) ? aN[j][r] : 0.f; vT[r] = vN[r] + ((n == m) ? 1.f : 0.f); vKa[r] = (n < m) ? aKa[j][r] : 0.f;
                    vBr[r] = (m <= n) ? aBr[j][r] : 0.f; vKr[r] = (m <= n) ? aKr[j][r] : 0.f; }
                st_row(RSLOT(8), vN, m0, n); st_tr(RSLOT(9), vN, m0, n); st_row(RSLOT(10), vT, m0, n); st_row(RSLOT(11), vKa, m0, n); st_row(RSLOT(12), vBr, m0, n); st_row(RSLOT(13), vKr, m0, n); }
        }
        __syncthreads();
#define SQUARE(XS, YS, OROW, OTR) { f32x4 ac[2] = {(f32x4){0.f, 0.f, 0.f, 0.f}, (f32x4){0.f, 0.f, 0.f, 0.f}}; mm64(ac, RSLOT(XS), RSLOT(YS), wave, lane); \
            _Pragma("unroll") for (int j = 0; j < 2; ++j) { const int n = 16 * (ntb + j) + l15; if (OROW >= 0) st_row(RSLOT(OROW < 0 ? 0 : OROW), ac[j], m0, n); st_tr(RSLOT(OTR), ac[j], m0, n); } }
#define TUPD(XS, YS, OUT, TRANSP) { f32x4 ac[2]; _Pragma("unroll") for (int j = 0; j < 2; ++j) ac[j] = ld_row(RSLOT(YS), m0, 16 * (ntb + j) + l15); mm64(ac, RSLOT(XS), RSLOT(YS), wave, lane); \
            _Pragma("unroll") for (int j = 0; j < 2; ++j) { const int n = 16 * (ntb + j) + l15; if (TRANSP) st_tr(RSLOT(OUT), ac[j], m0, n); else st_row(RSLOT(OUT), ac[j], m0, n); } }
        SQUARE(9, 8, 0, 1);
        __syncthreads();
        TUPD(1, 10, 14, false); SQUARE(1, 0, 8, 9);
        __syncthreads();
        TUPD(9, 14, 10, false); SQUARE(9, 8, 0, 1);
        __syncthreads();
        TUPD(1, 10, 14, false); SQUARE(1, 0, 8, 9);
        __syncthreads();
        TUPD(9, 14, 10, false); SQUARE(9, 8, -1, 1);
        __syncthreads();
        TUPD(1, 10, 14, true);
        __syncthreads();
        { f32x4 ac[2] = {(f32x4){0.f, 0.f, 0.f, 0.f}, (f32x4){0.f, 0.f, 0.f, 0.f}}, ad[2] = {(f32x4){0.f, 0.f, 0.f, 0.f}, (f32x4){0.f, 0.f, 0.f, 0.f}};
          mm64(ac, RSLOT(14), RSLOT(4), wave, lane); mm64(ad, RSLOT(11), RSLOT(14), wave, lane);
#pragma unroll
          for (int j = 0; j < 2; ++j) { const int n = 16 * (ntb + j) + l15; st_row(RSLOT(0), ac[j], m0, n); st_row(RSLOT(2), ad[j], m0, n); } }
        __syncthreads();
        { f32x4 ac[2] = {(f32x4){0.f, 0.f, 0.f, 0.f}, (f32x4){0.f, 0.f, 0.f, 0.f}};
          mm64(ac, RSLOT(2), RSLOT(5), wave, lane);
#pragma unroll
          for (int j = 0; j < 2; ++j) st_row(RSLOT(8), ac[j], m0, 16 * (ntb + j) + l15); }
        __syncthreads();
        {
            unsigned char* rec = (unsigned char*)F.out + (size_t)it * 32768;
            f32x4 aP[2], aQ[2], aG[2], aH[2];
#pragma unroll
            for (int j = 0; j < 2; ++j) { aP[j] = (f32x4){0.f, 0.f, 0.f, 0.f}; aQ[j] = aP[j]; aH[j] = aP[j]; aG[j] = ld_row(RSLOT(3), m0, 16 * (ntb + j) + l15); }
            mm64(aP, RSLOT(0), RSLOT(6), wave, lane);
            mm64(aQ, RSLOT(6), RSLOT(8), wave, lane); mm64(aQ, RSLOT(7), RSLOT(5), wave, lane);
            mm64(aG, RSLOT(0), RSLOT(12), wave, lane);
            mm64(aH, RSLOT(8), RSLOT(12), wave, lane); mm64(aH, RSLOT(5), RSLOT(13), wave, lane);
#pragma unroll
            for (int j = 0; j < 2; ++j) { const int n = 16 * (ntb + j) + l15;
#pragma unroll
                for (int r = 0; r < 4; ++r) if (m0 + r == n) aP[j][r] += expf(LWC[n]);
                st_fragmajor(rec, aP[j], m0, n); st_clayout(rec + 8192, aQ[j], m0, n); st_fragmajor(rec + 16384, aG[j], m0, n); st_clayout(rec + 24576, aH[j], m0, n); }
        }
        __syncthreads();
    }
}
__device__ __forceinline__ void p3_rwkv_scan_mfma(Frame& F, int bh, int ntile) {
    const int lane = F.lane;
    const unsigned char* recs = (const unsigned char*)F.out + (size_t)bh * 128 * 32768;
    unsigned char* stash = F.ws + WS_HB + (size_t)bh * 128 * 8192 + ntile * 4096;
    f32x16 z[2];
#pragma unroll
    for (int i = 0; i < 16; ++i) { z[0][i] = 0.f; z[1][i] = 0.f; }
    bf16x8 pa[2][4]; v4u qc[2][2];
    { const unsigned char* rec = recs;
#pragma unroll
      for (int mtile = 0; mtile < 2; ++mtile) {
#pragma unroll
          for (int ks = 0; ks < 4; ++ks) pa[mtile][ks] = *(const bf16x8*)(rec + ((mtile * 4 + ks) * 64 + lane) * 16);
          qc[mtile][0] = *(const v4u*)(rec + 8192 + ((mtile * 2 + ntile) * 64 + lane) * 32); qc[mtile][1] = *(const v4u*)(rec + 8192 + ((mtile * 2 + ntile) * 64 + lane) * 32 + 16); } }
    for (int c = 0; c < T / 64; ++c) {
        bf16x8 zf[4];
#pragma unroll
        for (int kt = 0; kt < 2; ++kt)
#pragma unroll
            for (int s = 0; s < 2; ++s) { v4u w; w.x = cvtpk(z[kt][8 * s + 0], z[kt][8 * s + 1]); w.y = cvtpk(z[kt][8 * s + 2], z[kt][8 * s + 3]); w.z = cvtpk(z[kt][8 * s + 4], z[kt][8 * s + 5]); w.w = cvtpk(z[kt][8 * s + 6], z[kt][8 * s + 7]);
                zf[kt * 2 + s] = __builtin_bit_cast(bf16x8, w); *(v4u*)(stash + (size_t)c * 8192 + ((kt * 2 + s) * 64 + lane) * 16) = w; }
        if (c == T / 64 - 1) break;
        bf16x8 ca[2][4]; v4u cq[2][2];
#pragma unroll
        for (int mtile = 0; mtile < 2; ++mtile) {
#pragma unroll
            for (int ks = 0; ks < 4; ++ks) ca[mtile][ks] = pa[mtile][ks];
            cq[mtile][0] = qc[mtile][0]; cq[mtile][1] = qc[mtile][1]; }
        if (c + 2 < T / 64) { const unsigned char* rec = recs + (size_t)(c + 1) * 32768;
#pragma unroll
            for (int mtile = 0; mtile < 2; ++mtile) {
#pragma unroll
                for (int ks = 0; ks < 4; ++ks) pa[mtile][ks] = *(const bf16x8*)(rec + ((mtile * 4 + ks) * 64 + lane) * 16);
                qc[mtile][0] = *(const v4u*)(rec + 8192 + ((mtile * 2 + ntile) * 64 + lane) * 32); qc[mtile][1] = *(const v4u*)(rec + 8192 + ((mtile * 2 + ntile) * 64 + lane) * 32 + 16); } }
#pragma unroll
        for (int mtile = 0; mtile < 2; ++mtile) {
            f32x16 acc;
#pragma unroll
            for (int i = 0; i < 4; ++i) { const unsigned w0 = cq[mtile][0][i], w1 = cq[mtile][1][i];
                acc[2 * i] = __builtin_bit_cast(float, w0 << 16); acc[2 * i + 1] = __builtin_bit_cast(float, w0 & 0xffff0000u);
                acc[8 + 2 * i] = __builtin_bit_cast(float, w1 << 16); acc[8 + 2 * i + 1] = __builtin_bit_cast(float, w1 & 0xffff0000u); }
#pragma unroll
            for (int ks = 0; ks < 4; ++ks) acc = __builtin_amdgcn_mfma_f32_32x32x16_bf16(ca[mtile][ks], zf[ks], acc, 0, 0, 0);
            z[mtile] = acc;
        }
    }
}
__device__ __forceinline__ void p3b_rwkv_out_mfma(Frame& F) {
    const int gw = F.vcu * NWAVES + F.wave, NGW = F.G * NWAVES, lane = F.lane, hh = lane >> 5, tl = lane & 31;
    bf16* Y = (bf16*)(F.ws + WS_XB); const float* GG = (const float*)(F.ws + WS_G); const bf16* VS = (const bf16*)(F.ws + WS_VS); const float* BON = (const float*)(F.ws + WS_BONUS);
    const float* lnw = F.in[12]; const float* lnb = F.in[13];
    for (int it = gw; it < BATCH * 8 * (T / 64); it += NGW) {
        const int chunk = it & 127, h = (it >> 7) & 7, b = it >> 10; const int row0 = b * T + chunk * 64;
        const unsigned char* rec = (const unsigned char*)F.out + (size_t)it * 32768;
        const unsigned char* stash = F.ws + WS_HB + (size_t)it * 8192;
        bf16x8 zf[2][4], gf[2][4];
#pragma unroll
        for (int a = 0; a < 2; ++a)
#pragma unroll
            for (int ks = 0; ks < 4; ++ks) { zf[a][ks] = *(const bf16x8*)(stash + a * 4096 + (ks * 64 + lane) * 16); gf[a][ks] = *(const bf16x8*)(rec + 16384 + ((a * 4 + ks) * 64 + lane) * 16); }
        f32x16 y[2][2];
#pragma unroll
        for (int vt = 0; vt < 2; ++vt)
#pragma unroll
            for (int tt = 0; tt < 2; ++tt) { const v4u c0 = *(const v4u*)(rec + 24576 + ((vt * 2 + tt) * 64 + lane) * 32), c1 = *(const v4u*)(rec + 24576 + ((vt * 2 + tt) * 64 + lane) * 32 + 16);
                f32x16 acc;
#pragma unroll
                for (int i = 0; i < 4; ++i) { acc[2 * i] = __builtin_bit_cast(float, c0[i] << 16); acc[2 * i + 1] = __builtin_bit_cast(float, c0[i] & 0xffff0000u);
                    acc[8 + 2 * i] = __builtin_bit_cast(float, c1[i] << 16); acc[8 + 2 * i + 1] = __builtin_bit_cast(float, c1[i] & 0xffff0000u); }
#pragma unroll
                for (int ks = 0; ks < 4; ++ks) acc = __builtin_amdgcn_mfma_f32_32x32x16_bf16(zf[vt][ks], gf[tt][ks], acc, 0, 0, 0);
                y[vt][tt] = acc; }
#pragma unroll
        for (int tt = 0; tt < 2; ++tt) {
            float s = 0.f;
#pragma unroll
            for (int vt = 0; vt < 2; ++vt)
#pragma unroll
                for (int i = 0; i < 16; ++i) s += y[vt][tt][i];
            s += __shfl_xor(s, 32); const float mean = s * (1.0f / 64.0f); float qv = 0.f;
#pragma unroll
            for (int vt = 0; vt < 2; ++vt)
#pragma unroll
                for (int i = 0; i < 16; ++i) { const float d = y[vt][tt][i] - mean; qv += d * d; }
            qv += __shfl_xor(qv, 32); const float rstd = 1.0f / sqrtf(qv * (1.0f / 64.0f) + GN_EPS);
            const int row = row0 + 32 * tt + tl; const float bon = BON[(size_t)row * 8 + h];
#pragma unroll
            for (int vt = 0; vt < 2; ++vt)
#pragma unroll
                for (int g = 0; g < 4; ++g) { const int v0 = 32 * vt + 8 * g + 4 * hh, ch = h * 64 + v0;
                    const f32x4 gw4 = *(const f32x4*)(GG + (size_t)row * 512 + ch), lw4 = *(const f32x4*)(lnw + ch), lb4 = *(const f32x4*)(lnb + ch);
                    const u32x2 vsw = *(const u32x2*)(VS + (size_t)row * 512 + ch);
                    float vs4[4] = {__builtin_bit_cast(float, vsw.x << 16), __builtin_bit_cast(float, vsw.x & 0xffff0000u), __builtin_bit_cast(float, vsw.y << 16), __builtin_bit_cast(float, vsw.y & 0xffff0000u)};
                    float o[4];
#pragma unroll
                    for (int r = 0; r < 4; ++r) o[r] = ((y[vt][tt][4 * g + r] - mean) * rstd * lw4[r] + lb4[r] + bon * vs4[r]) * gw4[r];
                    u32x2 w; w.x = cvtpk(o[0], o[1]); w.y = cvtpk(o[2], o[3]);
                    *(u32x2*)(Y + (size_t)row * D + ch) = w; }
        }
    }
}

struct Args { const float* in[26]; float* out; unsigned char* ws; };
__global__ void __launch_bounds__(NWAVES * 64, 2) hybrid_fwd(Args args) {
    extern __shared__ __attribute__((aligned(16))) unsigned char lds[];
    Frame F;
    F.lds = (LAS unsigned char*)lds;
    F.MISC = (volatile LAS unsigned*)(F.lds + MISC_OFF);
    F.tid = threadIdx.x; F.lane = F.tid & 63; F.wave = __builtin_amdgcn_readfirstlane(F.tid >> 6);
    F.G = gridDim.x; { const int bx = blockIdx.x; F.vcu = (F.G % 8 == 0) ? (bx % 8) * (F.G / 8) + bx / 8 : bx; }
    F.ws = args.ws; F.out = args.out; F.ctl = (gu32*)(args.ws + WS_CTL);
#pragma unroll
    for (int i = 0; i < 26; ++i) F.in[i] = args.in[i];
    for (int u = F.tid; u < (LDS_BYTES - LDSCTL_OFF) / 4; u += NWAVES * 64) ((LAS unsigned*)(F.lds + LDSCTL_OFF))[u] = 0u;
    __syncthreads();
    XcdBarrier bar = xcd_barrier_post((unsigned*)(F.ctl + CW_BAR), F.MISC + 8);
#define GRID_BAR() xcd_barrier(bar)

    bf16* Win_t = (bf16*)(F.ws + WS_WIN); bf16* Wout_t = (bf16*)(F.ws + WS_WOUT); bf16* Wgu_t = (bf16*)(F.ws + WS_WGU); bf16* Wd_t = (bf16*)(F.ws + WS_WD);
    bf16* XB = (bf16*)(F.ws + WS_XB); bf16* PB = (bf16*)(F.ws + WS_PB); bf16* HB = (bf16*)(F.ws + WS_HB); bf16* ACT = (bf16*)(F.ws + WS_PB);
    float* rstd1 = (float*)(F.ws + WS_RSTD1); float* ssq2 = (float*)(F.ctl + CW_SSQ2); float* ssq3 = (float*)(F.ctl + CW_SSQ3);

    p0_prologue(F);
    GRID_BAR();
    {
        pg8::Gemm g{XB, Win_t, M, NMAIN, D}; pg8::StaticOrder S; S.init(M, NMAIN, F.G, (int)blockIdx.x);
        pg8::EpiRowScaleBf16 E{PB, NMAIN, rstd1};
        pg8::gemm_phase<pg8::EpiRowScaleBf16, pg8::StaticOrder, true, true>(F.lds + RING_OFF, g, S, E);
    }
    GRID_BAR();
    p2_gates_naive(F);
    p2_rwkv_chunk(F);
    p2_compress_naive(F);
    GRID_BAR();
    if (blockIdx.x < 4) p3_rwkv_scan_mfma(F, 4 * (int)blockIdx.x + (F.wave >> 1), F.wave & 1);
    else p3_nsa_naive(F, 4, (int)F.G - 4);
    GRID_BAR();
    p3b_rwkv_out_mfma(F);
    GRID_BAR();
    {
        pg8::Gemm g{XB, Wout_t, M, D, D}; pg8::StaticOrder S; S.init(M, D, F.G, (int)blockIdx.x);
        pg8::EpiResid E{F.in[0], F.out, HB, ssq2, D};
        pg8::gemm_phase<pg8::EpiResid, pg8::StaticOrder, true, true>(F.lds + RING_OFF, g, S, E);
    }
    GRID_BAR();
    {
        pg8::Gemm g{HB, Wgu_t, M, NGU, D}; pg8::StaticOrder S; S.init(M, NGU, F.G, (int)blockIdx.x);
        pg8::EpiSwiGLU E{ACT, DFF, ssq2, NORM_EPS};
        pg8::gemm_phase<pg8::EpiSwiGLU, pg8::StaticOrder, true, true>(F.lds + RING_OFF, g, S, E);
    }
    GRID_BAR();
    {
        pg8::Gemm g{ACT, Wd_t, M, D, DFF}; pg8::StaticOrder S; S.init(M, D, F.G, (int)blockIdx.x);
        pg8::EpiResid E{F.out, F.out, nullptr, ssq3, D};
        pg8::gemm_phase<pg8::EpiResid, pg8::StaticOrder, true, true>(F.lds + RING_OFF, g, S, E);
    }
    GRID_BAR();
    p7_final_norm(F);
#undef GRID_BAR
}

extern "C" void kernel_launch(void* const* d_in, const int* in_sizes, int n_in, void* d_out, int out_size, void* d_ws, size_t ws_size, hipStream_t stream) {
    static int grid = 0;
    if (grid == 0) {
        if (n_in != 26 || in_sizes[0] != M * D || out_size != M * D || ws_size < WS_END) { fprintf(stderr, "kernel_launch: unexpected shapes (n_in %d, in0 %d, out %d, ws %zu); nothing launched\n", n_in, n_in > 0 ? in_sizes[0] : -1, out_size, ws_size); grid = -1; return; }
        int dev = 0, cus = 0, per_cu = 0;
        if (hipGetDevice(&dev) != hipSuccess || hipDeviceGetAttribute(&cus, hipDeviceAttributeMultiprocessorCount, dev) != hipSuccess) { fprintf(stderr, "kernel_launch: device query failed\n"); grid = -1; return; }
        if (hipFuncSetAttribute((const void*)hybrid_fwd, hipFuncAttributeMaxDynamicSharedMemorySize, LDS_BYTES) != hipSuccess) { fprintf(stderr, "kernel_launch: hipFuncSetAttribute failed\n"); grid = -1; return; }
        if (hipOccupancyMaxActiveBlocksPerMultiprocessor(&per_cu, (const void*)hybrid_fwd, NWAVES * 64, LDS_BYTES) != hipSuccess || per_cu < 1)
            fprintf(stderr, "kernel_launch: note: occupancy query reports %d workgroups per CU\n", per_cu);
        (void)hipGetLastError();
        grid = cus;
    }
    if (grid < 0) return;
    if (hipMemsetAsync((char*)d_ws + WS_CTL, 0, CTL_ZERO_BYTES, stream) != hipSuccess) { fprintf(stderr, "kernel_launch: hipMemsetAsync failed\n"); return; }
    Args a{};
    for (int i = 0; i < 26; ++i) a.in[i] = (const float*)d_in[i];
    a.out = (float*)d_out; a.ws = (unsigned char*)d_ws;
    hipLaunchKernelGGL(hybrid_fwd, dim3(grid), dim3(NWAVES * 64), LDS_BYTES, stream, a);
    const hipError_t le = hipPeekAtLastError();
    if (le != hipSuccess) fprintf(stderr, "kernel_launch: launch failed: %s\n", hipGetErrorName(le));
}
```

```cpp
#include <hip/hip_runtime.h>
#include <cstdio>
#include <cstdint>
namespace pg8 {
#define PG8_LAS __attribute__((address_space(3)))
typedef unsigned short bf16_t;
typedef short bf16x8 __attribute__((ext_vector_type(8)));
typedef float f32x4 __attribute__((ext_vector_type(4)));
typedef unsigned u32x4 __attribute__((ext_vector_type(4)));
constexpr int BM = 256, BK = 64, HALF = 128, HTB = HALF * BK * 2  , STAGE_BYTES = 8 * HTB, NXCD = 8, WGM = 8;

__host__ __device__ __forceinline__ int lds_byte(int r, int c) { const int st = (r >> 4) * 2 + (c >> 5), rr = r & 15, cc = c & 31, ob = rr * 64 + cc * 2; return st * 1024 + (ob ^ (((ob >> 9) & 1) << 5)); }
__host__ __device__ __forceinline__ void stage_rc(int b, int& R, int& C) { const int st = b / 1024, sb = b % 1024, swz = sb ^ (((sb >> 9) & 1) << 5); R = (st >> 1) * 16 + swz / 64; C = (st & 1) * 32 + (swz % 64) / 2; }
__host__ __device__ __forceinline__ int perm32(int rho) { const int n = rho >> 4, i = rho & 15; return 8 * (i >> 2) + 4 * n + (i & 3); }

struct Unit { int pm, pn; };
struct Gemm { const bf16_t* A; const bf16_t* Bt; int M, N, K; };

struct StaticOrder {
    int nM, nN, nwg, G, c;
    __host__ __device__ void init(int M, int N, int G_, int c_) { nM = M / BM; nN = N / BM; nwg = nM * nN; G = G_; c = c_; }
    __host__ __device__ bool next(int i, Unit& u) const {
        const long L = (long)i * G + c; if (L >= nwg) return false;
        int wgid = (int)L; { const int q = nwg / NXCD, r = nwg % NXCD, xcd = wgid % NXCD, off = wgid / NXCD; wgid = (xcd < r ? xcd * (q + 1) : r * (q + 1) + (xcd - r) * q) + off; }
        const int nig = WGM * nN, gid = wgid / nig, fm = gid * WGM, gsz = (nM - fm) < WGM ? (nM - fm) : WGM;
        u.pm = fm + ((wgid % nig) % gsz); u.pn = (wgid % nig) / gsz; return true;
    }
    __device__ __forceinline__ void a_ready(const Unit&) const {}
    __device__ __forceinline__ void done(const Unit&) const {}
};

__device__ __forceinline__ unsigned cvt_pk_bf16(float lo, float hi) { unsigned r; asm volatile("v_cvt_pk_bf16_f32 %0, %1, %2" : "=v"(r) : "v"(lo), "v"(hi)); return r; }
typedef float f32x2 __attribute__((ext_vector_type(2)));
__device__ __forceinline__ f32x2 gelu_pk(f32x2 v) {
    const f32x2 av = __builtin_elementwise_abs(v), d = av * 0.2316418882f + 1.0f;
    f32x2 t; t.x = __builtin_amdgcn_rcpf(d.x); t.y = __builtin_amdgcn_rcpf(d.y);
    f32x2 q = t * 0.5307027145f + (-0.7265760135f); q = q * t + 0.7107068705f; q = q * t + (-0.142248368f); q = q * t + 0.127414796f; q = q * t;
    const f32x2 s = (v * v) * (-0.72134752044f);
    f32x2 e; e.x = __builtin_amdgcn_exp2f(s.x); e.y = __builtin_amdgcn_exp2f(s.y);
    const f32x2 m = v * (q * e), r = v - m;
    f32x2 o; o.x = v.x < 0.f ? m.x : r.x; o.y = v.y < 0.f ? m.y : r.y; return o;
}

template <int ACT  > struct EpiBf16 {
    static constexpr bool PERM = true, AFTER_DRAIN = false; static_assert(ACT == 0 || ACT == 1, "EpiBf16: ACT is 0 (none) or 1 (gelu_pk)");
    bf16_t* O; int ldc; const float* bias; int split_cols; size_t split_stride; float scale0;
    __device__ __forceinline__ void operator()(const f32x4 (&acc)[2][2][4][2], const Unit& u, int wr, int wc, int fr, int fq) const {
        const int row0 = u.pm * BM + wr * 64 + fr; int colt = u.pn * BM; bf16_t* base = O;
        float sc = 1.f; if (split_cols) { const int t = colt / split_cols; base += (size_t)t * split_stride; colt -= t * split_cols; if (t == 0) sc = scale0; }
        const int col0 = colt + wc * 32 + 8 * fq, bcol0 = u.pn * BM + wc * 32 + 8 * fq;
        f32x4 bv[2][2];
#pragma unroll
        for (int bj = 0; bj < 2; ++bj)
#pragma unroll
            for (int n = 0; n < 2; ++n) bv[bj][n] = bias ? *(const f32x4*)(bias + bcol0 + bj * HALF + 4 * n) : (f32x4){0.f, 0.f, 0.f, 0.f};
#pragma unroll
        for (int ai = 0; ai < 2; ++ai)
#pragma unroll
            for (int m = 0; m < 4; ++m) { bf16_t* rowp = base + (size_t)(row0 + ai * HALF + m * 16) * ldc + col0;
#pragma unroll
                for (int bj = 0; bj < 2; ++bj) { f32x4 v0 = acc[ai][bj][m][0] + bv[bj][0], v1 = acc[ai][bj][m][1] + bv[bj][1];
                    if (ACT == 1) { f32x2 a = gelu_pk((f32x2){v0[0], v0[1]}), b = gelu_pk((f32x2){v0[2], v0[3]}), c = gelu_pk((f32x2){v1[0], v1[1]}), d = gelu_pk((f32x2){v1[2], v1[3]});
                        v0 = (f32x4){a.x, a.y, b.x, b.y}; v1 = (f32x4){c.x, c.y, d.x, d.y}; }
                    v0 = v0 * sc; v1 = v1 * sc; u32x4 w; w.x = cvt_pk_bf16(v0[0], v0[1]); w.y = cvt_pk_bf16(v0[2], v0[3]); w.z = cvt_pk_bf16(v1[0], v1[1]); w.w = cvt_pk_bf16(v1[2], v1[3]);
                    *(u32x4*)(rowp + bj * HALF) = w; } }
    }
};

struct EpiRowScaleBf16 {
    static constexpr bool PERM = true, AFTER_DRAIN = false;
    bf16_t* O; int ldc; const float* rs;
    __device__ __forceinline__ void operator()(const f32x4 (&acc)[2][2][4][2], const Unit& u, int wr, int wc, int fr, int fq) const {
        const int row0 = u.pm * BM + wr * 64 + fr; const int col0 = u.pn * BM + wc * 32 + 8 * fq;
#pragma unroll
        for (int ai = 0; ai < 2; ++ai)
#pragma unroll
            for (int m = 0; m < 4; ++m) { const int row = row0 + ai * HALF + m * 16; const float s = rs[row]; bf16_t* rowp = O + (size_t)row * ldc + col0;
#pragma unroll
                for (int bj = 0; bj < 2; ++bj) { const f32x4 v0 = acc[ai][bj][m][0] * s, v1 = acc[ai][bj][m][1] * s;
                    u32x4 w; w.x = cvt_pk_bf16(v0[0], v0[1]); w.y = cvt_pk_bf16(v0[2], v0[3]); w.z = cvt_pk_bf16(v1[0], v1[1]); w.w = cvt_pk_bf16(v1[2], v1[3]);
                    *(u32x4*)(rowp + bj * HALF) = w; } }
    }
};
struct EpiResid {
    static constexpr bool PERM = true, AFTER_DRAIN = false;
    const float* base; float* out; bf16_t* ob; float* ssq; int ldc;
    __device__ __forceinline__ void operator()(const f32x4 (&acc)[2][2][4][2], const Unit& u, int wr, int wc, int fr, int fq) const {
        const int row0 = u.pm * BM + wr * 64 + fr; const int col0 = u.pn * BM + wc * 32 + 8 * fq;
#pragma unroll
        for (int ai = 0; ai < 2; ++ai)
#pragma unroll
            for (int m = 0; m < 4; ++m) { const int row = row0 + ai * HALF + m * 16; const size_t off = (size_t)row * ldc + col0; float ss = 0.f;
#pragma unroll
                for (int bj = 0; bj < 2; ++bj) {
                    const f32x4 b0 = *(const f32x4*)(base + off + bj * HALF), b1 = *(const f32x4*)(base + off + bj * HALF + 4);
                    const f32x4 v0 = acc[ai][bj][m][0] + b0, v1 = acc[ai][bj][m][1] + b1;
                    *(f32x4*)(out + off + bj * HALF) = v0; *(f32x4*)(out + off + bj * HALF + 4) = v1;
                    ss += (v0[0] * v0[0] + v0[1] * v0[1]) + (v0[2] * v0[2] + v0[3] * v0[3]) + (v1[0] * v1[0] + v1[1] * v1[1]) + (v1[2] * v1[2] + v1[3] * v1[3]);
                    if (ob) { u32x4 w; w.x = cvt_pk_bf16(v0[0], v0[1]); w.y = cvt_pk_bf16(v0[2], v0[3]); w.z = cvt_pk_bf16(v1[0], v1[1]); w.w = cvt_pk_bf16(v1[2], v1[3]);
                        *(u32x4*)(ob + off + bj * HALF) = w; } }
                ss += __shfl_xor(ss, 16); ss += __shfl_xor(ss, 32);
                if (fq == 0) atomicAdd(ssq + row, ss); }
    }
};
struct EpiSwiGLU {
    static constexpr bool PERM = true, AFTER_DRAIN = false;
    bf16_t* O; int ldc; const float* ssq; float eps;
    __device__ __forceinline__ void operator()(const f32x4 (&acc)[2][2][4][2], const Unit& u, int wr, int wc, int fr, int fq) const {
        const int row0 = u.pm * BM + wr * 64 + fr; const int col0 = u.pn * HALF + wc * 32 + 8 * fq;
#pragma unroll
        for (int ai = 0; ai < 2; ++ai)
#pragma unroll
            for (int m = 0; m < 4; ++m) { const int row = row0 + ai * HALF + m * 16; const float s = 1.0f / sqrtf(ssq[row] * (1.0f / 1024.0f) + eps);
                float a[8];
#pragma unroll
                for (int n = 0; n < 2; ++n)
#pragma unroll
                    for (int j = 0; j < 4; ++j) { const float g = acc[ai][0][m][n][j] * s, up = acc[ai][1][m][n][j] * s; a[n * 4 + j] = g / (1.0f + __expf(-g)) * up; }
                u32x4 w; w.x = cvt_pk_bf16(a[0], a[1]); w.y = cvt_pk_bf16(a[2], a[3]); w.z = cvt_pk_bf16(a[4], a[5]); w.w = cvt_pk_bf16(a[6], a[7]);
                *(u32x4*)(O + (size_t)row * ldc + col0) = w; }
    }
};
template <class Epi, class Sched, bool ALIGN_EPI = false, bool SP2 = false>
__device__ __forceinline__ void gemm_phase(PG8_LAS unsigned char* lds, const Gemm g, const Sched& S, const Epi& E) {
    const int tid = threadIdx.x, wid = __builtin_amdgcn_readfirstlane(tid >> 6), lane = tid & 63, wr = wid >> 2, wc = wid & 3, fr = lane & 15, fq = lane >> 4;
    const int K = g.K, nt = K / BK;
    unsigned voffA[2], voffB[2];
#pragma unroll
    for (int i = 0; i < 2; ++i) { int R, C; stage_rc(tid * 16 + i * 8192, R, C); const int Rb = Epi::PERM ? ((R & ~31) + perm32(R & 31)) : R;
        voffA[i] = (unsigned)(R * K + C) * 2u; voffB[i] = (unsigned)(Rb * K + C) * 2u; }
    const size_t kstep = (size_t)(BK * 2);
    const size_t hstep = (size_t)HALF * K * 2;
    const size_t tstep = 2 * hstep;
    const unsigned ldsw = (unsigned)wid * 1024u;
    const int aoff = lds_byte(wr * 64 + fr, fq * 8), boff = lds_byte(wc * 32 + fr, fq * 8);
#define PG8_SA(b, h) (((b) * 2 + (h)) * HTB)
#define PG8_SB(b, h) ((4 + (b) * 2 + (h)) * HTB)
#define PG8_STAGE(bufoff, gbase, voff) do { _Pragma("unroll") for (int _i = 0; _i < 2; ++_i) \
        __builtin_amdgcn_global_load_lds((const unsigned*)((const char*)(gbase) + (voff)[_i]), (PG8_LAS unsigned*)(lds + (bufoff) + ldsw + _i * 8192), 16, 0, 0); } while (0)
#define PG8_LDA(dst, b, h) do { _Pragma("unroll") for (int m = 0; m < 4; ++m) _Pragma("unroll") for (int k = 0; k < 2; ++k) dst[m][k] = *(const PG8_LAS bf16x8*)(lds + PG8_SA(b, h) + aoff + m * 2048 + k * 1024); } while (0)
#define PG8_LDB(dst, b, h) do { _Pragma("unroll") for (int n = 0; n < 2; ++n) _Pragma("unroll") for (int k = 0; k < 2; ++k) dst[n][k] = *(const PG8_LAS bf16x8*)(lds + PG8_SB(b, h) + boff + n * 2048 + k * 1024); } while (0)
#define PG8_MMA(ai, bj, At, Bt) do { __builtin_amdgcn_s_setprio(1); _Pragma("unroll") for (int m = 0; m < 4; ++m) _Pragma("unroll") for (int n = 0; n < 2; ++n) _Pragma("unroll") for (int k = 0; k < 2; ++k) \
        acc[ai][bj][m][n] = __builtin_amdgcn_mfma_f32_16x16x32_bf16(Bt[n][k], At[m][k], acc[ai][bj][m][n], 0, 0, 0); __builtin_amdgcn_s_setprio(0); } while (0)
#define PG8_WAIT_V(n) asm volatile("s_waitcnt vmcnt(" #n ")" ::: "memory")
#define PG8_WAIT_L(n) asm volatile("s_waitcnt lgkmcnt(" #n ")" ::: "memory")
#define PG8_BAR __builtin_amdgcn_s_barrier()
#define PG8_SCHED __builtin_amdgcn_sched_barrier(0)
    Unit cur, nxt; int ui = 0;
    if (!S.next(0, cur)) return;
    f32x4 acc[2][2][4][2];
#pragma unroll
    for (int a = 0; a < 2; ++a)
#pragma unroll
        for (int b = 0; b < 2; ++b)
#pragma unroll
            for (int m = 0; m < 4; ++m)
#pragma unroll
                for (int n = 0; n < 2; ++n) acc[a][b][m][n] = (f32x4){0.f, 0.f, 0.f, 0.f};
    bf16x8 At[4][2], B0[2][2], B1[2][2];
    const char* cA = (const char*)g.A + (size_t)cur.pm * tstep; const char* cB = (const char*)g.Bt + (size_t)cur.pn * tstep;
    S.a_ready(cur);
    if constexpr (SP2) {
        PG8_STAGE(PG8_SB(0, 0), cB, voffB); PG8_STAGE(PG8_SB(0, 1), cB + hstep, voffB); PG8_STAGE(PG8_SA(0, 0), cA, voffA); PG8_STAGE(PG8_SA(0, 1), cA + hstep, voffA);
        if (wr == 1) PG8_BAR;
        PG8_WAIT_V(2); PG8_BAR;
        PG8_STAGE(PG8_SB(1, 0), cB + kstep, voffB); PG8_STAGE(PG8_SA(1, 0), cA + kstep, voffA); PG8_STAGE(PG8_SB(1, 1), cB + hstep + kstep, voffB);
        PG8_WAIT_V(6); PG8_BAR;
    } else {
        PG8_STAGE(PG8_SB(0, 0), cB, voffB); PG8_STAGE(PG8_SA(0, 0), cA, voffA); PG8_STAGE(PG8_SB(0, 1), cB + hstep, voffB); PG8_STAGE(PG8_SA(0, 1), cA + hstep, voffA);
        if (wr == 1) PG8_BAR;
        PG8_WAIT_V(4); PG8_BAR;
        PG8_STAGE(PG8_SB(1, 0), cB + kstep, voffB); PG8_STAGE(PG8_SA(1, 0), cA + kstep, voffA); PG8_STAGE(PG8_SB(1, 1), cB + hstep + kstep, voffB);
        PG8_WAIT_V(6); PG8_BAR;
    }
    for (;;) {
        const bool has_next = S.next(ui + 1, nxt);
        const char* nA = has_next ? (const char*)g.A + (size_t)nxt.pm * tstep : cA; const char* nB = has_next ? (const char*)g.Bt + (size_t)nxt.pn * tstep : cB;
        for (int t = 0; t < nt; t += 2) {
            const bool last = (t == nt - 2);
            const char* a1 = cA + (size_t)(t + 1) * kstep;
            const char* a2 = last ? nA : cA + (size_t)(t + 2) * kstep; const char* b2 = last ? nB : cB + (size_t)(t + 2) * kstep;
            const char* a3 = a2 + kstep; const char* b3 = b2 + kstep;
            if (last && has_next) S.a_ready(nxt);
            if constexpr (SP2) {
            PG8_LDB(B0, 0, 0); PG8_LDB(B1, 0, 1); PG8_SCHED; PG8_LDA(At, 0, 0); PG8_STAGE(PG8_SA(1, 1), a1 + hstep, voffA);
            PG8_WAIT_V(8); PG8_WAIT_L(0); PG8_BAR; PG8_MMA(0, 0, At, B0); PG8_MMA(0, 1, At, B1); PG8_BAR; PG8_SCHED;
            PG8_LDA(At, 0, 1); PG8_STAGE(PG8_SB(0, 0), b2, voffB); PG8_STAGE(PG8_SB(0, 1), b2 + hstep, voffB); PG8_STAGE(PG8_SA(0, 0), a2, voffA);
            PG8_WAIT_V(8); PG8_WAIT_L(0); PG8_BAR; PG8_MMA(1, 0, At, B0); PG8_MMA(1, 1, At, B1); PG8_BAR; PG8_SCHED;
            PG8_LDB(B0, 1, 0); PG8_LDB(B1, 1, 1); PG8_SCHED; PG8_LDA(At, 1, 0); PG8_STAGE(PG8_SA(0, 1), a2 + hstep, voffA);
            PG8_WAIT_V(8); PG8_WAIT_L(0); PG8_BAR; PG8_MMA(0, 0, At, B0); PG8_MMA(0, 1, At, B1); PG8_BAR; PG8_SCHED;
            PG8_LDA(At, 1, 1); PG8_STAGE(PG8_SB(1, 0), b3, voffB); PG8_STAGE(PG8_SB(1, 1), b3 + hstep, voffB); PG8_STAGE(PG8_SA(1, 0), a3, voffA);
            PG8_WAIT_V(8); PG8_WAIT_L(0); PG8_BAR; PG8_MMA(1, 0, At, B0); PG8_MMA(1, 1, At, B1); PG8_BAR; PG8_SCHED;
            } else {
            PG8_LDB(B0, 0, 0); PG8_SCHED; PG8_LDA(At, 0, 0); PG8_STAGE(PG8_SA(1, 1), a1 + hstep, voffA);
            PG8_WAIT_L(8); PG8_BAR; PG8_WAIT_L(0); PG8_MMA(0, 0, At, B0); PG8_BAR; PG8_SCHED;
            PG8_LDB(B1, 0, 1); PG8_STAGE(PG8_SB(0, 0), b2, voffB);
            PG8_BAR; PG8_WAIT_L(0); PG8_MMA(0, 1, At, B1); PG8_BAR;
            PG8_LDA(At, 0, 1); PG8_STAGE(PG8_SA(0, 0), a2, voffA);
            PG8_BAR; PG8_WAIT_L(0); PG8_MMA(1, 0, At, B0); PG8_BAR; PG8_SCHED;
            PG8_STAGE(PG8_SB(0, 1), b2 + hstep, voffB);
            PG8_WAIT_V(6); PG8_BAR; PG8_MMA(1, 1, At, B1); PG8_BAR;
            PG8_LDB(B0, 1, 0); PG8_SCHED; PG8_LDA(At, 1, 0); PG8_STAGE(PG8_SA(0, 1), a2 + hstep, voffA);
            PG8_WAIT_L(8); PG8_BAR; PG8_WAIT_L(0); PG8_MMA(0, 0, At, B0); PG8_BAR; PG8_SCHED;
            PG8_LDB(B1, 1, 1); PG8_STAGE(PG8_SB(1, 0), b3, voffB);
            PG8_BAR; PG8_WAIT_L(0); PG8_MMA(0, 1, At, B1); PG8_BAR;
            PG8_LDA(At, 1, 1); PG8_STAGE(PG8_SA(1, 0), a3, voffA);
            PG8_BAR; PG8_WAIT_L(0); PG8_MMA(1, 0, At, B0); PG8_BAR; PG8_SCHED;
            PG8_STAGE(PG8_SB(1, 1), b3 + hstep, voffB);
            PG8_WAIT_V(6); PG8_BAR; PG8_MMA(1, 1, At, B1); PG8_BAR;
            }
        }
        if constexpr (ALIGN_EPI) { if (wr == 0) PG8_BAR; }
        if constexpr (!Epi::AFTER_DRAIN) { E(acc, cur, wr, wc, fr, fq); S.done(cur); }
        if (!has_next) break;
#pragma unroll
        for (int a = 0; a < 2; ++a)
#pragma unroll
            for (int b = 0; b < 2; ++b)
#pragma unroll
                for (int m = 0; m < 4; ++m)
#pragma unroll
                    for (int n = 0; n < 2; ++n) acc[a][b][m][n] = (f32x4){0.f, 0.f, 0.f, 0.f};
        cur = nxt; cA = nA; cB = nB; ++ui;
        if constexpr (ALIGN_EPI) { if (wr == 1) PG8_BAR; }
    }
    PG8_WAIT_V(0);
    if constexpr (!ALIGN_EPI) { if (wr == 0) PG8_BAR; }
    PG8_BAR;
    if constexpr (Epi::AFTER_DRAIN) { E.fused(acc, cur, wr, wc, fr, fq, lds, wid, lane); S.done(cur); }
#undef PG8_SA
#undef PG8_SB
#undef PG8_STAGE
#undef PG8_LDA
#undef PG8_LDB
#undef PG8_MMA
#undef PG8_WAIT_V
#undef PG8_WAIT_L
#undef PG8_BAR
#undef PG8_SCHED
}
}

#ifndef PG8_SP2
#define PG8_SP2 true
#endif
#ifndef PG8_ALIGN
#define PG8_ALIGN true
#endif

constexpr int NWAVES = 8;
constexpr int BATCH = 2, T = 8192, D = 1024, M = BATCH * T;
constexpr int NIN = 3096, NMAIN = 3072, DFF = 2816, NGU = 2 * DFF;
constexpr int C_R = 0, C_K = 512, C_V = 1024, C_DW = 1536, C_DA = 1600, C_DG = 1664, C_Q = 1792, C_KC = 2304, C_VC = 2432, C_KS = 2560, C_VS = 2688, C_KW = 2816, C_VW = 2944, C_GL = 3072;
constexpr int NCMP = 511, NCMPP = 512;
constexpr float NORM_EPS = 1e-6f, GN_EPS = 64e-5f, NEGV = -1e30f, BIGV = 1e30f;

constexpr size_t MiB = 1u << 20;
constexpr size_t WS_CTL = 0, CTL_ZERO_BYTES = 1 * MiB;
constexpr size_t WS_WIN = 2 * MiB;
constexpr size_t WS_WOUT = 9 * MiB;
constexpr size_t WS_WGU = 11 * MiB;
constexpr size_t WS_WD = 22 * MiB;
constexpr size_t WS_RSTD1 = 28 * MiB;
constexpr size_t WS_GATES = 28 * MiB + 256 * 1024;
constexpr size_t WS_CMP = 30 * MiB;
constexpr size_t WS_LORA = 31 * MiB;
constexpr size_t WS_XB = 32 * MiB;
constexpr size_t WS_PB = 64 * MiB;
constexpr size_t WS_HB = 160 * MiB;
constexpr size_t WS_G = 192 * MiB;
constexpr size_t WS_VS = 224 * MiB;
constexpr size_t WS_BONUS = 240 * MiB;
constexpr size_t WS_VT = 242 * MiB;
constexpr size_t WS_END = 256 * MiB;
constexpr int CW_BAR = 4096;
constexpr int CW_SSQ2 = 65536;
constexpr int CW_SSQ3 = 65536 + 16384;
constexpr int CW_QUEUE = 2048;
static_assert((CW_SSQ3 + 16384) * 4 <= (int)CTL_ZERO_BYTES, "ctl");

constexpr int RING_OFF = 0, RING_BYTES = 131072;
constexpr int LDSCTL_OFF = RING_BYTES, MISC_OFF = LDSCTL_OFF + 320;
constexpr int LDS_BYTES = 147456;
#define GAS __attribute__((address_space(1)))
#define LAS __attribute__((address_space(3)))
typedef unsigned short bf16;
typedef unsigned v4u __attribute__((ext_vector_type(4)));
typedef float f32x4 __attribute__((ext_vector_type(4)));
typedef short bf16x8 __attribute__((ext_vector_type(8)));
typedef GAS unsigned gu32;
typedef GAS unsigned long long gu64;
#define RLX_AGENT __ATOMIC_RELAXED, __HIP_MEMORY_SCOPE_AGENT
#define LDS_WAIT() asm volatile("s_waitcnt lgkmcnt(0)" ::: "memory")
#define VM_WAIT() asm volatile("s_waitcnt vmcnt(0)" ::: "memory")
__device__ __forceinline__ unsigned long long rt() { return __builtin_amdgcn_s_memrealtime(); }
__device__ __forceinline__ unsigned f2bf(float f) { unsigned u = __builtin_bit_cast(unsigned, f); return (u + 0x7fffu + ((u >> 16) & 1u)) >> 16; }
__device__ __forceinline__ unsigned pk2(float lo, float hi) { return f2bf(lo) | (f2bf(hi) << 16); }

#define XB_TMO      128
#define XB_XCNT(j)  (256  + 64 * (j))
#define XB_XSUB(j)  (1280 + 64 * (j))
#define XB_XGEN(j)  (2304 + 64 * (j))
#define XB_TOP      3328
#define XB_TOPGEN   3392
#define XCD_BAR_WORDS 3456
#define XB_SPIN_CAP (1u << 18)

__device__ __forceinline__ unsigned xb_ld(unsigned* p)              { return __hip_atomic_load(p, __ATOMIC_RELAXED, __HIP_MEMORY_SCOPE_AGENT); }
__device__ __forceinline__ unsigned xb_add(unsigned* p, unsigned v) { return __hip_atomic_fetch_add(p, v, __ATOMIC_RELAXED, __HIP_MEMORY_SCOPE_AGENT); }
__device__ __forceinline__ unsigned xb_xcc_id() { return (unsigned)__builtin_amdgcn_s_getreg((3 << 11) | 20) & 0xFu; }
#define XB_SPIN(cond, bar) do { unsigned _sp = 0; while (cond) { __builtin_amdgcn_s_sleep(1); \
    if ((++_sp & 255u) == 0u) { if (xb_ld(&(bar)[XB_TMO])) break; if (_sp > XB_SPIN_CAP) { atomicAdd(&(bar)[XB_TMO], 1u); break; } } } } while (0)

struct XcdBarrier {
    unsigned* bar; unsigned x;
    volatile LAS unsigned* st;
};

__device__ __forceinline__ XcdBarrier xcd_barrier_post(unsigned* bar, volatile LAS unsigned* st) {
    XcdBarrier b; b.bar = bar; b.x = xb_xcc_id(); b.st = st;
    if (threadIdx.x == 0) (void)xb_add(&bar[XB_XCNT(b.x)], 1u);
    return b;
}
__device__ __forceinline__ void xcd_barrier_complete(unsigned* bar, unsigned x, unsigned& nloc, unsigned& nx) {
    const unsigned G = gridDim.x * gridDim.y * gridDim.z;
    unsigned sum, cnt, mine, sp = 0u;
    for (;;) {
        sum = 0u; cnt = 0u; mine = 0u;
#pragma unroll
        for (unsigned j = 0; j < 16; ++j) { const unsigned c = xb_ld(&bar[XB_XCNT(j)]); sum += c; cnt += (c > 0u) ? 1u : 0u; mine = (j == x) ? c : mine; }
        if (sum == G) break;
        __builtin_amdgcn_s_sleep(1);
        if ((++sp & 255u) == 0u) { if (xb_ld(&bar[XB_TMO])) break; if (sp > XB_SPIN_CAP) { atomicAdd(&bar[XB_TMO], 1u); break; } }
    }
    nloc = mine > 0u ? mine : 1u; nx = cnt > 0u ? cnt : 1u;
}

__device__ __forceinline__ void xcd_barrier(const XcdBarrier& b) {
    asm volatile("s_waitcnt vmcnt(0)" ::: "memory");
    __syncthreads();
    if (threadIdx.x == 0) {
        unsigned* bar = b.bar;
        __builtin_amdgcn_s_waitcnt(0);
        unsigned nloc = b.st[0], nx = b.st[1];
        if (nloc == 0u) { xcd_barrier_complete(bar, b.x, nloc, nx); b.st[0] = nloc; b.st[1] = nx; }
        const unsigned old = xb_add(&bar[XB_XSUB(b.x)], 1u);
        const unsigned gen = old / nloc;
        if (old + 1u == (gen + 1u) * nloc) {
            __builtin_amdgcn_fence(__ATOMIC_RELEASE, "agent");
            asm volatile("s_waitcnt vmcnt(0)" ::: "memory");
            const unsigned og = xb_add(&bar[XB_TOP], 1u);
            const unsigned tg = og / nx;
            if (og + 1u == (tg + 1u) * nx) xb_add(&bar[XB_TOPGEN], 1u);
            else XB_SPIN(xb_ld(&bar[XB_TOPGEN]) == tg, bar);
            __builtin_amdgcn_fence(__ATOMIC_ACQUIRE, "agent");
            xb_add(&bar[XB_XGEN(b.x)], 1u);
            asm volatile("s_waitcnt vmcnt(0)" ::: "memory");
        } else {
            XB_SPIN(xb_ld(&bar[XB_XGEN(b.x)]) == gen, bar);
            __builtin_amdgcn_fence(__ATOMIC_ACQUIRE, "agent");
            asm volatile("s_waitcnt vmcnt(0)" ::: "memory");
        }
    }
    __syncthreads();
}


struct Frame {
    LAS unsigned char* lds;
    volatile LAS unsigned* MISC;
    gu32* ctl;
    int tid, lane, wave;
    int vcu, G;
    const float* in[26];
    float* out; unsigned char* ws;
};
__device__ __forceinline__ float wave_sum(float v) {
#pragma unroll
    for (int o = 1; o < 64; o <<= 1) v += __shfl_xor(v, o);
    return v;
}
__device__ __forceinline__ float wave_max(float v) {
#pragma unroll
    for (int o = 1; o < 64; o <<= 1) v = fmaxf(v, __shfl_xor(v, o));
    return v;
}
__device__ __forceinline__ float bf2f(bf16 b) { return __builtin_bit_cast(float, (unsigned)b << 16); }
__device__ __forceinline__ float sigmoidf_(float x) { return 1.0f / (1.0f + expf(-x)); }
__device__ __forceinline__ float softplusf_(float z) { return z > 20.f ? z : log1pf(expf(z)); }
__device__ __forceinline__ float gelu_tanhf_(float x) { const float u = 0.7978845608028654f * (x + 0.044715f * x * x * x); return 0.5f * x * (1.0f + tanhf(u)); }

template <int MODE  >
__device__ __forceinline__ void p0_transpose_item(const float* W, int K, int N, const float* gain, bf16* WT, LAS float* scr, int item, int lane) {
    const int nblk = (N + 31) / 32, kb = item / nblk, nb = item % nblk, k0 = 64 * kb, n0 = 32 * nb;
#pragma unroll 8
    for (int i = 0; i < 32; ++i) { const int kk = 2 * i + (lane >> 5); const int n = n0 + (lane & 31);
        float v = 0.f; if (n < N) { v = W[(size_t)(k0 + kk) * N + n]; if (gain) v *= gain[k0 + kk]; }
        scr[kk * 33 + (lane & 31)] = v; }
    LDS_WAIT(); asm volatile("" ::: "memory");
    const int c = lane & 7;
    int rb = n0; if (MODE == 1) rb = 256 * (n0 / 128) + (n0 % 128); if (MODE == 2) rb = 256 * (n0 / 128) + 128 + (n0 % 128);
#pragma unroll
    for (int j = 0; j < 4; ++j) { const int n = (lane >> 3) + 8 * j; const LAS float* s = scr + (8 * c) * 33 + n;
        v4u o; o.x = pk2(s[0 * 33], s[1 * 33]); o.y = pk2(s[2 * 33], s[3 * 33]); o.z = pk2(s[4 * 33], s[5 * 33]); o.w = pk2(s[6 * 33], s[7 * 33]);
        *(GAS v4u*)(WT + (size_t)(rb + n) * K + k0 + 8 * c) = o; }
    LDS_WAIT(); asm volatile("" ::: "memory");
}
__device__ __forceinline__ void p0_prologue(Frame& F) {
    LAS float* scr = (LAS float*)(F.lds + RING_OFF + F.wave * 16384);
    const int gw = F.vcu * NWAVES + F.wave, NGW = F.G * NWAVES;
    constexpr int I_IN = (D / 64) * ((NIN + 31) / 32), I_OUT = (D / 64) * (D / 32), I_G = (D / 64) * (DFF / 32), I_D = (DFF / 64) * (D / 32);
    constexpr int I_L = 16, I_LG = 32;
    constexpr int NITEMS = I_IN + I_OUT + 2 * I_G + I_D + 2 * I_L + I_LG;
    bf16* W2T = (bf16*)(F.ws + WS_LORA); bf16* A2T = W2T + 512 * 64; bf16* G2T = A2T + 512 * 64;
    bf16* Win_t = (bf16*)(F.ws + WS_WIN); bf16* Wout_t = (bf16*)(F.ws + WS_WOUT); bf16* Wgu_t = (bf16*)(F.ws + WS_WGU); bf16* Wd_t = (bf16*)(F.ws + WS_WD);
    for (int it = gw; it < NITEMS; it += NGW) {
        int r = it;
        if (r < I_IN) { p0_transpose_item<0>(F.in[2], D, NIN, F.in[1], Win_t, scr, r, F.lane); continue; } r -= I_IN;
        if (r < I_OUT) { p0_transpose_item<0>(F.in[20], D, D, nullptr, Wout_t, scr, r, F.lane); continue; } r -= I_OUT;
        if (r < I_G) { p0_transpose_item<1>(F.in[22], D, DFF, F.in[21], Wgu_t, scr, r, F.lane); continue; } r -= I_G;
        if (r < I_G) { p0_transpose_item<2>(F.in[23], D, DFF, F.in[21], Wgu_t, scr, r, F.lane); continue; } r -= I_G;
        if (r < I_D) { p0_transpose_item<0>(F.in[24], DFF, D, nullptr, Wd_t, scr, r, F.lane); continue; } r -= I_D;
        if (r < I_L) { p0_transpose_item<0>(F.in[5], 64, 512, nullptr, W2T, scr, r, F.lane); continue; } r -= I_L;
        if (r < I_L) { p0_transpose_item<0>(F.in[7], 64, 512, nullptr, A2T, scr, r, F.lane); continue; } r -= I_L;
        p0_transpose_item<0>(F.in[8], 128, 512, nullptr, G2T, scr, r, F.lane);
    }
    bf16* XB = (bf16*)(F.ws + WS_XB); float* rstd1 = (float*)(F.ws + WS_RSTD1);
    for (int m = gw; m < M; m += NGW) {
        const GAS f32x4* xr = (const GAS f32x4*)(F.in[0] + (size_t)m * D) + F.lane;
        f32x4 v[4]; float s = 0.f;
#pragma unroll
        for (int j = 0; j < 4; ++j) { v[j] = xr[64 * j]; s += (v[j].x * v[j].x + v[j].y * v[j].y) + (v[j].z * v[j].z + v[j].w * v[j].w); }
        const float tot = wave_sum(s);
        GAS unsigned long long* o8 = (GAS unsigned long long*)(XB + (size_t)m * D) + F.lane;
#pragma unroll
        for (int j = 0; j < 4; ++j) o8[64 * j] = (unsigned long long)pk2(v[j].x, v[j].y) | ((unsigned long long)pk2(v[j].z, v[j].w) << 32);
        if (F.lane == 0) rstd1[m] = 1.0f / sqrtf(tot * (1.0f / D) + NORM_EPS);
    }
}

__device__ __forceinline__ void p2_gates_naive(Frame& F) {
    const int gw = F.vcu * NWAVES + F.wave, NGW = F.G * NWAVES, lane = F.lane;
    const bf16* XB = (const bf16*)(F.ws + WS_XB); const bf16* Wg = (const bf16*)(F.ws + WS_WIN) + (size_t)C_GL * D; const float* rstd1 = (const float*)(F.ws + WS_RSTD1);
    float* gates = (float*)(F.ws + WS_GATES);
    for (int m = gw; m < M; m += NGW) {
        float xv[16];
        { const bf16x8 a = *(const bf16x8*)(XB + (size_t)m * D + lane * 16), b = *(const bf16x8*)(XB + (size_t)m * D + lane * 16 + 8);
#pragma unroll
          for (int j = 0; j < 8; ++j) { xv[j] = bf2f((bf16)a[j]); xv[8 + j] = bf2f((bf16)b[j]); } }
        const float rs = rstd1[m];
        float mine = 0.f;
        for (int j = 0; j < 24; ++j) {
            const bf16x8 a = *(const bf16x8*)(Wg + (size_t)j * D + lane * 16), b = *(const bf16x8*)(Wg + (size_t)j * D + lane * 16 + 8);
            float s = 0.f;
#pragma unroll
            for (int q = 0; q < 8; ++q) { s += xv[q] * bf2f((bf16)a[q]); s += xv[8 + q] * bf2f((bf16)b[q]); }
            s = wave_sum(s);
            if (lane == j) mine = s;
        }
        if (lane < 24) gates[(size_t)m * 24 + lane] = sigmoidf_(mine * rs);
    }
}
__device__ __forceinline__ void p2_rwkv_prep_naive(Frame& F) {
    LAS float* L = (LAS float*)(F.lds + RING_OFF);
    const bf16* PB = (const bf16*)(F.ws + WS_PB);
    const float* mu = F.in[3]; const float* w0 = F.in[4]; const float* w2 = F.in[5]; const float* a0 = F.in[6]; const float* a2 = F.in[7]; const float* g2 = F.in[8];
    float* wdec = F.out; float* asig = F.out + (size_t)M * 512; float* gg = (float*)(F.ws + WS_G);
    const int c = F.tid;
    for (int it = F.vcu; it < M / 16; it += F.G) {
        const int r0 = it * 16;
        for (int idx = F.tid; idx < 16 * 256; idx += NWAVES * 64) {
            const int tok = idx >> 8, j = idx & 255; const int row = r0 + tok; const int col = C_DW + j;
            const float p = bf2f(PB[(size_t)row * NMAIN + col]);
            const float pp = ((row % T) == 0) ? 0.f : bf2f(PB[(size_t)(row - 1) * NMAIN + col]);
            const float ps = p + mu[col] * (pp - p);
            L[tok * 256 + j] = (j < 64) ? tanhf(ps) : (j < 128 ? ps : sigmoidf_(ps));
        }
        __syncthreads();
        float aw[16], aa[16], ag[16];
#pragma unroll
        for (int k = 0; k < 16; ++k) { aw[k] = 0.f; aa[k] = 0.f; ag[k] = 0.f; }
        for (int j = 0; j < 64; ++j) { const float w = w2[j * 512 + c], a = a2[j * 512 + c];
#pragma unroll
            for (int k = 0; k < 16; ++k) { aw[k] += L[k * 256 + j] * w; aa[k] += L[k * 256 + 64 + j] * a; } }
        for (int j = 0; j < 128; ++j) { const float g = g2[j * 512 + c];
#pragma unroll
            for (int k = 0; k < 16; ++k) ag[k] += L[k * 256 + 128 + j] * g; }
        const float w0c = w0[c], a0c = a0[c];
#pragma unroll
        for (int k = 0; k < 16; ++k) { const size_t o = (size_t)(r0 + k) * 512 + c;
            const float wl = -softplusf_(-(w0c + aw[k])) - 0.5f;
            wdec[o] = expf(-expf(wl)); asig[o] = sigmoidf_(a0c + aa[k]); gg[o] = ag[k]; }
        __syncthreads();
    }
}
__device__ __forceinline__ void p2_compress_naive(Frame& F) {
    LAS float* X = (LAS float*)(F.lds + RING_OFF);
    LAS float* PE = X + 144 * 64;
    LAS float* HID = PE + 2048;
    const bf16* PB = (const bf16*)(F.ws + WS_PB);
    for (int it = F.vcu; it < 2 * 2 * 2 * 64; it += F.G) {
        const int kv = it >> 8, b = (it >> 7) & 1, hk = (it >> 6) & 1, c0 = (it & 63) * 8;
        const float* pe = kv ? F.in[15] : F.in[14]; const float* W1 = kv ? F.in[18] : F.in[16]; const float* W2 = kv ? F.in[19] : F.in[17];
        const int col = (kv ? C_VC : C_KC) + hk * 64;
        for (int idx = F.tid; idx < 144 * 64; idx += NWAVES * 64) { const int tok = idx >> 6, d = idx & 63; const int t = 16 * c0 + tok;
            X[idx] = (t < T) ? bf2f(PB[(size_t)(b * T + t) * NMAIN + col + d]) : 0.f; }
        for (int idx = F.tid; idx < 2048; idx += NWAVES * 64) PE[idx] = pe[idx];
        __syncthreads();
        { const int n = F.tid & 255, half = F.tid >> 8; float acc[4] = {0.f, 0.f, 0.f, 0.f};
          for (int k = 0; k < 2048; ++k) { const float w = W1[(size_t)k * 256 + n]; const int l = k >> 6, d = k & 63; const float pev = PE[k];
#pragma unroll
              for (int jj = 0; jj < 4; ++jj) acc[jj] += (X[((4 * half + jj) * 16 + l) * 64 + d] + pev) * w; }
#pragma unroll
          for (int jj = 0; jj < 4; ++jj) HID[(4 * half + jj) * 256 + n] = gelu_tanhf_(acc[jj]); }
        __syncthreads();
        { const int blk = F.tid >> 6, j = F.tid & 63; float s = 0.f;
          for (int n = 0; n < 256; ++n) s += HID[blk * 256 + n] * W2[n * 64 + j];
          const int c = c0 + blk; const int bhk = b * 2 + hk; const bf16 ov = (c < NCMP) ? (bf16)f2bf(s) : (bf16)0; const int pc = (c & ~15) | (((c >> 2) & 1) << 3) | (((c >> 3) & 1) << 2) | (c & 3);
          if (kv == 0) ((bf16*)(F.ws + WS_CMP))[((size_t)bhk * NCMPP + c) * 64 + j] = ov; else ((bf16*)(F.ws + WS_CMP + 262144))[((size_t)bhk * 64 + j) * NCMPP + pc] = ov; }
        __syncthreads();
    }
}
__device__ __forceinline__ void p3_rwkv_scan_naive(Frame& F, int b, int h) {
    const bf16* PB = (const bf16*)(F.ws + WS_PB); const float* wdec = F.out; const float* asig = F.out + (size_t)M * 512; float* yraw = (float*)(F.ws + WS_HB);
    const float* mu = F.in[3]; const float* k_k = F.in[9]; const float* k_a = F.in[10];
    const int lane = F.lane, vl = lane >> 3, kq = lane & 7, v = F.wave * 8 + vl, ch0 = h * 64 + kq * 8;
    float S[8], mur[8], muk[8], kkp[8], kap[8], pr[8], pk[8];
#pragma unroll
    for (int j = 0; j < 8; ++j) { S[j] = 0.f; mur[j] = mu[C_R + ch0 + j]; muk[j] = mu[C_K + ch0 + j]; kkp[j] = k_k[ch0 + j]; kap[j] = k_a[ch0 + j]; pr[j] = 0.f; pk[j] = 0.f; }
    const float muv = mu[C_V + h * 64 + v]; float pv = 0.f;
    const size_t row0 = (size_t)b * T;
    bf16x8 nr = *(const bf16x8*)(PB + row0 * NMAIN + C_R + ch0), nk = *(const bf16x8*)(PB + row0 * NMAIN + C_K + ch0);
    bf16 nv = PB[row0 * NMAIN + C_V + h * 64 + v];
    f32x4 nw0 = *(const f32x4*)(wdec + row0 * 512 + ch0), nw1 = *(const f32x4*)(wdec + row0 * 512 + ch0 + 4);
    f32x4 na0 = *(const f32x4*)(asig + row0 * 512 + ch0), na1 = *(const f32x4*)(asig + row0 * 512 + ch0 + 4);
    for (int t = 0; t < T; ++t) {
        const size_t row = row0 + t;
        const bf16x8 cr8 = nr, ck8 = nk; const bf16 cvb = nv; const f32x4 w0 = nw0, w1 = nw1, a0 = na0, a1 = na1;
        if (t + 1 < T) { const size_t rn = row + 1;
            nr = *(const bf16x8*)(PB + rn * NMAIN + C_R + ch0); nk = *(const bf16x8*)(PB + rn * NMAIN + C_K + ch0); nv = PB[rn * NMAIN + C_V + h * 64 + v];
            nw0 = *(const f32x4*)(wdec + rn * 512 + ch0); nw1 = *(const f32x4*)(wdec + rn * 512 + ch0 + 4);
            na0 = *(const f32x4*)(asig + rn * 512 + ch0); na1 = *(const f32x4*)(asig + rn * 512 + ch0 + 4); }
        float r[8], k[8], kk[8], wd[8], as[8];
        float ss = 0.f;
#pragma unroll
        for (int j = 0; j < 8; ++j) { const float cr = bf2f((bf16)cr8[j]), ck = bf2f((bf16)ck8[j]);
            r[j] = cr + mur[j] * (pr[j] - cr); k[j] = ck + muk[j] * (pk[j] - ck); pr[j] = cr; pk[j] = ck;
            wd[j] = j < 4 ? w0[j] : w1[j - 4]; as[j] = j < 4 ? a0[j] : a1[j - 4];
            kk[j] = k[j] * kkp[j]; ss += kk[j] * kk[j]; }
        const float cv = bf2f(cvb); const float vv = cv + muv * (pv - cv); pv = cv;
        ss += __shfl_xor(ss, 1); ss += __shfl_xor(ss, 2); ss += __shfl_xor(ss, 4);
        const float inv = 1.0f / fmaxf(sqrtf(ss), 1e-12f);
        float sa = 0.f;
#pragma unroll
        for (int j = 0; j < 8; ++j) { kk[j] *= inv; sa += S[j] * (-kk[j]); }
        sa += __shfl_xor(sa, 1); sa += __shfl_xor(sa, 2); sa += __shfl_xor(sa, 4);
        float y = 0.f;
#pragma unroll
        for (int j = 0; j < 8; ++j) { const float km = k[j] * (1.0f + (as[j] - 1.0f) * kap[j]);
            S[j] = S[j] * wd[j] + sa * (kk[j] * as[j]) + vv * km; y += S[j] * r[j]; }
        y += __shfl_xor(y, 1); y += __shfl_xor(y, 2); y += __shfl_xor(y, 4);
        if (kq == 0) yraw[row * 512 + h * 64 + v] = y;
    }
}
__device__ __forceinline__ void p3b_rwkv_out_naive(Frame& F) {
    const int gw = F.vcu * NWAVES + F.wave, NGW = F.G * NWAVES, lane = F.lane;
    const bf16* PB = (const bf16*)(F.ws + WS_PB); const float* asig = F.out + (size_t)M * 512; const float* yraw = (const float*)(F.ws + WS_HB); const float* gg = (const float*)(F.ws + WS_G);
    bf16* Y = (bf16*)(F.ws + WS_XB);
    const float* mu = F.in[3]; const float* k_a = F.in[10]; const float* r_k = F.in[11]; const float* lnw = F.in[12]; const float* lnb = F.in[13];
    for (int it = gw; it < M * 8; it += NGW) {
        const int row = it >> 3, h = it & 7, ch = h * 64 + lane;
        const float yv = yraw[(size_t)row * 512 + ch];
        const float mean = wave_sum(yv) * (1.0f / 64.0f); const float d = yv - mean; const float var = wave_sum(d * d) * (1.0f / 64.0f);
        const float yn = d * (1.0f / sqrtf(var + GN_EPS)) * lnw[ch] + lnb[ch];
        const bool first = (row % T) == 0;
        const float cr = bf2f(PB[(size_t)row * NMAIN + C_R + ch]), ck = bf2f(PB[(size_t)row * NMAIN + C_K + ch]), cv = bf2f(PB[(size_t)row * NMAIN + C_V + ch]);
        const float qr = first ? 0.f : bf2f(PB[(size_t)(row - 1) * NMAIN + C_R + ch]), qk = first ? 0.f : bf2f(PB[(size_t)(row - 1) * NMAIN + C_K + ch]), qv = first ? 0.f : bf2f(PB[(size_t)(row - 1) * NMAIN + C_V + ch]);
        const float r = cr + mu[C_R + ch] * (qr - cr), k = ck + mu[C_K + ch] * (qk - ck), vv = cv + mu[C_V + ch] * (qv - cv);
        const float as = asig[(size_t)row * 512 + ch]; const float km = k * (1.0f + (as - 1.0f) * k_a[ch]);
        const float bonus = wave_sum(r * km * r_k[ch]) * vv;
        const float o = (yn + bonus) * gg[(size_t)row * 512 + ch];
        Y[(size_t)row * D + ch] = (bf16)f2bf(o);
    }
}
__device__ __forceinline__ float dot64_lds_bf16row(const LAS float* qs, const bf16* krow) {
    float s = 0.f;
#pragma unroll
    for (int i = 0; i < 8; ++i) { const bf16x8 kv = *(const bf16x8*)(krow + 8 * i); const f32x4 q0 = *(const LAS f32x4*)(qs + 8 * i), q1 = *(const LAS f32x4*)(qs + 8 * i + 4);
        s += q0[0] * bf2f((bf16)kv[0]) + q0[1] * bf2f((bf16)kv[1]) + q0[2] * bf2f((bf16)kv[2]) + q0[3] * bf2f((bf16)kv[3]);
        s += q1[0] * bf2f((bf16)kv[4]) + q1[1] * bf2f((bf16)kv[5]) + q1[2] * bf2f((bf16)kv[6]) + q1[3] * bf2f((bf16)kv[7]); }
    return s;
}
__device__ __forceinline__ float dot64_lds_f32row(const LAS float* qs, const float* krow) {
    float s = 0.f;
#pragma unroll
    for (int i = 0; i < 16; ++i) { const f32x4 kv = *(const f32x4*)(krow + 4 * i); const f32x4 q = *(const LAS f32x4*)(qs + 4 * i); s += q[0] * kv[0] + q[1] * kv[1] + q[2] * kv[2] + q[3] * kv[3]; }
    return s;
}
#define WAVE_LDS_FENCE() asm volatile("s_waitcnt lgkmcnt(0)" ::: "memory")
__device__ __forceinline__ void nsa_token_naive(Frame& F, int b, int hk, int t, LAS float* wl) {
    LAS float* qs = wl; LAS float* pbuf = wl + 64; LAS float* ocb = wl + 64 + 1024; LAS int* seli = (LAS int*)(wl + 64 + 1024 + 256);
    const int lane = F.lane; const size_t row = (size_t)b * T + t; const int cur = t >> 6;
    const bf16* PB = (const bf16*)(F.ws + WS_PB); const float* CMPK = (const float*)(F.ws + WS_CMP) + (size_t)((0 * 2 + b) * 2 + hk) * NCMPP * 64;
    const float* CMPV = (const float*)(F.ws + WS_CMP) + (size_t)((1 * 2 + b) * 2 + hk) * NCMPP * 64;
    const float* gates = (const float*)(F.ws + WS_GATES); bf16* Y = (bf16*)(F.ws + WS_XB);
    const int nvc = t >= 31 ? ((t - 31) >> 4) + 1 : 0;
    float imp0 = 0.f, imp1 = 0.f;
    for (int g = 0; g < 4; ++g) {
        const int h = hk * 4 + g; const float slope = exp2f(-(float)(h + 1));
        WAVE_LDS_FENCE();
        qs[lane] = bf2f(PB[row * NMAIN + C_Q + h * 64 + lane]) * 0.125f;
        WAVE_LDS_FENCE();
        float o = 0.f;
        if (nvc > 0) {
            float m = -INFINITY;
            for (int c = lane; c < nvc; c += 64) { const float s = dot64_lds_f32row(qs, CMPK + (size_t)c * 64) - slope * (float)(t - (16 * c + 31)); pbuf[c] = s; m = fmaxf(m, s); }
            m = wave_max(m); float l = 0.f;
            for (int c = lane; c < nvc; c += 64) { const float e = expf(pbuf[c] - m); pbuf[c] = e; l += e; }
            l = wave_sum(l); const float inv = 1.0f / l;
            for (int c = lane; c < nvc; c += 64) pbuf[c] *= inv;
            WAVE_LDS_FENCE();
#pragma unroll
            for (int hh = 0; hh < 2; ++hh) { const int n = lane + 64 * hh; float s = 0.f;
#pragma unroll
                for (int j = -1; j < 4; ++j) { const int c = 4 * n + j; if (c >= 0 && c < nvc) s += pbuf[c] * ((j == -1 || j == 3) ? 1.f : 2.f); }
                if (hh == 0) imp0 += s; else imp1 += s; }
            for (int c = 0; c < nvc; ++c) o += pbuf[c] * CMPV[(size_t)c * 64 + lane];
        }
        ocb[g * 64 + lane] = o;
    }
    {
        float v0 = (lane > cur) ? NEGV : ((lane == 0 || lane == cur || lane == cur - 1) ? BIGV : imp0);
        const int n1 = lane + 64;
        float v1 = (n1 > cur) ? NEGV : ((n1 == cur || n1 == cur - 1) ? BIGV : imp1);
        for (int it = 0; it < 16; ++it) {
            const float m = wave_max(fmaxf(v0, v1));
            const unsigned long long b0 = __ballot(v0 == m);
            int idx;
            if (b0) { idx = __builtin_ctzll(b0); if (lane == idx) v0 = -INFINITY; }
            else { const unsigned long long b1 = __ballot(v1 == m); idx = 64 + __builtin_ctzll(b1); if (lane == idx - 64) v1 = -INFINITY; }
            if (lane == 0) seli[it] = (m > 0.5f * NEGV) ? idx : -1;
        }
        WAVE_LDS_FENCE();
    }
    for (int g = 0; g < 4; ++g) {
        const int h = hk * 4 + g; const float slope = exp2f(-(float)(h + 1));
        WAVE_LDS_FENCE();
        qs[lane] = bf2f(PB[row * NMAIN + C_Q + h * 64 + lane]) * 0.125f;
        WAVE_LDS_FENCE();
        float os = 0.f;
        {
            float m = -INFINITY;
            for (int sl = 0; sl < 16; ++sl) { const int idx = seli[sl]; float s = -INFINITY;
                if (idx >= 0) { const int pos = idx * 64 + lane; if (pos <= t) s = dot64_lds_bf16row(qs, PB + ((size_t)b * T + pos) * NMAIN + C_KS + hk * 64) - slope * (float)(t - pos); }
                pbuf[sl * 64 + lane] = s; m = fmaxf(m, s); }
            m = wave_max(m); float l = 0.f;
            for (int sl = 0; sl < 16; ++sl) { const float e = expf(pbuf[sl * 64 + lane] - m); pbuf[sl * 64 + lane] = e; l += e; }
            l = wave_sum(l); const float inv = 1.0f / l;
            WAVE_LDS_FENCE();
            for (int sl = 0; sl < 16; ++sl) { const int idx = seli[sl]; if (idx < 0) continue;
                for (int j = 0; j < 64; ++j) { const int pos = idx * 64 + j; if (pos > t) break; os += pbuf[sl * 64 + j] * bf2f(PB[((size_t)b * T + pos) * NMAIN + C_VS + hk * 64 + lane]); } }
            os *= inv;
        }
        WAVE_LDS_FENCE();
        float ow = 0.f;
        {
            float m = -INFINITY;
            for (int i = lane; i < 512; i += 64) { const int pos = t - 511 + i; float s = -INFINITY;
                if (pos >= 0) s = dot64_lds_bf16row(qs, PB + ((size_t)b * T + pos) * NMAIN + C_KW + hk * 64) - slope * (float)(t - pos);
                pbuf[i] = s; m = fmaxf(m, s); }
            m = wave_max(m); float l = 0.f;
            for (int i = lane; i < 512; i += 64) { const float e = expf(pbuf[i] - m); pbuf[i] = e; l += e; }
            l = wave_sum(l); const float inv = 1.0f / l;
            WAVE_LDS_FENCE();
            for (int i = 0; i < 512; ++i) { const int pos = t - 511 + i; if (pos < 0) continue; ow += pbuf[i] * bf2f(PB[((size_t)b * T + pos) * NMAIN + C_VW + hk * 64 + lane]); }
            ow *= inv;
        }
        const float g0 = gates[row * 24 + h * 3 + 0], g1 = gates[row * 24 + h * 3 + 1], g2 = gates[row * 24 + h * 3 + 2];
        Y[row * D + 512 + h * 64 + lane] = (bf16)f2bf(g0 * ocb[g * 64 + lane] + g1 * os + g2 * ow);
    }
}
__device__ __forceinline__ void p3_nsa_naive(Frame& F, int first_wg, int nwg) {
    LAS float* wl = (LAS float*)(F.lds + RING_OFF) + F.wave * 2048;
    const int me = (int)blockIdx.x - first_wg; if (me < 0) return;
    for (int it = me; it < 4 * (T / 8); it += nwg) {
        const int bh = it / (T / 8), tg = it % (T / 8); const int b = bh >> 1, hk = bh & 1;
        nsa_token_naive(F, b, hk, tg * 8 + F.wave, wl);
    }
}
__device__ __forceinline__ void p7_final_norm(Frame& F) {
    const int gw = F.vcu * NWAVES + F.wave, NGW = F.G * NWAVES;
    const float* ssq3 = (const float*)(F.ctl + CW_SSQ3); const float* gf = F.in[25];
    f32x4 gv[4];
#pragma unroll
    for (int j = 0; j < 4; ++j) gv[j] = *((const f32x4*)gf + F.lane + 64 * j);
    for (int m = gw; m < M; m += NGW) {
        const float rs = 1.0f / sqrtf(ssq3[m] * (1.0f / D) + NORM_EPS);
        f32x4* xr = (f32x4*)(F.out + (size_t)m * D) + F.lane;
#pragma unroll
        for (int j = 0; j < 4; ++j) { f32x4 v = xr[64 * j]; v = v * rs * gv[j]; xr[64 * j] = v; }
    }
}

typedef float f32x16 __attribute__((ext_vector_type(16)));
typedef float f32x2_t __attribute__((ext_vector_type(2))); typedef __bf16 bf16x2_t __attribute__((ext_vector_type(2)));
__device__ __forceinline__ unsigned cvtpk(float lo, float hi) { f32x2_t v = {lo, hi}; bf16x2_t b = __builtin_convertvector(v, bf16x2_t); return __builtin_bit_cast(unsigned, b); }
typedef unsigned u32x2 __attribute__((ext_vector_type(2)));
constexpr int XTRA_OFF = RING_BYTES + 1024;
#define RSLOT(i) (L + (i) * 8192)
__device__ __forceinline__ bf16x8 rfrag(const LAS unsigned char* S, int R0, int ks, int lane) {
    const int row = R0 + (lane & 15), ch = 4 * ks + (lane >> 4);
    return *(const LAS bf16x8*)(S + row * 128 + ((ch ^ (row & 7)) << 4));
}
__device__ __forceinline__ void mm64(f32x4 (&acc)[2], const LAS unsigned char* X, const LAS unsigned char* Y, int wave, int lane) {
#pragma unroll
    for (int ks = 0; ks < 2; ++ks) { const bf16x8 a = rfrag(X, 16 * (wave >> 1), ks, lane);
#pragma unroll
        for (int j = 0; j < 2; ++j) { const bf16x8 b = rfrag(Y, 16 * (2 * (wave & 1) + j), ks, lane); acc[j] = __builtin_amdgcn_mfma_f32_16x16x32_bf16(a, b, acc[j], 0, 0, 0); } }
}
__device__ __forceinline__ void st_row(LAS unsigned char* O, const f32x4 v, int m0, int n) {
    u32x2 w; w.x = cvtpk(v[0], v[1]); w.y = cvtpk(v[2], v[3]);
    *(LAS u32x2*)(O + n * 128 + ((((m0 >> 3) ^ (n & 7)) << 4) | ((m0 & 7) << 1))) = w;
}
__device__ __forceinline__ void st_tr(LAS unsigned char* O, const f32x4 v, int m0, int n) {
#pragma unroll
    for (int r = 0; r < 4; ++r) { const int m = m0 + r; *(LAS unsigned short*)(O + m * 128 + ((((n >> 3) ^ (m & 7)) << 4) | ((n & 7) << 1))) = (unsigned short)f2bf(v[r]); }
}
__device__ __forceinline__ f32x4 ld_row(const LAS unsigned char* O, int m0, int n) {
    const u32x2 w = *(const LAS u32x2*)(O + n * 128 + ((((m0 >> 3) ^ (n & 7)) << 4) | ((m0 & 7) << 1)));
    f32x4 v; v[0] = __builtin_bit_cast(float, w.x << 16); v[1] = __builtin_bit_cast(float, w.x & 0xffff0000u); v[2] = __builtin_bit_cast(float, w.y << 16); v[3] = __builtin_bit_cast(float, w.y & 0xffff0000u); return v;
}
__device__ __forceinline__ void st_fragmajor(unsigned char* G, const f32x4 v, int m0, int R) {
    const int kk = m0 & 31, s = kk >> 4, jj = (kk >> 3) & 1, hh = (kk >> 2) & 1, lanep = (R & 31) + 32 * hh;
    u32x2 w; w.x = cvtpk(v[0], v[1]); w.y = cvtpk(v[2], v[3]);
    *(u32x2*)(G + ((((R >> 5) * 2 + (m0 >> 5)) * 2 + s) * 64 + lanep) * 16 + jj * 8) = w;
}
__device__ __forceinline__ void st_clayout(unsigned char* G, const f32x4 v, int m0, int n) {
    const int mm = m0 & 31, g = mm >> 3, hh = (mm >> 2) & 1, lanep = (n & 31) + 32 * hh;
    u32x2 w; w.x = cvtpk(v[0], v[1]); w.y = cvtpk(v[2], v[3]);
    *(u32x2*)(G + (((m0 >> 5) * 2 + (n >> 5)) * 64 + lanep) * 32 + g * 8) = w;
}
__device__ __forceinline__ void ld8f(float (&o)[8], const float* p) { const f32x4 a = *(const f32x4*)p, b = *(const f32x4*)(p + 4); o[0] = a[0]; o[1] = a[1]; o[2] = a[2]; o[3] = a[3]; o[4] = b[0]; o[5] = b[1]; o[6] = b[2]; o[7] = b[3]; }
__device__ __forceinline__ void ld8bf(float (&o)[8], const bf16* p) { const bf16x8 a = *(const bf16x8*)p;
#pragma unroll
    for (int j = 0; j < 8; ++j) o[j] = bf2f((bf16)a[j]); }
__device__ __forceinline__ v4u pack8(const float (&x)[8]) { v4u o; o.x = cvtpk(x[0], x[1]); o.y = cvtpk(x[2], x[3]); o.z = cvtpk(x[4], x[5]); o.w = cvtpk(x[6], x[7]); return o; }

__device__ __forceinline__ void p2_rwkv_chunk(Frame& F) {
    LAS unsigned char* L = F.lds + RING_OFF;
    LAS float* WPRE = (LAS float*)RSLOT(12); LAS float* APRE = (LAS float*)RSLOT(14);
    LAS float* SEG = (LAS float*)(F.lds + XTRA_OFF); LAS float* LWC = SEG + 512;
    const int tid = F.tid, lane = F.lane, wave = F.wave;
    const int t = tid >> 3, kq = tid & 7;
    const int mt = wave >> 1, ntb = 2 * (wave & 1), q = lane >> 4, l15 = lane & 15;
    const bf16* PB = (const bf16*)(F.ws + WS_PB);
    const bf16* W2T = (const bf16*)(F.ws + WS_LORA); const bf16* A2T = W2T + 512 * 64; const bf16* G2T = A2T + 512 * 64;
    const float* mu = F.in[3];
    float* GG = (float*)(F.ws + WS_G); bf16* VS = (bf16*)(F.ws + WS_VS); float* BON = (float*)(F.ws + WS_BONUS);
    for (int it = F.vcu; it < BATCH * 8 * (T / 64); it += F.G) {
        const int chunk = it & 127, h = (it >> 7) & 7, b = it >> 10;
        const int row0 = b * T + chunk * 64;
        for (int idx = tid; idx < 64 * 32; idx += NWAVES * 64) {
            const int tok = idx >> 5, c8 = idx & 31; const int row = row0 + tok; const int col = C_DW + 8 * c8;
            float p[8], pp[8], m8[8], o[8]; ld8bf(p, PB + (size_t)row * NMAIN + col); ld8f(m8, mu + col);
            if ((row % T) != 0) ld8bf(pp, PB + (size_t)(row - 1) * NMAIN + col); else {
#pragma unroll
                for (int j = 0; j < 8; ++j) pp[j] = 0.f; }
#pragma unroll
            for (int j = 0; j < 8; ++j) { const float ps = p[j] + m8[j] * (pp[j] - p[j]); o[j] = (c8 < 8) ? tanhf(ps) : (c8 < 16 ? ps : sigmoidf_(ps)); }
            *(LAS v4u*)(RSLOT(8 + (c8 >> 3)) + tok * 128 + (((c8 & 7) ^ (tok & 7)) << 4)) = pack8(o);
        }
        __syncthreads();
        {
            f32x4 accw[2], acca[2], accg[2];
#pragma unroll
            for (int j = 0; j < 2; ++j) { accw[j] = (f32x4){0.f, 0.f, 0.f, 0.f}; acca[j] = accw[j]; accg[j] = accw[j]; }
            const int mr = h * 64 + 16 * mt + l15;
#pragma unroll
            for (int ks = 0; ks < 2; ++ks) { const bf16x8 aw = *(const bf16x8*)(W2T + (size_t)mr * 64 + 32 * ks + 8 * q), aa = *(const bf16x8*)(A2T + (size_t)mr * 64 + 32 * ks + 8 * q);
#pragma unroll
                for (int j = 0; j < 2; ++j) { const bf16x8 b1 = rfrag(RSLOT(8), 16 * (ntb + j), ks, lane), b2 = rfrag(RSLOT(9), 16 * (ntb + j), ks, lane);
                    accw[j] = __builtin_amdgcn_mfma_f32_16x16x32_bf16(aw, b1, accw[j], 0, 0, 0); acca[j] = __builtin_amdgcn_mfma_f32_16x16x32_bf16(aa, b2, acca[j], 0, 0, 0); } }
#pragma unroll
            for (int ks = 0; ks < 4; ++ks) { const bf16x8 ag = *(const bf16x8*)(G2T + (size_t)mr * 128 + 32 * ks + 8 * q);
#pragma unroll
                for (int j = 0; j < 2; ++j) { const bf16x8 b3 = rfrag(RSLOT(10 + (ks >> 1)), 16 * (ntb + j), ks & 1, lane); accg[j] = __builtin_amdgcn_mfma_f32_16x16x32_bf16(ag, b3, accg[j], 0, 0, 0); } }
            const int m0 = 16 * mt + 4 * q;
#pragma unroll
            for (int j = 0; j < 2; ++j) { const int n = 16 * (ntb + j) + l15;
                *(LAS f32x4*)(WPRE + n * 64 + m0) = accw[j]; *(LAS f32x4*)(APRE + n * 64 + m0) = acca[j];
                *(f32x4*)(GG + (size_t)(row0 + n) * 512 + h * 64 + m0) = accg[j]; }
        }
        __syncthreads();
        float r8[8], km8[8], v8[8], a8[8], b8[8], lg8[8];
        {
            const int row = row0 + t, ch = h * 64 + 8 * kq; const bool first = (row % T) == 0;
            const bf16* prow = PB + (size_t)row * NMAIN; const bf16* qrow = PB + (size_t)(first ? row : row - 1) * NMAIN;
            { float c[8], p[8], m[8]; ld8bf(c, prow + C_R + ch); ld8bf(p, qrow + C_R + ch); ld8f(m, mu + C_R + ch);
#pragma unroll
              for (int j = 0; j < 8; ++j) { const float pj = first ? 0.f : p[j]; r8[j] = c[j] + m[j] * (pj - c[j]); } }
            asm volatile("" ::: "memory");
            { float c[8], p[8], m[8]; ld8bf(c, prow + C_V + ch); ld8bf(p, qrow + C_V + ch); ld8f(m, mu + C_V + ch);
#pragma unroll
              for (int j = 0; j < 8; ++j) { const float pj = first ? 0.f : p[j]; v8[j] = c[j] + m[j] * (pj - c[j]); }
              *(v4u*)(VS + (size_t)row * 512 + ch) = pack8(v8); }
            asm volatile("" ::: "memory");
            float kr[8];
            { float c[8], p[8], m[8]; ld8bf(c, prow + C_K + ch); ld8bf(p, qrow + C_K + ch); ld8f(m, mu + C_K + ch);
#pragma unroll
              for (int j = 0; j < 8; ++j) { const float pj = first ? 0.f : p[j]; kr[j] = c[j] + m[j] * (pj - c[j]); } }
            asm volatile("" ::: "memory");
            { float w0v[8]; ld8f(w0v, F.in[4] + ch); const f32x4 x0 = *(const LAS f32x4*)(WPRE + t * 64 + 8 * kq), x1 = *(const LAS f32x4*)(WPRE + t * 64 + 8 * kq + 4);
#pragma unroll
              for (int j = 0; j < 8; ++j) { const float wp = j < 4 ? x0[j & 3] : x1[j & 3]; const float wl = -softplusf_(-(w0v[j] + wp)) - 0.5f; lg8[j] = -expf(wl); }
              *(LAS f32x4*)(WPRE + t * 64 + 8 * kq) = (f32x4){lg8[0], lg8[1], lg8[2], lg8[3]}; *(LAS f32x4*)(WPRE + t * 64 + 8 * kq + 4) = (f32x4){lg8[4], lg8[5], lg8[6], lg8[7]}; }
            asm volatile("" ::: "memory");
            float as8[8];
            { float a0v[8]; ld8f(a0v, F.in[6] + ch); const f32x4 y0 = *(const LAS f32x4*)(APRE + t * 64 + 8 * kq), y1 = *(const LAS f32x4*)(APRE + t * 64 + 8 * kq + 4);
#pragma unroll
              for (int j = 0; j < 8; ++j) { const float ap = j < 4 ? y0[j & 3] : y1[j & 3]; as8[j] = sigmoidf_(a0v[j] + ap); } }
            asm volatile("" ::: "memory");
            float kk[8], ss = 0.f;
            { float kkp[8]; ld8f(kkp, F.in[9] + ch);
#pragma unroll
              for (int j = 0; j < 8; ++j) { kk[j] = kr[j] * kkp[j]; ss += kk[j] * kk[j]; } }
            ss += __shfl_xor(ss, 1); ss += __shfl_xor(ss, 2); ss += __shfl_xor(ss, 4);
            const float inv = 1.0f / fmaxf(sqrtf(ss), 1e-12f); float bon = 0.f;
            { float kap[8], rkp[8]; ld8f(kap, F.in[10] + ch); ld8f(rkp, F.in[11] + ch);
#pragma unroll
              for (int j = 0; j < 8; ++j) { kk[j] *= inv; km8[j] = kr[j] * (1.0f + (as8[j] - 1.0f) * kap[j]); a8[j] = -kk[j]; b8[j] = kk[j] * as8[j]; bon += r8[j] * km8[j] * rkp[j]; } }
            bon += __shfl_xor(bon, 1); bon += __shfl_xor(bon, 2); bon += __shfl_xor(bon, 4);
            if (kq == 0) BON[(size_t)row * 8 + h] = bon;
        }
        __syncthreads();
        {
            const int k = tid & 63, seg = tid >> 6; float c[8], run = 0.f;
#pragma unroll
            for (int i = 0; i < 8; ++i) { run += WPRE[(8 * seg + i) * 64 + k]; c[i] = run; }
            SEG[seg * 64 + k] = run;
            __syncthreads();
            float pre = 0.f;
            for (int s2 = 0; s2 < seg; ++s2) pre += SEG[s2 * 64 + k];
#pragma unroll
            for (int i = 0; i < 8; ++i) WPRE[(8 * seg + i) * 64 + k] = pre + c[i];
            if (seg == 7) LWC[k] = pre + c[7];
        }
        __syncthreads();
        {
            float lw[8], At[8], Bt[8], Kt[8], Rt[8], Bh[8], Kh[8];
            { const f32x4 x0 = *(const LAS f32x4*)(WPRE + t * 64 + 8 * kq), x1 = *(const LAS f32x4*)(WPRE + t * 64 + 8 * kq + 4);
#pragma unroll
              for (int j = 0; j < 4; ++j) { lw[j] = x0[j]; lw[4 + j] = x1[j]; } }
#pragma unroll
            for (int j = 0; j < 8; ++j) { const float lc = LWC[8 * kq + j]; const float eA = expf(lw[j] - lg8[j]), eN = expf(-lw[j]), eP = expf(lw[j]), eC = expf(lc - lw[j]);
                At[j] = a8[j] * eA; Bt[j] = b8[j] * eN; Kt[j] = km8[j] * eN; Rt[j] = r8[j] * eP; Bh[j] = b8[j] * eC; Kh[j] = km8[j] * eC; }
            const int o16 = t * 128 + ((kq ^ (t & 7)) << 4);
            *(LAS v4u*)(RSLOT(0) + o16) = pack8(At); *(LAS v4u*)(RSLOT(1) + o16) = pack8(Bt); *(LAS v4u*)(RSLOT(2) + o16) = pack8(Kt); *(LAS v4u*)(RSLOT(3) + o16) = pack8(Rt);
#pragma unroll
            for (int j = 0; j < 8; ++j) { const int kch = 8 * kq + j; const int o2 = kch * 128 + ((((t >> 3) ^ j) << 4) | ((t & 7) << 1));
                *(LAS unsigned short*)(RSLOT(4) + o2) = (unsigned short)f2bf(At[j]); *(LAS unsigned short*)(RSLOT(5) + o2) = (unsigned short)f2bf(v8[j]);
                *(LAS unsigned short*)(RSLOT(6) + o2) = (unsigned short)f2bf(Bh[j]); *(LAS unsigned short*)(RSLOT(7) + o2) = (unsigned short)f2bf(Kh[j]); }
        }
        __syncthreads();
        const int m0 = 16 * mt + 4 * q;
        {
            f32x4 aN[2], aKa[2], aBr[2], aKr[2];
#pragma unroll
            for (int j = 0; j < 2; ++j) { aN[j] = (f32x4){0.f, 0.f, 0.f, 0.f}; aKa[j] = aN[j]; aBr[j] = aN[j]; aKr[j] = aN[j]; }
#pragma unroll
            for (int ks = 0; ks < 2; ++ks) { const bf16x8 xa = rfrag(RSLOT(0), 16 * mt, ks, lane), xb = rfrag(RSLOT(1), 16 * mt, ks, lane), xk = rfrag(RSLOT(2), 16 * mt, ks, lane);
#pragma unroll
                for (int j = 0; j < 2; ++j) { const bf16x8 yb = rfrag(RSLOT(1), 16 * (ntb + j), ks, lane), yk = rfrag(RSLOT(2), 16 * (ntb + j), ks, lane), yr = rfrag(RSLOT(3), 16 * (ntb + j), ks, lane);
                    aN[j] = __builtin_amdgcn_mfma_f32_16x16x32_bf16(xa, yb, aN[j], 0, 0, 0); aKa[j] = __builtin_amdgcn_mfma_f32_16x16x32_bf16(xa, yk, aKa[j], 0, 0, 0);
                    aBr[j] = __builtin_amdgcn_mfma_f32_16x16x32_bf16(xb, yr, aBr[j], 0, 0, 0); aKr[j] = __builtin_amdgcn_mfma_f32_16x16x32_bf16(xk, yr, aKr[j], 0, 0, 0); } }
#pragma unroll
            for (int j = 0; j < 2; ++j) { const int n = 16 * (ntb + j) + l15; f32x4 vN, vT, vKa, vBr, vKr;
#pragma unroll
                for (int r = 0; r < 4; ++r) { const int m = m0 + r; vN[r] = (n < m) ? aN[j][r] : 0.f; vT[r] = vN[r] + ((n == m) ? 1.f : 0.f); vKa[r] = (n < m) ? aKa[j][r] : 0.f;
                    vBr[r] = (m <= n) ? aBr[j][r] : 0.f; vKr[r] = (m <= n) ? aKr[j][r] : 0.f; }
                st_row(RSLOT(8), vN, m0, n); st_tr(RSLOT(9), vN, m0, n); st_row(RSLOT(10), vT, m0, n); st_row(RSLOT(11), vKa, m0, n); st_row(RSLOT(12), vBr, m0, n); st_row(RSLOT(13), vKr, m0, n); }
        }
        __syncthreads();
#define SQUARE(XS, YS, OROW, OTR) { f32x4 ac[2] = {(f32x4){0.f, 0.f, 0.f, 0.f}, (f32x4){0.f, 0.f, 0.f, 0.f}}; mm64(ac, RSLOT(XS), RSLOT(YS), wave, lane); \
            _Pragma("unroll") for (int j = 0; j < 2; ++j) { const int n = 16 * (ntb + j) + l15; if (OROW >= 0) st_row(RSLOT(OROW < 0 ? 0 : OROW), ac[j], m0, n); st_tr(RSLOT(OTR), ac[j], m0, n); } }
#define TUPD(XS, YS, OUT, TRANSP) { f32x4 ac[2]; _Pragma("unroll") for (int j = 0; j < 2; ++j) ac[j] = ld_row(RSLOT(YS), m0, 16 * (ntb + j) + l15); mm64(ac, RSLOT(XS), RSLOT(YS), wave, lane); \
            _Pragma("unroll") for (int j = 0; j < 2; ++j) { const int n = 16 * (ntb + j) + l15; if (TRANSP) st_tr(RSLOT(OUT), ac[j], m0, n); else st_row(RSLOT(OUT), ac[j], m0, n); } }
        SQUARE(9, 8, 0, 1);
        __syncthreads();
        TUPD(1, 10, 14, false); SQUARE(1, 0, 8, 9);
        __syncthreads();
        TUPD(9, 14, 10, false); SQUARE(9, 8, 0, 1);
        __syncthreads();
        TUPD(1, 10, 14, false); SQUARE(1, 0, 8, 9);
        __syncthreads();
        TUPD(9, 14, 10, false); SQUARE(9, 8, -1, 1);
        __syncthreads();
        TUPD(1, 10, 14, true);
        __syncthreads();
        { f32x4 ac[2] = {(f32x4){0.f, 0.f, 0.f, 0.f}, (f32x4){0.f, 0.f, 0.f, 0.f}}, ad[2] = {(f32x4){0.f, 0.f, 0.f, 0.f}, (f32x4){0.f, 0.f, 0.f, 0.f}};
          mm64(ac, RSLOT(14), RSLOT(4), wave, lane); mm64(ad, RSLOT(11), RSLOT(14), wave, lane);
#pragma unroll
          for (int j = 0; j < 2; ++j) { const int n = 16 * (ntb + j) + l15; st_row(RSLOT(0), ac[j], m0, n); st_row(RSLOT(2), ad[j], m0, n); } }
        __syncthreads();
        { f32x4 ac[2] = {(f32x4){0.f, 0.f, 0.f, 0.f}, (f32x4){0.f, 0.f, 0.f, 0.f}};
          mm64(ac, RSLOT(2), RSLOT(5), wave, lane);
#pragma unroll
          for (int j = 0; j < 2; ++j) st_row(RSLOT(8), ac[j], m0, 16 * (ntb + j) + l15); }
        __syncthreads();
        {
            unsigned char* rec = (unsigned char*)F.out + (size_t)it * 32768;
            f32x4 aP[2], aQ[2], aG[2], aH[2];
#pragma unroll
            for (int j = 0; j < 2; ++j) { aP[j] = (f32x4){0.f, 0.f, 0.f, 0.f}; aQ[j] = aP[j]; aH[j] = aP[j]; aG[j] = ld_row(RSLOT(3), m0, 16 * (ntb + j) + l15); }
            mm64(aP, RSLOT(0), RSLOT(6), wave, lane);
            mm64(aQ, RSLOT(6), RSLOT(8), wave, lane); mm64(aQ, RSLOT(7), RSLOT(5), wave, lane);
            mm64(aG, RSLOT(0), RSLOT(12), wave, lane);
            mm64(aH, RSLOT(8), RSLOT(12), wave, lane); mm64(aH, RSLOT(5), RSLOT(13), wave, lane);
#pragma unroll
            for (int j = 0; j < 2; ++j) { const int n = 16 * (ntb + j) + l15;
#pragma unroll
                for (int r = 0; r < 4; ++r) if (m0 + r == n) aP[j][r] += expf(LWC[n]);
                st_fragmajor(rec, aP[j], m0, n); st_clayout(rec + 8192, aQ[j], m0, n); st_fragmajor(rec + 16384, aG[j], m0, n); st_clayout(rec + 24576, aH[j], m0, n); }
        }
        __syncthreads();
    }
}
__device__ __forceinline__ void p3_rwkv_scan_mfma(Frame& F, int bh, int ntile) {
    const int lane = F.lane;
    const unsigned char* recs = (const unsigned char*)F.out + (size_t)bh * 128 * 32768;
    unsigned char* stash = F.ws + WS_HB + (size_t)bh * 128 * 8192 + ntile * 4096;
    f32x16 z[2];
#pragma unroll
    for (int i = 0; i < 16; ++i) { z[0][i] = 0.f; z[1][i] = 0.f; }
    bf16x8 pa[2][4]; v4u qc[2][2];
    { const unsigned char* rec = recs;
#pragma unroll
      for (int mtile = 0; mtile < 2; ++mtile) {
#pragma unroll
          for (int ks = 0; ks < 4; ++ks) pa[mtile][ks] = *(const bf16x8*)(rec + ((mtile * 4 + ks) * 64 + lane) * 16);
          qc[mtile][0] = *(const v4u*)(rec + 8192 + ((mtile * 2 + ntile) * 64 + lane) * 32); qc[mtile][1] = *(const v4u*)(rec + 8192 + ((mtile * 2 + ntile) * 64 + lane) * 32 + 16); } }
    for (int c = 0; c < T / 64; ++c) {
        bf16x8 zf[4];
#pragma unroll
        for (int kt = 0; kt < 2; ++kt)
#pragma unroll
            for (int s = 0; s < 2; ++s) { v4u w; w.x = cvtpk(z[kt][8 * s + 0], z[kt][8 * s + 1]); w.y = cvtpk(z[kt][8 * s + 2], z[kt][8 * s + 3]); w.z = cvtpk(z[kt][8 * s + 4], z[kt][8 * s + 5]); w.w = cvtpk(z[kt][8 * s + 6], z[kt][8 * s + 7]);
                zf[kt * 2 + s] = __builtin_bit_cast(bf16x8, w); *(v4u*)(stash + (size_t)c * 8192 + ((kt * 2 + s) * 64 + lane) * 16) = w; }
        if (c == T / 64 - 1) break;
        bf16x8 ca[2][4]; v4u cq[2][2];
#pragma unroll
        for (int mtile = 0; mtile < 2; ++mtile) {
#pragma unroll
            for (int ks = 0; ks < 4; ++ks) ca[mtile][ks] = pa[mtile][ks];
            cq[mtile][0] = qc[mtile][0]; cq[mtile][1] = qc[mtile][1]; }
        if (c + 2 < T / 64) { const unsigned char* rec = recs + (size_t)(c + 1) * 32768;
#pragma unroll
            for (int mtile = 0; mtile < 2; ++mtile) {
#pragma unroll
                for (int ks = 0; ks < 4; ++ks) pa[mtile][ks] = *(const bf16x8*)(rec + ((mtile * 4 + ks) * 64 + lane) * 16);
                qc[mtile][0] = *(const v4u*)(rec + 8192 + ((mtile * 2 + ntile) * 64 + lane) * 32); qc[mtile][1] = *(const v4u*)(rec + 8192 + ((mtile * 2 + ntile) * 64 + lane) * 32 + 16); } }
#pragma unroll
        for (int mtile = 0; mtile < 2; ++mtile) {
            f32x16 acc;
#pragma unroll
            for (int i = 0; i < 4; ++i) { const unsigned w0 = cq[mtile][0][i], w1 = cq[mtile][1][i];
                acc[2 * i] = __builtin_bit_cast(float, w0 << 16); acc[2 * i + 1] = __builtin_bit_cast(float, w0 & 0xffff0000u);
                acc[8 + 2 * i] = __builtin_bit_cast(float, w1 << 16); acc[8 + 2 * i + 1] = __builtin_bit_cast(float, w1 & 0xffff0000u); }
#pragma unroll
            for (int ks = 0; ks < 4; ++ks) acc = __builtin_amdgcn_mfma_f32_32x32x16_bf16(ca[mtile][ks], zf[ks], acc, 0, 0, 0);
            z[mtile] = acc;
        }
    }
}
__device__ __forceinline__ void p3b_rwkv_out_mfma(Frame& F) {
    const int gw = F.vcu * NWAVES + F.wave, NGW = F.G * NWAVES, lane = F.lane, hh = lane >> 5, tl = lane & 31;
    bf16* Y = (bf16*)(F.ws + WS_XB); const float* GG = (const float*)(F.ws + WS_G); const bf16* VS = (const bf16*)(F.ws + WS_VS); const float* BON = (const float*)(F.ws + WS_BONUS);
    const float* lnw = F.in[12]; const float* lnb = F.in[13];
    for (int it = gw; it < BATCH * 8 * (T / 64); it += NGW) {
        const int chunk = it & 127, h = (it >> 7) & 7, b = it >> 10; const int row0 = b * T + chunk * 64;
        const unsigned char* rec = (const unsigned char*)F.out + (size_t)it * 32768;
        const unsigned char* stash = F.ws + WS_HB + (size_t)it * 8192;
        bf16x8 zf[2][4], gf[2][4];
#pragma unroll
        for (int a = 0; a < 2; ++a)
#pragma unroll
            for (int ks = 0; ks < 4; ++ks) { zf[a][ks] = *(const bf16x8*)(stash + a * 4096 + (ks * 64 + lane) * 16); gf[a][ks] = *(const bf16x8*)(rec + 16384 + ((a * 4 + ks) * 64 + lane) * 16); }
        f32x16 y[2][2];
#pragma unroll
        for (int vt = 0; vt < 2; ++vt)
#pragma unroll
            for (int tt = 0; tt < 2; ++tt) { const v4u c0 = *(const v4u*)(rec + 24576 + ((vt * 2 + tt) * 64 + lane) * 32), c1 = *(const v4u*)(rec + 24576 + ((vt * 2 + tt) * 64 + lane) * 32 + 16);
                f32x16 acc;
#pragma unroll
                for (int i = 0; i < 4; ++i) { acc[2 * i] = __builtin_bit_cast(float, c0[i] << 16); acc[2 * i + 1] = __builtin_bit_cast(float, c0[i] & 0xffff0000u);
                    acc[8 + 2 * i] = __builtin_bit_cast(float, c1[i] << 16); acc[8 + 2 * i + 1] = __builtin_bit_cast(float, c1[i] & 0xffff0000u); }
#pragma unroll
                for (int ks = 0; ks < 4; ++ks) acc = __builtin_amdgcn_mfma_f32_32x32x16_bf16(zf[vt][ks], gf[tt][ks], acc, 0, 0, 0);
                y[vt][tt] = acc; }
#pragma unroll
        for (int tt = 0; tt < 2; ++tt) {
            float s = 0.f;
#pragma unroll
            for (int vt = 0; vt < 2; ++vt)
#pragma unroll
                for (int i = 0; i < 16; ++i) s += y[vt][tt][i];
            s += __shfl_xor(s, 32); const float mean = s * (1.0f / 64.0f); float qv = 0.f;
#pragma unroll
            for (int vt = 0; vt < 2; ++vt)
#pragma unroll
                for (int i = 0; i < 16; ++i) { const float d = y[vt][tt][i] - mean; qv += d * d; }
            qv += __shfl_xor(qv, 32); const float rstd = 1.0f / sqrtf(qv * (1.0f / 64.0f) + GN_EPS);
            const int row = row0 + 32 * tt + tl; const float bon = BON[(size_t)row * 8 + h];
#pragma unroll
            for (int vt = 0; vt < 2; ++vt)
#pragma unroll
                for (int g = 0; g < 4; ++g) { const int v0 = 32 * vt + 8 * g + 4 * hh, ch = h * 64 + v0;
                    const f32x4 gw4 = *(const f32x4*)(GG + (size_t)row * 512 + ch), lw4 = *(const f32x4*)(lnw + ch), lb4 = *(const f32x4*)(lnb + ch);
                    const u32x2 vsw = *(const u32x2*)(VS + (size_t)row * 512 + ch);
                    float vs4[4] = {__builtin_bit_cast(float, vsw.x << 16), __builtin_bit_cast(float, vsw.x & 0xffff0000u), __builtin_bit_cast(float, vsw.y << 16), __builtin_bit_cast(float, vsw.y & 0xffff0000u)};
                    float o[4];
#pragma unroll
                    for (int r = 0; r < 4; ++r) o[r] = ((y[vt][tt][4 * g + r] - mean) * rstd * lw4[r] + lb4[r] + bon * vs4[r]) * gw4[r];
                    u32x2 w; w.x = cvtpk(o[0], o[1]); w.y = cvtpk(o[2], o[3]);
                    *(u32x2*)(Y + (size_t)row * D + ch) = w; }
        }
    }
}

constexpr int NSA_KB = 0, NSA_VB = 16384, NSA_IMP = 32768, NSA_OUT = 65536, NSA_SELM = RING_BYTES + 1024, NSA_LIST = RING_BYTES + 2048, NSA_MISC = RING_BYTES + 3072;
static_assert(NSA_OUT + 8 * 8192 <= RING_BYTES && NSA_MISC + 1024 <= LDS_BYTES, "nsa lds map");
constexpr float LOG2E = 1.4426950408889634f;
constexpr float NEGB = -1e30f;
__device__ __forceinline__ int perm16(int c) { return (c & ~15) | (((c >> 2) & 1) << 3) | (((c >> 3) & 1) << 2) | (c & 3); }

__device__ __forceinline__ void p2_vtrans(Frame& F) {
    LAS unsigned short* TL = (LAS unsigned short*)(F.lds + RING_OFF);
    const bf16* PB = (const bf16*)(F.ws + WS_PB); bf16* VT = (bf16*)(F.ws + WS_VT);
    const int tid = F.tid;
    for (int it = F.vcu; it < 2 * 4 * (T / 64); it += F.G) {
        const int n = it & 127, bhk = (it >> 7) & 3, kind = it >> 9; const int b = bhk >> 1, hk = bhk & 1;
        const int col = (kind ? C_VW : C_VS) + hk * 64;
        { const int tok = tid >> 3, ch = tid & 7; const bf16x8 v = *(const bf16x8*)(PB + (size_t)(b * T + 64 * n + tok) * NMAIN + col + 8 * ch);
#pragma unroll
          for (int j = 0; j < 8; ++j) TL[tok * 66 + 8 * ch + j] = (unsigned short)v[j]; }
        __syncthreads();
        { const int d = tid >> 3, ch = tid & 7; bf16x8 o;
#pragma unroll
          for (int j = 0; j < 8; ++j) { const int key = perm16(8 * ch + j); o[j] = (short)TL[key * 66 + d]; }
          *(bf16x8*)(VT + ((size_t)(kind * 4 + bhk) * 64 + d) * T + 64 * n + 8 * ch) = o; }
        __syncthreads();
    }
}
struct NsaCtx { const bf16* kc; const bf16* vct; const bf16* ks; const bf16* vst; const bf16* kw; const bf16* vwt; };
__device__ __forceinline__ void nsa_load(const NsaCtx& C, int desc, int tid, v4u& kr, v4u& vr) {
    const int kind = desc >> 8, n = desc & 255, row = tid >> 3, ch = tid & 7;
    const bf16* kp; const bf16* vp;
    if (kind == 0) { kp = C.kc + (size_t)(64 * n + row) * 64 + 8 * ch; vp = C.vct + (size_t)row * NCMPP + 64 * n + 8 * ch; }
    else if (kind == 1) { kp = C.ks + (size_t)(64 * n + row) * NMAIN + 8 * ch; vp = C.vst + (size_t)row * T + 64 * n + 8 * ch; }
    else { kp = C.kw + (size_t)(64 * n + row) * NMAIN + 8 * ch; vp = C.vwt + (size_t)row * T + 64 * n + 8 * ch; }
    kr = *(const v4u*)kp; vr = *(const v4u*)vp;
}
__device__ __forceinline__ void nsa_store(LAS unsigned char* L, int buf, int tid, const v4u kr, const v4u vr) {
    const int row = tid >> 3, ch = tid & 7; const int o = row * 128 + ((ch ^ (row & 7)) << 4);
    *(LAS v4u*)(L + NSA_KB + buf * 8192 + o) = kr; *(LAS v4u*)(L + NSA_VB + buf * 8192 + o) = vr;
}
template <int MODE>
__device__ __forceinline__ void nsa_block(const LAS unsigned char* KB, const LAS unsigned char* VB, const bf16x8 (&qf)[4], f32x16 (&o)[2], float& m, float& l,
                                          float ck, float cb, int lo, int hi, bool masked, float invl, LAS float* impw, int nbase, int lane) {
    const int r32 = lane & 31, hh = lane >> 5;
    f32x16 s0, s1;
    { const float cbh = cb + ck * (float)(4 * hh);
#pragma unroll
      for (int i = 0; i < 16; ++i) { const float c = (float)((i & 3) + 8 * (i >> 2)); s0[i] = __builtin_fmaf(ck, c, cbh); s1[i] = __builtin_fmaf(ck, c + 32.f, cbh); } }
    { const LAS unsigned char* kp = KB + r32 * 128; const int sw = r32 & 7;
#pragma unroll
      for (int ks = 0; ks < 4; ++ks) { const bf16x8 a0 = *(const LAS bf16x8*)(kp + (((2 * ks + hh) ^ sw) << 4)), a1 = *(const LAS bf16x8*)(kp + 4096 + (((2 * ks + hh) ^ sw) << 4));
          s0 = __builtin_amdgcn_mfma_f32_32x32x16_bf16(a0, qf[ks], s0, 0, 0, 0); s1 = __builtin_amdgcn_mfma_f32_32x32x16_bf16(a1, qf[ks], s1, 0, 0, 0); } }
    if (masked) { const int lo2 = lo - 4 * hh, hi2 = hi - 4 * hh;
#pragma unroll
        for (int i = 0; i < 16; ++i) { const int c = (i & 3) + 8 * (i >> 2); if (c < lo2 || c > hi2) s0[i] = NEGB; if (c + 32 < lo2 || c + 32 > hi2) s1[i] = NEGB; } }
    if (MODE != 2) {
        float bm = fmaxf(s0[0], s1[0]);
#pragma unroll
        for (int i = 1; i < 16; ++i) bm = fmaxf(bm, fmaxf(s0[i], s1[i]));
        bm = fmaxf(bm, __shfl_xor(bm, 32));
        const float mn = fmaxf(m, bm);
        if (__any(mn > m)) { const float alpha = __builtin_amdgcn_exp2f(m - mn); l *= alpha;
            if (MODE == 0) {
#pragma unroll
                for (int i = 0; i < 16; ++i) { o[0][i] *= alpha; o[1][i] *= alpha; } } }
        m = mn;
    }
    float ls = 0.f;
#pragma unroll
    for (int i = 0; i < 16; ++i) { s0[i] = __builtin_amdgcn_exp2f(s0[i] - m); s1[i] = __builtin_amdgcn_exp2f(s1[i] - m); ls += s0[i] + s1[i]; }
    if (MODE != 2) l += ls;
    if (MODE == 1) return;
    if (MODE == 2) {
#pragma unroll
        for (int i = 0; i < 16; ++i) { s0[i] *= invl; s1[i] *= invl; }
        const int tok = r32 >> 2;
#pragma unroll
        for (int kt = 0; kt < 2; ++kt)
#pragma unroll
            for (int gi = 0; gi < 4; ++gi) { const f32x16& s = kt ? s1 : s0;
                float a = 2.f * (s[4 * gi] + s[4 * gi + 1] + s[4 * gi + 2]) + s[4 * gi + 3], bq = s[4 * gi + 3];
                a += __shfl_xor(a, 1); a += __shfl_xor(a, 2); bq += __shfl_xor(bq, 1); bq += __shfl_xor(bq, 2);
                const int n = nbase + 8 * kt + 2 * gi + hh;
                if ((lane & 3) == 0) { impw[tok * 128 + n] += a; }
                asm volatile("" ::: "memory");
                if ((lane & 3) == 0 && n + 1 < 128) { impw[tok * 128 + n + 1] += bq; }
                asm volatile("" ::: "memory"); }
    }
    bf16x8 pf[4];
#pragma unroll
    for (int kt = 0; kt < 2; ++kt)
#pragma unroll
        for (int s = 0; s < 2; ++s) { const f32x16& sv = kt ? s1 : s0; v4u w; w.x = cvtpk(sv[8 * s + 0], sv[8 * s + 1]); w.y = cvtpk(sv[8 * s + 2], sv[8 * s + 3]); w.z = cvtpk(sv[8 * s + 4], sv[8 * s + 5]); w.w = cvtpk(sv[8 * s + 6], sv[8 * s + 7]);
            pf[kt * 2 + s] = __builtin_bit_cast(bf16x8, w); }
    { const LAS unsigned char* vp = VB + r32 * 128; const int sw = r32 & 7;
#pragma unroll
      for (int sp = 0; sp < 4; ++sp) { const bf16x8 a0 = *(const LAS bf16x8*)(vp + (((2 * sp + hh) ^ sw) << 4)), a1 = *(const LAS bf16x8*)(vp + 4096 + (((2 * sp + hh) ^ sw) << 4));
          o[0] = __builtin_amdgcn_mfma_f32_32x32x16_bf16(a0, pf[sp], o[0], 0, 0, 0); o[1] = __builtin_amdgcn_mfma_f32_32x32x16_bf16(a1, pf[sp], o[1], 0, 0, 0); } }
}
__device__ __forceinline__ void nsa_item(Frame& F, int b, int hk, int cur) {
    LAS unsigned char* L = F.lds + RING_OFF;
    const int tid = F.tid, lane = F.lane, wave = F.wave, r32 = lane & 31, hh = lane >> 5, tok = r32 >> 2, g = r32 & 3;
    const int t0 = 64 * cur, t = t0 + 8 * wave + tok, head = hk * 4 + g, bhk = b * 2 + hk;
    const size_t row = (size_t)b * T + t;
    const bf16* PB = (const bf16*)(F.ws + WS_PB);
    NsaCtx C;
    C.kc = (const bf16*)(F.ws + WS_CMP) + (size_t)bhk * NCMPP * 64; C.vct = (const bf16*)(F.ws + WS_CMP + 262144) + (size_t)bhk * 64 * NCMPP;
    C.ks = PB + (size_t)b * T * NMAIN + C_KS + hk * 64; C.kw = PB + (size_t)b * T * NMAIN + C_KW + hk * 64;
    C.vst = (const bf16*)(F.ws + WS_VT) + (size_t)(0 * 4 + bhk) * 64 * T; C.vwt = (const bf16*)(F.ws + WS_VT) + (size_t)(1 * 4 + bhk) * 64 * T;
    LAS float* impw = (LAS float*)(L + NSA_IMP) + wave * 1024;
    LAS unsigned* SELM = (LAS unsigned*)(L + NSA_SELM); LAS int* LIST = (LAS int*)(L + NSA_LIST); LAS int* MISC = (LAS int*)(L + NSA_MISC);
    const float slope2 = exp2f(-(float)(head + 1)) * LOG2E;
    bf16x8 qf[4];
#pragma unroll
    for (int ks = 0; ks < 4; ++ks) { float q8[8]; ld8bf(q8, PB + row * NMAIN + C_Q + head * 64 + 16 * ks + 8 * hh);
#pragma unroll
        for (int j = 0; j < 8; ++j) q8[j] *= 0.125f * LOG2E;
        qf[ks] = __builtin_bit_cast(bf16x8, pack8(q8)); }
#pragma unroll
    for (int i = 0; i < 16; ++i) impw[i * 64 + lane] = 0.f;
    const float* gates = (const float*)(F.ws + WS_GATES) + row * 24 + head * 3;
    const float gt0 = gates[0], gt1 = gates[1], gt2 = gates[2];
    LAS float* outp = (LAS float*)(L + NSA_OUT) + wave * 2048 + lane;
    f32x16 o[2];
#pragma unroll
    for (int i = 0; i < 16; ++i) { o[0][i] = 0.f; o[1][i] = 0.f; }
    float m = NEGB, l = 0.f, invl = 0.f;
    v4u kr, vr;
    const int nbc = (4 * cur + 3 + 63) >> 6; const int nA = 2 * nbc;
    const int tmin = t0 + 8 * wave;
    nsa_load(C, 0, tid, kr, vr); nsa_store(L, 0, tid, kr, vr);
    __syncthreads();
    for (int i = 0; i < nA; ++i) {
        const int n = (i < nbc) ? i : i - nbc;
        if (i + 1 < nA) nsa_load(C, (i + 1 < nbc) ? i + 1 : i + 1 - nbc, tid, kr, vr);
        if (i == nbc) { const float lt = l + __shfl_xor(l, 32); invl = (t >= 31) ? 1.0f / lt : 0.f; }
        if (1024 * n + 31 <= tmin + 7) {
            const float ck = 16.f * slope2, cb = slope2 * (float)(1024 * n + 31 - t);
            const int hi = (t >= 31) ? ((t - 31) >> 4) - 64 * n : -1;
            const bool masked = (16 * (64 * n + 63) + 31 > tmin);
            const LAS unsigned char* KB = L + NSA_KB + (i & 1) * 8192; const LAS unsigned char* VB = L + NSA_VB + (i & 1) * 8192;
            if (i < nbc) nsa_block<1>(KB, VB, qf, o, m, l, ck, cb, 0, hi, masked, 0.f, impw, 0, lane);
            else nsa_block<2>(KB, VB, qf, o, m, l, ck, cb, 0, hi, masked, invl, impw, 16 * n, lane);
        }
        if (i + 1 < nA) nsa_store(L, (i + 1) & 1, tid, kr, vr);
        __syncthreads();
    }
#pragma unroll
    for (int i = 0; i < 16; ++i) { outp[64 * i] = gt0 * o[0][i]; outp[64 * (16 + i)] = gt0 * o[1][i]; o[0][i] = 0.f; o[1][i] = 0.f; }
    asm volatile("s_waitcnt lgkmcnt(0)" ::: "memory");
    {
        unsigned long long mlo[8], mhi[8];
        if (cur < 16) {
#pragma unroll
            for (int tk = 0; tk < 8; ++tk) { mlo[tk] = (1ull << (cur + 1)) - 1ull; mhi[tk] = 0ull; }
        } else {
            float v0[8], v1[8];
#pragma unroll
            for (int tk = 0; tk < 8; ++tk) { const float i0 = impw[tk * 128 + lane], i1 = impw[tk * 128 + 64 + lane]; const int n1 = lane + 64;
                v0[tk] = (lane > cur) ? NEGV : ((lane == 0 || lane == cur || lane == cur - 1) ? BIGV : i0);
                v1[tk] = (n1 > cur) ? NEGV : ((n1 == cur || n1 == cur - 1) ? BIGV : i1); mlo[tk] = 0ull; mhi[tk] = 0ull; }
            for (int itr = 0; itr < 16; ++itr) {
#pragma unroll
                for (int tk = 0; tk < 8; ++tk) {
                    const float mx = wave_max(fmaxf(v0[tk], v1[tk]));
                    const unsigned long long b0 = __ballot(v0[tk] == mx);
                    if (b0) { const int idx = __builtin_ctzll(b0); if (lane == idx) v0[tk] = -INFINITY; if (mx > 0.5f * NEGV) mlo[tk] |= 1ull << idx; }
                    else { const unsigned long long b1 = __ballot(v1[tk] == mx); const int idx = __builtin_ctzll(b1); if (lane == idx) v1[tk] = -INFINITY; if (mx > 0.5f * NEGV) mhi[tk] |= 1ull << idx; }
                }
            }
        }
        if (lane == 0) {
#pragma unroll
            for (int tk = 0; tk < 8; ++tk) { LAS unsigned* p = SELM + (8 * wave + tk) * 4; p[0] = (unsigned)mlo[tk]; p[1] = (unsigned)(mlo[tk] >> 32); p[2] = (unsigned)mhi[tk]; p[3] = (unsigned)(mhi[tk] >> 32); }
        }
    }
    __syncthreads();
    if (wave == 0) {
        unsigned u0 = SELM[lane * 4 + 0], u1 = SELM[lane * 4 + 1], u2 = SELM[lane * 4 + 2], u3 = SELM[lane * 4 + 3];
#pragma unroll
        for (int ofs = 1; ofs < 64; ofs <<= 1) { u0 |= __shfl_xor(u0, ofs); u1 |= __shfl_xor(u1, ofs); u2 |= __shfl_xor(u2, ofs); u3 |= __shfl_xor(u3, ofs); }
        if (lane == 0) {
            int cnt = 0;
            for (int w4 = 0; w4 < 4; ++w4) { unsigned u = (w4 == 0) ? u0 : (w4 == 1) ? u1 : (w4 == 2) ? u2 : u3; while (u) { const int bit = __builtin_ctz(u); u &= u - 1; LIST[cnt++] = (1 << 8) | (32 * w4 + bit); } }
            MISC[0] = cnt;
            for (int n = (cur >= 8 ? cur - 8 : 0); n <= cur; ++n) LIST[cnt++] = (2 << 8) | n;
            MISC[1] = cnt;
        }
    }
    __syncthreads();
    const int nS = MISC[0], nB = MISC[1];
    m = NEGB; l = 0.f;
    nsa_load(C, LIST[0], tid, kr, vr); nsa_store(L, 0, tid, kr, vr);
    __syncthreads();
    for (int i = 0; i < nB; ++i) {
        const int desc = LIST[i]; const int kind = desc >> 8, n = desc & 255;
        if (i + 1 < nB) nsa_load(C, LIST[i + 1], tid, kr, vr);
        if (i == nS) {
            const float lt = l + __shfl_xor(l, 32); const float f = gt1 / lt;
#pragma unroll
            for (int k = 0; k < 16; ++k) { outp[64 * k] += f * o[0][k]; outp[64 * (16 + k)] += f * o[1][k]; o[0][k] = 0.f; o[1][k] = 0.f; }
            m = NEGB; l = 0.f;
        }
        const LAS unsigned char* KB = L + NSA_KB + (i & 1) * 8192; const LAS unsigned char* VB = L + NSA_VB + (i & 1) * 8192;
        const float cb = slope2 * (float)(64 * n - t);
        if (kind == 1) {
            const unsigned bit = (SELM[(8 * wave + tok) * 4 + (n >> 5)] >> (n & 31)) & 1u;
            if (__any((int)bit)) {
                const bool masked = (n == cur) || !__all((int)bit);
                const int hi = bit ? (t - 64 * n) : -1;
                nsa_block<0>(KB, VB, qf, o, m, l, slope2, cb, 0, hi, masked, 0.f, impw, 0, lane);
            }
        } else {
            const bool masked = (n == cur) || (n == cur - 8);
            nsa_block<0>(KB, VB, qf, o, m, l, slope2, cb, t - 511 - 64 * n, t - 64 * n, masked, 0.f, impw, 0, lane);
        }
        if (i + 1 < nB) nsa_store(L, (i + 1) & 1, tid, kr, vr);
        __syncthreads();
    }
    { const float lt = l + __shfl_xor(l, 32); const float f = gt2 / lt;
#pragma unroll
      for (int k = 0; k < 16; ++k) { o[0][k] = outp[64 * k] + f * o[0][k]; o[1][k] = outp[64 * (16 + k)] + f * o[1][k]; } }
    bf16* Y = (bf16*)(F.ws + WS_XB) + row * D + 512 + head * 64;
#pragma unroll
    for (int dt = 0; dt < 2; ++dt)
#pragma unroll
        for (int gi = 0; gi < 4; ++gi) { u32x2 w; w.x = cvtpk(o[dt][4 * gi], o[dt][4 * gi + 1]); w.y = cvtpk(o[dt][4 * gi + 2], o[dt][4 * gi + 3]);
            *(u32x2*)(Y + 32 * dt + 8 * gi + 4 * hh) = w; }
}
__device__ __forceinline__ void p3_nsa_mfma(Frame& F) {
    LAS int* QS = (LAS int*)(F.lds + RING_OFF + NSA_MISC + 64);
    for (;;) {
        if (F.tid == 0) QS[0] = (int)__hip_atomic_fetch_add((unsigned*)(F.ctl + CW_QUEUE), 1u, __ATOMIC_RELAXED, __HIP_MEMORY_SCOPE_AGENT);
        __syncthreads();
        const int q = QS[0];
        __syncthreads();
        if (q >= 4 * (T / 64)) break;
        const int cur = 127 - (q >> 2), bhk = q & 3;
        nsa_item(F, bhk >> 1, bhk & 1, cur);
    }
}

struct Args { const float* in[26]; float* out; unsigned char* ws; };
__global__ void __launch_bounds__(NWAVES * 64, 2) hybrid_fwd(Args args) {
    extern __shared__ __attribute__((aligned(16))) unsigned char lds[];
    Frame F;
    F.lds = (LAS unsigned char*)lds;
    F.MISC = (volatile LAS unsigned*)(F.lds + MISC_OFF);
    F.tid = threadIdx.x; F.lane = F.tid & 63; F.wave = __builtin_amdgcn_readfirstlane(F.tid >> 6);
    F.G = gridDim.x; { const int bx = blockIdx.x; F.vcu = (F.G % 8 == 0) ? (bx % 8) * (F.G / 8) + bx / 8 : bx; }
    F.ws = args.ws; F.out = args.out; F.ctl = (gu32*)(args.ws + WS_CTL);
#pragma unroll
    for (int i = 0; i < 26; ++i) F.in[i] = args.in[i];
    for (int u = F.tid; u < (LDS_BYTES - LDSCTL_OFF) / 4; u += NWAVES * 64) ((LAS unsigned*)(F.lds + LDSCTL_OFF))[u] = 0u;
    __syncthreads();
    XcdBarrier bar = xcd_barrier_post((unsigned*)(F.ctl + CW_BAR), F.MISC + 8);
#define GRID_BAR() xcd_barrier(bar)

    bf16* Win_t = (bf16*)(F.ws + WS_WIN); bf16* Wout_t = (bf16*)(F.ws + WS_WOUT); bf16* Wgu_t = (bf16*)(F.ws + WS_WGU); bf16* Wd_t = (bf16*)(F.ws + WS_WD);
    bf16* XB = (bf16*)(F.ws + WS_XB); bf16* PB = (bf16*)(F.ws + WS_PB); bf16* HB = (bf16*)(F.ws + WS_HB); bf16* ACT = (bf16*)(F.ws + WS_PB);
    float* rstd1 = (float*)(F.ws + WS_RSTD1); float* ssq2 = (float*)(F.ctl + CW_SSQ2); float* ssq3 = (float*)(F.ctl + CW_SSQ3);

    p0_prologue(F);
    GRID_BAR();
    {
        pg8::Gemm g{XB, Win_t, M, NMAIN, D}; pg8::StaticOrder S; S.init(M, NMAIN, F.G, (int)blockIdx.x);
        pg8::EpiRowScaleBf16 E{PB, NMAIN, rstd1};
        pg8::gemm_phase<pg8::EpiRowScaleBf16, pg8::StaticOrder, true, true>(F.lds + RING_OFF, g, S, E);
    }
    GRID_BAR();
    p2_gates_naive(F);
    p2_rwkv_chunk(F);
    p2_compress_naive(F);
    p2_vtrans(F);
    GRID_BAR();
    if (blockIdx.x < 4) p3_rwkv_scan_mfma(F, 4 * (int)blockIdx.x + (F.wave >> 1), F.wave & 1);
    p3_nsa_mfma(F);
    GRID_BAR();
    p3b_rwkv_out_mfma(F);
    GRID_BAR();
    {
        pg8::Gemm g{XB, Wout_t, M, D, D}; pg8::StaticOrder S; S.init(M, D, F.G, (int)blockIdx.x);
        pg8::EpiResid E{F.in[0], F.out, HB, ssq2, D};
        pg8::gemm_phase<pg8::EpiResid, pg8::StaticOrder, true, true>(F.lds + RING_OFF, g, S, E);
    }
    GRID_BAR();
    {
        pg8::Gemm g{HB, Wgu_t, M, NGU, D}; pg8::StaticOrder S; S.init(M, NGU, F.G, (int)blockIdx.x);
        pg8::EpiSwiGLU E{ACT, DFF, ssq2, NORM_EPS};
        pg8::gemm_phase<pg8::EpiSwiGLU, pg8::StaticOrder, true, true>(F.lds + RING_OFF, g, S, E);
    }
    GRID_BAR();
    {
        pg8::Gemm g{ACT, Wd_t, M, D, DFF}; pg8::StaticOrder S; S.init(M, D, F.G, (int)blockIdx.x);
        pg8::EpiResid E{F.out, F.out, nullptr, ssq3, D};
        pg8::gemm_phase<pg8::EpiResid, pg8::StaticOrder, true, true>(F.lds + RING_OFF, g, S, E);
    }
    GRID_BAR();
    p7_final_norm(F);
#undef GRID_BAR
}

extern "C" void kernel_launch(void* const* d_in, const int* in_sizes, int n_in, void* d_out, int out_size, void* d_ws, size_t ws_size, hipStream_t stream) {
    static int grid = 0;
    if (grid == 0) {
        if (n_in != 26 || in_sizes[0] != M * D || out_size != M * D || ws_size < WS_END) { fprintf(stderr, "kernel_launch: unexpected shapes (n_in %d, in0 %d, out %d, ws %zu); nothing launched\n", n_in, n_in > 0 ? in_sizes[0] : -1, out_size, ws_size); grid = -1; return; }
        int dev = 0, cus = 0, per_cu = 0;
        if (hipGetDevice(&dev) != hipSuccess || hipDeviceGetAttribute(&cus, hipDeviceAttributeMultiprocessorCount, dev) != hipSuccess) { fprintf(stderr, "kernel_launch: device query failed\n"); grid = -1; return; }
        if (hipFuncSetAttribute((const void*)hybrid_fwd, hipFuncAttributeMaxDynamicSharedMemorySize, LDS_BYTES) != hipSuccess) { fprintf(stderr, "kernel_launch: hipFuncSetAttribute failed\n"); grid = -1; return; }
        if (hipOccupancyMaxActiveBlocksPerMultiprocessor(&per_cu, (const void*)hybrid_fwd, NWAVES * 64, LDS_BYTES) != hipSuccess || per_cu < 1)
            fprintf(stderr, "kernel_launch: note: occupancy query reports %d workgroups per CU\n", per_cu);
        (void)hipGetLastError();
        grid = cus;
    }
    if (grid < 0) return;
    if (hipMemsetAsync((char*)d_ws + WS_CTL, 0, CTL_ZERO_BYTES, stream) != hipSuccess) { fprintf(stderr, "kernel_launch: hipMemsetAsync failed\n"); return; }
    Args a{};
    for (int i = 0; i < 26; ++i) a.in[i] = (const float*)d_in[i];
    a.out = (float*)d_out; a.ws = (unsigned char*)d_ws;
    hipLaunchKernelGGL(hybrid_fwd, dim3(grid), dim3(NWAVES * 64), LDS_BYTES, stream, a);
    const hipError_t le = hipPeekAtLastError();
    if (le != hipSuccess) fprintf(stderr, "kernel_launch: launch failed: %s\n", hipGetErrorName(le));
}
```

```cpp
#include <hip/hip_runtime.h>
#include <cstdio>
#include <cstdint>
namespace pg8 {
#define PG8_LAS __attribute__((address_space(3)))
typedef unsigned short bf16_t;
typedef short bf16x8 __attribute__((ext_vector_type(8)));
typedef float f32x4 __attribute__((ext_vector_type(4)));
typedef unsigned u32x4 __attribute__((ext_vector_type(4)));
constexpr int BM = 256, BK = 64, HALF = 128, HTB = HALF * BK * 2  , STAGE_BYTES = 8 * HTB, NXCD = 8, WGM = 8;

__host__ __device__ __forceinline__ int lds_byte(int r, int c) { const int st = (r >> 4) * 2 + (c >> 5), rr = r & 15, cc = c & 31, ob = rr * 64 + cc * 2; return st * 1024 + (ob ^ (((ob >> 9) & 1) << 5)); }
__host__ __device__ __forceinline__ void stage_rc(int b, int& R, int& C) { const int st = b / 1024, sb = b % 1024, swz = sb ^ (((sb >> 9) & 1) << 5); R = (st >> 1) * 16 + swz / 64; C = (st & 1) * 32 + (swz % 64) / 2; }
__host__ __device__ __forceinline__ int perm32(int rho) { const int n = rho >> 4, i = rho & 15; return 8 * (i >> 2) + 4 * n + (i & 3); }

struct Unit { int pm, pn; };
struct Gemm { const bf16_t* A; const bf16_t* Bt; int M, N, K; };

struct StaticOrder {
    int nM, nN, nwg, G, c;
    __host__ __device__ void init(int M, int N, int G_, int c_) { nM = M / BM; nN = N / BM; nwg = nM * nN; G = G_; c = c_; }
    __host__ __device__ bool next(int i, Unit& u) const {
        const long L = (long)i * G + c; if (L >= nwg) return false;
        int wgid = (int)L; { const int q = nwg / NXCD, r = nwg % NXCD, xcd = wgid % NXCD, off = wgid / NXCD; wgid = (xcd < r ? xcd * (q + 1) : r * (q + 1) + (xcd - r) * q) + off; }
        const int nig = WGM * nN, gid = wgid / nig, fm = gid * WGM, gsz = (nM - fm) < WGM ? (nM - fm) : WGM;
        u.pm = fm + ((wgid % nig) % gsz); u.pn = (wgid % nig) / gsz; return true;
    }
    __device__ __forceinline__ void a_ready(const Unit&) const {}
    __device__ __forceinline__ void done(const Unit&) const {}
};

__device__ __forceinline__ unsigned cvt_pk_bf16(float lo, float hi) { unsigned r; asm volatile("v_cvt_pk_bf16_f32 %0, %1, %2" : "=v"(r) : "v"(lo), "v"(hi)); return r; }
typedef float f32x2 __attribute__((ext_vector_type(2)));
__device__ __forceinline__ f32x2 gelu_pk(f32x2 v) {
    const f32x2 av = __builtin_elementwise_abs(v), d = av * 0.2316418882f + 1.0f;
    f32x2 t; t.x = __builtin_amdgcn_rcpf(d.x); t.y = __builtin_amdgcn_rcpf(d.y);
    f32x2 q = t * 0.5307027145f + (-0.7265760135f); q = q * t + 0.7107068705f; q = q * t + (-0.142248368f); q = q * t + 0.127414796f; q = q * t;
    const f32x2 s = (v * v) * (-0.72134752044f);
    f32x2 e; e.x = __builtin_amdgcn_exp2f(s.x); e.y = __builtin_amdgcn_exp2f(s.y);
    const f32x2 m = v * (q * e), r = v - m;
    f32x2 o; o.x = v.x < 0.f ? m.x : r.x; o.y = v.y < 0.f ? m.y : r.y; return o;
}

template <int ACT  > struct EpiBf16 {
    static constexpr bool PERM = true, AFTER_DRAIN = false; static_assert(ACT == 0 || ACT == 1, "EpiBf16: ACT is 0 (none) or 1 (gelu_pk)");
    bf16_t* O; int ldc; const float* bias; int split_cols; size_t split_stride; float scale0;
    __device__ __forceinline__ void operator()(const f32x4 (&acc)[2][2][4][2], const Unit& u, int wr, int wc, int fr, int fq) const {
        const int row0 = u.pm * BM + wr * 64 + fr; int colt = u.pn * BM; bf16_t* base = O;
        float sc = 1.f; if (split_cols) { const int t = colt / split_cols; base += (size_t)t * split_stride; colt -= t * split_cols; if (t == 0) sc = scale0; }
        const int col0 = colt + wc * 32 + 8 * fq, bcol0 = u.pn * BM + wc * 32 + 8 * fq;
        f32x4 bv[2][2];
#pragma unroll
        for (int bj = 0; bj < 2; ++bj)
#pragma unroll
            for (int n = 0; n < 2; ++n) bv[bj][n] = bias ? *(const f32x4*)(bias + bcol0 + bj * HALF + 4 * n) : (f32x4){0.f, 0.f, 0.f, 0.f};
#pragma unroll
        for (int ai = 0; ai < 2; ++ai)
#pragma unroll
            for (int m = 0; m < 4; ++m) { bf16_t* rowp = base + (size_t)(row0 + ai * HALF + m * 16) * ldc + col0;
#pragma unroll
                for (int bj = 0; bj < 2; ++bj) { f32x4 v0 = acc[ai][bj][m][0] + bv[bj][0], v1 = acc[ai][bj][m][1] + bv[bj][1];
                    if (ACT == 1) { f32x2 a = gelu_pk((f32x2){v0[0], v0[1]}), b = gelu_pk((f32x2){v0[2], v0[3]}), c = gelu_pk((f32x2){v1[0], v1[1]}), d = gelu_pk((f32x2){v1[2], v1[3]});
                        v0 = (f32x4){a.x, a.y, b.x, b.y}; v1 = (f32x4){c.x, c.y, d.x, d.y}; }
                    v0 = v0 * sc; v1 = v1 * sc; u32x4 w; w.x = cvt_pk_bf16(v0[0], v0[1]); w.y = cvt_pk_bf16(v0[2], v0[3]); w.z = cvt_pk_bf16(v1[0], v1[1]); w.w = cvt_pk_bf16(v1[2], v1[3]);
                    *(u32x4*)(rowp + bj * HALF) = w; } }
    }
};

struct EpiRowScaleBf16 {
    static constexpr bool PERM = true, AFTER_DRAIN = false;
    bf16_t* O; int ldc; const float* rs;
    __device__ __forceinline__ void operator()(const f32x4 (&acc)[2][2][4][2], const Unit& u, int wr, int wc, int fr, int fq) const {
        const int row0 = u.pm * BM + wr * 64 + fr; const int col0 = u.pn * BM + wc * 32 + 8 * fq;
#pragma unroll
        for (int ai = 0; ai < 2; ++ai)
#pragma unroll
            for (int m = 0; m < 4; ++m) { const int row = row0 + ai * HALF + m * 16; const float s = rs[row]; bf16_t* rowp = O + (size_t)row * ldc + col0;
#pragma unroll
                for (int bj = 0; bj < 2; ++bj) { const f32x4 v0 = acc[ai][bj][m][0] * s, v1 = acc[ai][bj][m][1] * s;
                    u32x4 w; w.x = cvt_pk_bf16(v0[0], v0[1]); w.y = cvt_pk_bf16(v0[2], v0[3]); w.z = cvt_pk_bf16(v1[0], v1[1]); w.w = cvt_pk_bf16(v1[2], v1[3]);
                    *(u32x4*)(rowp + bj * HALF) = w; } }
    }
};
struct EpiResid {
    static constexpr bool PERM = true, AFTER_DRAIN = false;
    const float* base; float* out; bf16_t* ob; float* ssq; int ldc;
    __device__ __forceinline__ void operator()(const f32x4 (&acc)[2][2][4][2], const Unit& u, int wr, int wc, int fr, int fq) const {
        const int row0 = u.pm * BM + wr * 64 + fr; const int col0 = u.pn * BM + wc * 32 + 8 * fq;
#pragma unroll
        for (int ai = 0; ai < 2; ++ai)
#pragma unroll
            for (int m = 0; m < 4; ++m) { const int row = row0 + ai * HALF + m * 16; const size_t off = (size_t)row * ldc + col0; float ss = 0.f;
#pragma unroll
                for (int bj = 0; bj < 2; ++bj) {
                    const f32x4 b0 = *(const f32x4*)(base + off + bj * HALF), b1 = *(const f32x4*)(base + off + bj * HALF + 4);
                    const f32x4 v0 = acc[ai][bj][m][0] + b0, v1 = acc[ai][bj][m][1] + b1;
                    *(f32x4*)(out + off + bj * HALF) = v0; *(f32x4*)(out + off + bj * HALF + 4) = v1;
                    ss += (v0[0] * v0[0] + v0[1] * v0[1]) + (v0[2] * v0[2] + v0[3] * v0[3]) + (v1[0] * v1[0] + v1[1] * v1[1]) + (v1[2] * v1[2] + v1[3] * v1[3]);
                    if (ob) { u32x4 w; w.x = cvt_pk_bf16(v0[0], v0[1]); w.y = cvt_pk_bf16(v0[2], v0[3]); w.z = cvt_pk_bf16(v1[0], v1[1]); w.w = cvt_pk_bf16(v1[2], v1[3]);
                        *(u32x4*)(ob + off + bj * HALF) = w; } }
                ss += __shfl_xor(ss, 16); ss += __shfl_xor(ss, 32);
                if (fq == 0) atomicAdd(ssq + row, ss); }
    }
};
struct EpiSwiGLU {
    static constexpr bool PERM = true, AFTER_DRAIN = false;
    bf16_t* O; int ldc; const float* ssq; float eps;
    __device__ __forceinline__ void operator()(const f32x4 (&acc)[2][2][4][2], const Unit& u, int wr, int wc, int fr, int fq) const {
        const int row0 = u.pm * BM + wr * 64 + fr; const int col0 = u.pn * HALF + wc * 32 + 8 * fq;
#pragma unroll
        for (int ai = 0; ai < 2; ++ai)
#pragma unroll
            for (int m = 0; m < 4; ++m) { const int row = row0 + ai * HALF + m * 16; const float s = 1.0f / sqrtf(ssq[row] * (1.0f / 1024.0f) + eps);
                float a[8];
#pragma unroll
                for (int n = 0; n < 2; ++n)
#pragma unroll
                    for (int j = 0; j < 4; ++j) { const float g = acc[ai][0][m][n][j] * s, up = acc[ai][1][m][n][j] * s; a[n * 4 + j] = g / (1.0f + __expf(-g)) * up; }
                u32x4 w; w.x = cvt_pk_bf16(a[0], a[1]); w.y = cvt_pk_bf16(a[2], a[3]); w.z = cvt_pk_bf16(a[4], a[5]); w.w = cvt_pk_bf16(a[6], a[7]);
                *(u32x4*)(O + (size_t)row * ldc + col0) = w; }
    }
};
template <class Epi, class Sched, bool ALIGN_EPI = false, bool SP2 = false>
__device__ __forceinline__ void gemm_phase(PG8_LAS unsigned char* lds, const Gemm g, const Sched& S, const Epi& E) {
    const int tid = threadIdx.x, wid = __builtin_amdgcn_readfirstlane(tid >> 6), lane = tid & 63, wr = wid >> 2, wc = wid & 3, fr = lane & 15, fq = lane >> 4;
    const int K = g.K, nt = K / BK;
    unsigned voffA[2], voffB[2];
#pragma unroll
    for (int i = 0; i < 2; ++i) { int R, C; stage_rc(tid * 16 + i * 8192, R, C); const int Rb = Epi::PERM ? ((R & ~31) + perm32(R & 31)) : R;
        voffA[i] = (unsigned)(R * K + C) * 2u; voffB[i] = (unsigned)(Rb * K + C) * 2u; }
    const size_t kstep = (size_t)(BK * 2);
    const size_t hstep = (size_t)HALF * K * 2;
    const size_t tstep = 2 * hstep;
    const unsigned ldsw = (unsigned)wid * 1024u;
    const int aoff = lds_byte(wr * 64 + fr, fq * 8), boff = lds_byte(wc * 32 + fr, fq * 8);
#define PG8_SA(b, h) (((b) * 2 + (h)) * HTB)
#define PG8_SB(b, h) ((4 + (b) * 2 + (h)) * HTB)
#define PG8_STAGE(bufoff, gbase, voff) do { _Pragma("unroll") for (int _i = 0; _i < 2; ++_i) \
        __builtin_amdgcn_global_load_lds((const unsigned*)((const char*)(gbase) + (voff)[_i]), (PG8_LAS unsigned*)(lds + (bufoff) + ldsw + _i * 8192), 16, 0, 0); } while (0)
#define PG8_LDA(dst, b, h) do { _Pragma("unroll") for (int m = 0; m < 4; ++m) _Pragma("unroll") for (int k = 0; k < 2; ++k) dst[m][k] = *(const PG8_LAS bf16x8*)(lds + PG8_SA(b, h) + aoff + m * 2048 + k * 1024); } while (0)
#define PG8_LDB(dst, b, h) do { _Pragma("unroll") for (int n = 0; n < 2; ++n) _Pragma("unroll") for (int k = 0; k < 2; ++k) dst[n][k] = *(const PG8_LAS bf16x8*)(lds + PG8_SB(b, h) + boff + n * 2048 + k * 1024); } while (0)
#define PG8_MMA(ai, bj, At, Bt) do { __builtin_amdgcn_s_setprio(1); _Pragma("unroll") for (int m = 0; m < 4; ++m) _Pragma("unroll") for (int n = 0; n < 2; ++n) _Pragma("unroll") for (int k = 0; k < 2; ++k) \
        acc[ai][bj][m][n] = __builtin_amdgcn_mfma_f32_16x16x32_bf16(Bt[n][k], At[m][k], acc[ai][bj][m][n], 0, 0, 0); __builtin_amdgcn_s_setprio(0); } while (0)
#define PG8_WAIT_V(n) asm volatile("s_waitcnt vmcnt(" #n ")" ::: "memory")
#define PG8_WAIT_L(n) asm volatile("s_waitcnt lgkmcnt(" #n ")" ::: "memory")
#define PG8_BAR __builtin_amdgcn_s_barrier()
#define PG8_SCHED __builtin_amdgcn_sched_barrier(0)
    Unit cur, nxt; int ui = 0;
    if (!S.next(0, cur)) return;
    f32x4 acc[2][2][4][2];
#pragma unroll
    for (int a = 0; a < 2; ++a)
#pragma unroll
        for (int b = 0; b < 2; ++b)
#pragma unroll
            for (int m = 0; m < 4; ++m)
#pragma unroll
                for (int n = 0; n < 2; ++n) acc[a][b][m][n] = (f32x4){0.f, 0.f, 0.f, 0.f};
    bf16x8 At[4][2], B0[2][2], B1[2][2];
    const char* cA = (const char*)g.A + (size_t)cur.pm * tstep; const char* cB = (const char*)g.Bt + (size_t)cur.pn * tstep;
    S.a_ready(cur);
    if constexpr (SP2) {
        PG8_STAGE(PG8_SB(0, 0), cB, voffB); PG8_STAGE(PG8_SB(0, 1), cB + hstep, voffB); PG8_STAGE(PG8_SA(0, 0), cA, voffA); PG8_STAGE(PG8_SA(0, 1), cA + hstep, voffA);
        if (wr == 1) PG8_BAR;
        PG8_WAIT_V(2); PG8_BAR;
        PG8_STAGE(PG8_SB(1, 0), cB + kstep, voffB); PG8_STAGE(PG8_SA(1, 0), cA + kstep, voffA); PG8_STAGE(PG8_SB(1, 1), cB + hstep + kstep, voffB);
        PG8_WAIT_V(6); PG8_BAR;
    } else {
        PG8_STAGE(PG8_SB(0, 0), cB, voffB); PG8_STAGE(PG8_SA(0, 0), cA, voffA); PG8_STAGE(PG8_SB(0, 1), cB + hstep, voffB); PG8_STAGE(PG8_SA(0, 1), cA + hstep, voffA);
        if (wr == 1) PG8_BAR;
        PG8_WAIT_V(4); PG8_BAR;
        PG8_STAGE(PG8_SB(1, 0), cB + kstep, voffB); PG8_STAGE(PG8_SA(1, 0), cA + kstep, voffA); PG8_STAGE(PG8_SB(1, 1), cB + hstep + kstep, voffB);
        PG8_WAIT_V(6); PG8_BAR;
    }
    for (;;) {
        const bool has_next = S.next(ui + 1, nxt);
        const char* nA = has_next ? (const char*)g.A + (size_t)nxt.pm * tstep : cA; const char* nB = has_next ? (const char*)g.Bt + (size_t)nxt.pn * tstep : cB;
        for (int t = 0; t < nt; t += 2) {
            const bool last = (t == nt - 2);
            const char* a1 = cA + (size_t)(t + 1) * kstep;
            const char* a2 = last ? nA : cA + (size_t)(t + 2) * kstep; const char* b2 = last ? nB : cB + (size_t)(t + 2) * kstep;
            const char* a3 = a2 + kstep; const char* b3 = b2 + kstep;
            if (last && has_next) S.a_ready(nxt);
            if constexpr (SP2) {
            PG8_LDB(B0, 0, 0); PG8_LDB(B1, 0, 1); PG8_SCHED; PG8_LDA(At, 0, 0); PG8_STAGE(PG8_SA(1, 1), a1 + hstep, voffA);
            PG8_WAIT_V(8); PG8_WAIT_L(0); PG8_BAR; PG8_MMA(0, 0, At, B0); PG8_MMA(0, 1, At, B1); PG8_BAR; PG8_SCHED;
            PG8_LDA(At, 0, 1); PG8_STAGE(PG8_SB(0, 0), b2, voffB); PG8_STAGE(PG8_SB(0, 1), b2 + hstep, voffB); PG8_STAGE(PG8_SA(0, 0), a2, voffA);
            PG8_WAIT_V(8); PG8_WAIT_L(0); PG8_BAR; PG8_MMA(1, 0, At, B0); PG8_MMA(1, 1, At, B1); PG8_BAR; PG8_SCHED;
            PG8_LDB(B0, 1, 0); PG8_LDB(B1, 1, 1); PG8_SCHED; PG8_LDA(At, 1, 0); PG8_STAGE(PG8_SA(0, 1), a2 + hstep, voffA);
            PG8_WAIT_V(8); PG8_WAIT_L(0); PG8_BAR; PG8_MMA(0, 0, At, B0); PG8_MMA(0, 1, At, B1); PG8_BAR; PG8_SCHED;
            PG8_LDA(At, 1, 1); PG8_STAGE(PG8_SB(1, 0), b3, voffB); PG8_STAGE(PG8_SB(1, 1), b3 + hstep, voffB); PG8_STAGE(PG8_SA(1, 0), a3, voffA);
            PG8_WAIT_V(8); PG8_WAIT_L(0); PG8_BAR; PG8_MMA(1, 0, At, B0); PG8_MMA(1, 1, At, B1); PG8_BAR; PG8_SCHED;
            } else {
            PG8_LDB(B0, 0, 0); PG8_SCHED; PG8_LDA(At, 0, 0); PG8_STAGE(PG8_SA(1, 1), a1 + hstep, voffA);
            PG8_WAIT_L(8); PG8_BAR; PG8_WAIT_L(0); PG8_MMA(0, 0, At, B0); PG8_BAR; PG8_SCHED;
            PG8_LDB(B1, 0, 1); PG8_STAGE(PG8_SB(0, 0), b2, voffB);
            PG8_BAR; PG8_WAIT_L(0); PG8_MMA(0, 1, At, B1); PG8_BAR;
            PG8_LDA(At, 0, 1); PG8_STAGE(PG8_SA(0, 0), a2, voffA);
            PG8_BAR; PG8_WAIT_L(0); PG8_MMA(1, 0, At, B0); PG8_BAR; PG8_SCHED;
            PG8_STAGE(PG8_SB(0, 1), b2 + hstep, voffB);
            PG8_WAIT_V(6); PG8_BAR; PG8_MMA(1, 1, At, B1); PG8_BAR;
            PG8_LDB(B0, 1, 0); PG8_SCHED; PG8_LDA(At, 1, 0); PG8_STAGE(PG8_SA(0, 1), a2 + hstep, voffA);
            PG8_WAIT_L(8); PG8_BAR; PG8_WAIT_L(0); PG8_MMA(0, 0, At, B0); PG8_BAR; PG8_SCHED;
            PG8_LDB(B1, 1, 1); PG8_STAGE(PG8_SB(1, 0), b3, voffB);
            PG8_BAR; PG8_WAIT_L(0); PG8_MMA(0, 1, At, B1); PG8_BAR;
            PG8_LDA(At, 1, 1); PG8_STAGE(PG8_SA(1, 0), a3, voffA);
            PG8_BAR; PG8_WAIT_L(0); PG8_MMA(1, 0, At, B0); PG8_BAR; PG8_SCHED;
            PG8_STAGE(PG8_SB(1, 1), b3 + hstep, voffB);
            PG8_WAIT_V(6); PG8_BAR; PG8_MMA(1, 1, At, B1); PG8_BAR;
            }
        }
        if constexpr (ALIGN_EPI) { if (wr == 0) PG8_BAR; }
        if constexpr (!Epi::AFTER_DRAIN) { E(acc, cur, wr, wc, fr, fq); S.done(cur); }
        if (!has_next) break;
#pragma unroll
        for (int a = 0; a < 2; ++a)
#pragma unroll
            for (int b = 0; b < 2; ++b)
#pragma unroll
                for (int m = 0; m < 4; ++m)
#pragma unroll
                    for (int n = 0; n < 2; ++n) acc[a][b][m][n] = (f32x4){0.f, 0.f, 0.f, 0.f};
        cur = nxt; cA = nA; cB = nB; ++ui;
        if constexpr (ALIGN_EPI) { if (wr == 1) PG8_BAR; }
    }
    PG8_WAIT_V(0);
    if constexpr (!ALIGN_EPI) { if (wr == 0) PG8_BAR; }
    PG8_BAR;
    if constexpr (Epi::AFTER_DRAIN) { E.fused(acc, cur, wr, wc, fr, fq, lds, wid, lane); S.done(cur); }
#undef PG8_SA
#undef PG8_SB
#undef PG8_STAGE
#undef PG8_LDA
#undef PG8_LDB
#undef PG8_MMA
#undef PG8_WAIT_V
#undef PG8_WAIT_L
#undef PG8_BAR
#undef PG8_SCHED
}
}

#ifndef PG8_SP2
#define PG8_SP2 true
#endif
#ifndef PG8_ALIGN
#define PG8_ALIGN true
#endif

constexpr int NWAVES = 8;
constexpr int BATCH = 2, T = 8192, D = 1024, M = BATCH * T;
constexpr int NIN = 3096, NMAIN = 3072, DFF = 2816, NGU = 2 * DFF;
constexpr int C_R = 0, C_K = 512, C_V = 1024, C_DW = 1536, C_DA = 1600, C_DG = 1664, C_Q = 1792, C_KC = 2304, C_VC = 2432, C_KS = 2560, C_VS = 2688, C_KW = 2816, C_VW = 2944, C_GL = 3072;
constexpr int NCMP = 511, NCMPP = 512;
constexpr float NORM_EPS = 1e-6f, GN_EPS = 64e-5f, NEGV = -1e30f, BIGV = 1e30f;

constexpr size_t MiB = 1u << 20;
constexpr size_t WS_CTL = 0, CTL_ZERO_BYTES = 1 * MiB;
constexpr size_t WS_WIN = 2 * MiB;
constexpr size_t WS_WOUT = 9 * MiB;
constexpr size_t WS_WGU = 11 * MiB;
constexpr size_t WS_WD = 22 * MiB;
constexpr size_t WS_RSTD1 = 28 * MiB;
constexpr size_t WS_GATES = 28 * MiB + 256 * 1024;
constexpr size_t WS_CMP = 30 * MiB;
constexpr size_t WS_LORA = 31 * MiB;
constexpr size_t WS_XB = 32 * MiB;
constexpr size_t WS_PB = 64 * MiB;
constexpr size_t WS_HB = 160 * MiB;
constexpr size_t WS_G = 192 * MiB;
constexpr size_t WS_VS = 224 * MiB;
constexpr size_t WS_BONUS = 240 * MiB;
constexpr size_t WS_VT = 242 * MiB;
constexpr size_t WS_CW1T = 250 * MiB;
constexpr size_t WS_CW2T = 252 * MiB;
constexpr size_t WS_END = 256 * MiB;
constexpr int CW_BAR = 4096;
constexpr int CW_SSQ2 = 65536;
constexpr int CW_SSQ3 = 65536 + 16384;
constexpr int CW_QUEUE = 2048;
constexpr int CW_BIAS1 = 3072;
static_assert((CW_SSQ3 + 16384) * 4 <= (int)CTL_ZERO_BYTES, "ctl");

constexpr int RING_OFF = 0, RING_BYTES = 131072;
constexpr int LDSCTL_OFF = RING_BYTES, MISC_OFF = LDSCTL_OFF + 320;
constexpr int LDS_BYTES = 147456;
#define GAS __attribute__((address_space(1)))
#define LAS __attribute__((address_space(3)))
typedef unsigned short bf16;
typedef unsigned v4u __attribute__((ext_vector_type(4)));
typedef float f32x4 __attribute__((ext_vector_type(4)));
typedef short bf16x8 __attribute__((ext_vector_type(8)));
typedef GAS unsigned gu32;
typedef GAS unsigned long long gu64;
#define RLX_AGENT __ATOMIC_RELAXED, __HIP_MEMORY_SCOPE_AGENT
#define LDS_WAIT() asm volatile("s_waitcnt lgkmcnt(0)" ::: "memory")
#define VM_WAIT() asm volatile("s_waitcnt vmcnt(0)" ::: "memory")
__device__ __forceinline__ unsigned long long rt() { return __builtin_amdgcn_s_memrealtime(); }
__device__ __forceinline__ unsigned f2bf(float f) { unsigned u = __builtin_bit_cast(unsigned, f); return (u + 0x7fffu + ((u >> 16) & 1u)) >> 16; }
__device__ __forceinline__ unsigned pk2(float lo, float hi) { return f2bf(lo) | (f2bf(hi) << 16); }

#define XB_TMO      128
#define XB_XCNT(j)  (256  + 64 * (j))
#define XB_XSUB(j)  (1280 + 64 * (j))
#define XB_XGEN(j)  (2304 + 64 * (j))
#define XB_TOP      3328
#define XB_TOPGEN   3392
#define XCD_BAR_WORDS 3456
#define XB_SPIN_CAP (1u << 18)

__device__ __forceinline__ unsigned xb_ld(unsigned* p)              { return __hip_atomic_load(p, __ATOMIC_RELAXED, __HIP_MEMORY_SCOPE_AGENT); }
__device__ __forceinline__ unsigned xb_add(unsigned* p, unsigned v) { return __hip_atomic_fetch_add(p, v, __ATOMIC_RELAXED, __HIP_MEMORY_SCOPE_AGENT); }
__device__ __forceinline__ unsigned xb_xcc_id() { return (unsigned)__builtin_amdgcn_s_getreg((3 << 11) | 20) & 0xFu; }
#define XB_SPIN(cond, bar) do { unsigned _sp = 0; while (cond) { __builtin_amdgcn_s_sleep(1); \
    if ((++_sp & 255u) == 0u) { if (xb_ld(&(bar)[XB_TMO])) break; if (_sp > XB_SPIN_CAP) { atomicAdd(&(bar)[XB_TMO], 1u); break; } } } } while (0)

struct XcdBarrier {
    unsigned* bar; unsigned x;
    volatile LAS unsigned* st;
};

__device__ __forceinline__ XcdBarrier xcd_barrier_post(unsigned* bar, volatile LAS unsigned* st) {
    XcdBarrier b; b.bar = bar; b.x = xb_xcc_id(); b.st = st;
    if (threadIdx.x == 0) (void)xb_add(&bar[XB_XCNT(b.x)], 1u);
    return b;
}
__device__ __forceinline__ void xcd_barrier_complete(unsigned* bar, unsigned x, unsigned& nloc, unsigned& nx) {
    const unsigned G = gridDim.x * gridDim.y * gridDim.z;
    unsigned sum, cnt, mine, sp = 0u;
    for (;;) {
        sum = 0u; cnt = 0u; mine = 0u;
#pragma unroll
        for (unsigned j = 0; j < 16; ++j) { const unsigned c = xb_ld(&bar[XB_XCNT(j)]); sum += c; cnt += (c > 0u) ? 1u : 0u; mine = (j == x) ? c : mine; }
        if (sum == G) break;
        __builtin_amdgcn_s_sleep(1);
        if ((++sp & 255u) == 0u) { if (xb_ld(&bar[XB_TMO])) break; if (sp > XB_SPIN_CAP) { atomicAdd(&bar[XB_TMO], 1u); break; } }
    }
    nloc = mine > 0u ? mine : 1u; nx = cnt > 0u ? cnt : 1u;
}

__device__ __forceinline__ void xcd_barrier(const XcdBarrier& b) {
    asm volatile("s_waitcnt vmcnt(0)" ::: "memory");
    __syncthreads();
    if (threadIdx.x == 0) {
        unsigned* bar = b.bar;
        __builtin_amdgcn_s_waitcnt(0);
        unsigned nloc = b.st[0], nx = b.st[1];
        if (nloc == 0u) { xcd_barrier_complete(bar, b.x, nloc, nx); b.st[0] = nloc; b.st[1] = nx; }
        const unsigned old = xb_add(&bar[XB_XSUB(b.x)], 1u);
        const unsigned gen = old / nloc;
        if (old + 1u == (gen + 1u) * nloc) {
            __builtin_amdgcn_fence(__ATOMIC_RELEASE, "agent");
            asm volatile("s_waitcnt vmcnt(0)" ::: "memory");
            const unsigned og = xb_add(&bar[XB_TOP], 1u);
            const unsigned tg = og / nx;
            if (og + 1u == (tg + 1u) * nx) xb_add(&bar[XB_TOPGEN], 1u);
            else XB_SPIN(xb_ld(&bar[XB_TOPGEN]) == tg, bar);
            __builtin_amdgcn_fence(__ATOMIC_ACQUIRE, "agent");
            xb_add(&bar[XB_XGEN(b.x)], 1u);
            asm volatile("s_waitcnt vmcnt(0)" ::: "memory");
        } else {
            XB_SPIN(xb_ld(&bar[XB_XGEN(b.x)]) == gen, bar);
            __builtin_amdgcn_fence(__ATOMIC_ACQUIRE, "agent");
            asm volatile("s_waitcnt vmcnt(0)" ::: "memory");
        }
    }
    __syncthreads();
}


struct Frame {
    LAS unsigned char* lds;
    volatile LAS unsigned* MISC;
    gu32* ctl;
    int tid, lane, wave;
    int vcu, G;
    const float* in[26];
    float* out; unsigned char* ws;
};
__device__ __forceinline__ float wave_sum(float v) {
#pragma unroll
    for (int o = 1; o < 64; o <<= 1) v += __shfl_xor(v, o);
    return v;
}
__device__ __forceinline__ float wave_max(float v) {
#pragma unroll
    for (int o = 1; o < 64; o <<= 1) v = fmaxf(v, __shfl_xor(v, o));
    return v;
}
__device__ __forceinline__ float bf2f(bf16 b) { return __builtin_bit_cast(float, (unsigned)b << 16); }
__device__ __forceinline__ float sigmoidf_(float x) { return 1.0f / (1.0f + expf(-x)); }
__device__ __forceinline__ float softplusf_(float z) { return z > 20.f ? z : log1pf(expf(z)); }
__device__ __forceinline__ float fexp_(float x) { return __builtin_amdgcn_exp2f(x * 1.4426950408889634f); }
__device__ __forceinline__ float frcp_(float x) { return __builtin_amdgcn_rcpf(x); }
__device__ __forceinline__ float fsigmoid_(float x) { return frcp_(1.0f + fexp_(-x)); }
__device__ __forceinline__ float ftanh_(float x) { return 1.0f - 2.0f * frcp_(1.0f + fexp_(2.0f * x)); }
__device__ __forceinline__ float fsoftplus_(float z) { return z > 15.f ? z : __builtin_amdgcn_logf(1.0f + fexp_(z)) * 0.6931471805599453f; }
__device__ __forceinline__ float fgelu_tanh_(float x) { const float u = 0.7978845608028654f * (x + 0.044715f * x * x * x); return 0.5f * x * (1.0f + ftanh_(u)); }
__device__ __forceinline__ float gelu_tanhf_(float x) { const float u = 0.7978845608028654f * (x + 0.044715f * x * x * x); return 0.5f * x * (1.0f + tanhf(u)); }

template <int MODE  >
__device__ __forceinline__ void p0_transpose_item(const float* W, int K, int N, const float* gain, bf16* WT, LAS float* scr, int item, int lane) {
    const int nblk = (N + 31) / 32, kb = item / nblk, nb = item % nblk, k0 = 64 * kb, n0 = 32 * nb;
#pragma unroll 8
    for (int i = 0; i < 32; ++i) { const int kk = 2 * i + (lane >> 5); const int n = n0 + (lane & 31);
        float v = 0.f; if (n < N) { v = W[(size_t)(k0 + kk) * N + n]; if (gain) v *= gain[k0 + kk]; }
        scr[kk * 33 + (lane & 31)] = v; }
    LDS_WAIT(); asm volatile("" ::: "memory");
    const int c = lane & 7;
    int rb = n0; if (MODE == 1) rb = 256 * (n0 / 128) + (n0 % 128); if (MODE == 2) rb = 256 * (n0 / 128) + 128 + (n0 % 128);
#pragma unroll
    for (int j = 0; j < 4; ++j) { const int n = (lane >> 3) + 8 * j; const LAS float* s = scr + (8 * c) * 33 + n;
        v4u o; o.x = pk2(s[0 * 33], s[1 * 33]); o.y = pk2(s[2 * 33], s[3 * 33]); o.z = pk2(s[4 * 33], s[5 * 33]); o.w = pk2(s[6 * 33], s[7 * 33]);
        *(GAS v4u*)(WT + (size_t)(rb + n) * K + k0 + 8 * c) = o; }
    LDS_WAIT(); asm volatile("" ::: "memory");
}
__device__ __forceinline__ void p0_prologue(Frame& F) {
    LAS float* scr = (LAS float*)(F.lds + RING_OFF + F.wave * 16384);
    const int gw = F.vcu * NWAVES + F.wave, NGW = F.G * NWAVES;
    constexpr int I_IN = (D / 64) * ((NIN + 31) / 32), I_OUT = (D / 64) * (D / 32), I_G = (D / 64) * (DFF / 32), I_D = (DFF / 64) * (D / 32);
    constexpr int I_L = 16, I_LG = 32;
    constexpr int I_C1 = (2048 / 64) * (256 / 32), I_C2 = (256 / 64) * (64 / 32), I_B1 = 64;
    constexpr int NITEMS = I_IN + I_OUT + 2 * I_G + I_D + 2 * I_L + I_LG + 2 * I_C1 + 2 * I_C2 + I_B1;
    bf16* CW1T = (bf16*)(F.ws + WS_CW1T); bf16* CW2T = (bf16*)(F.ws + WS_CW2T);
    bf16* W2T = (bf16*)(F.ws + WS_LORA); bf16* A2T = W2T + 512 * 64; bf16* G2T = A2T + 512 * 64;
    bf16* Win_t = (bf16*)(F.ws + WS_WIN); bf16* Wout_t = (bf16*)(F.ws + WS_WOUT); bf16* Wgu_t = (bf16*)(F.ws + WS_WGU); bf16* Wd_t = (bf16*)(F.ws + WS_WD);
    for (int it = gw; it < NITEMS; it += NGW) {
        int r = it;
        if (r < I_IN) { p0_transpose_item<0>(F.in[2], D, NIN, F.in[1], Win_t, scr, r, F.lane); continue; } r -= I_IN;
        if (r < I_OUT) { p0_transpose_item<0>(F.in[20], D, D, nullptr, Wout_t, scr, r, F.lane); continue; } r -= I_OUT;
        if (r < I_G) { p0_transpose_item<1>(F.in[22], D, DFF, F.in[21], Wgu_t, scr, r, F.lane); continue; } r -= I_G;
        if (r < I_G) { p0_transpose_item<2>(F.in[23], D, DFF, F.in[21], Wgu_t, scr, r, F.lane); continue; } r -= I_G;
        if (r < I_D) { p0_transpose_item<0>(F.in[24], DFF, D, nullptr, Wd_t, scr, r, F.lane); continue; } r -= I_D;
        if (r < I_L) { p0_transpose_item<0>(F.in[5], 64, 512, nullptr, W2T, scr, r, F.lane); continue; } r -= I_L;
        if (r < I_L) { p0_transpose_item<0>(F.in[7], 64, 512, nullptr, A2T, scr, r, F.lane); continue; } r -= I_L;
        if (r < I_LG) { p0_transpose_item<0>(F.in[8], 128, 512, nullptr, G2T, scr, r, F.lane); continue; } r -= I_LG;
        if (r < I_C1) { p0_transpose_item<0>(F.in[16], 2048, 256, nullptr, CW1T, scr, r, F.lane); continue; } r -= I_C1;
        if (r < I_C1) { p0_transpose_item<0>(F.in[18], 2048, 256, nullptr, CW1T + 256 * 2048, scr, r, F.lane); continue; } r -= I_C1;
        if (r < I_C2) { p0_transpose_item<0>(F.in[17], 256, 64, nullptr, CW2T, scr, r, F.lane); continue; } r -= I_C2;
        if (r < I_C2) { p0_transpose_item<0>(F.in[19], 256, 64, nullptr, CW2T + 64 * 256, scr, r, F.lane); continue; } r -= I_C2;
        { const int kv = r >> 5, ng = (r >> 3) & 3, kp = r & 7; const float* pe = kv ? F.in[15] : F.in[14]; const float* W1 = kv ? F.in[18] : F.in[16];
          float a = 0.f; const int n = ng * 64 + F.lane;
#pragma unroll 8
          for (int k = kp * 256; k < kp * 256 + 256; ++k) a += pe[k] * W1[(size_t)k * 256 + n];
          atomicAdd((float*)(F.ctl + CW_BIAS1) + kv * 256 + n, a); }
    }
    bf16* XB = (bf16*)(F.ws + WS_XB); float* rstd1 = (float*)(F.ws + WS_RSTD1);
    for (int m = gw; m < M; m += NGW) {
        const GAS f32x4* xr = (const GAS f32x4*)(F.in[0] + (size_t)m * D) + F.lane;
        f32x4 v[4]; float s = 0.f;
#pragma unroll
        for (int j = 0; j < 4; ++j) { v[j] = xr[64 * j]; s += (v[j].x * v[j].x + v[j].y * v[j].y) + (v[j].z * v[j].z + v[j].w * v[j].w); }
        const float tot = wave_sum(s);
        GAS unsigned long long* o8 = (GAS unsigned long long*)(XB + (size_t)m * D) + F.lane;
#pragma unroll
        for (int j = 0; j < 4; ++j) o8[64 * j] = (unsigned long long)pk2(v[j].x, v[j].y) | ((unsigned long long)pk2(v[j].z, v[j].w) << 32);
        if (F.lane == 0) rstd1[m] = 1.0f / sqrtf(tot * (1.0f / D) + NORM_EPS);
    }
}

__device__ __forceinline__ void p2_gates_naive(Frame& F) {
    const int gw = F.vcu * NWAVES + F.wave, NGW = F.G * NWAVES, lane = F.lane;
    const bf16* XB = (const bf16*)(F.ws + WS_XB); const bf16* Wg = (const bf16*)(F.ws + WS_WIN) + (size_t)C_GL * D; const float* rstd1 = (const float*)(F.ws + WS_RSTD1);
    float* gates = (float*)(F.ws + WS_GATES);
    for (int m = gw; m < M; m += NGW) {
        float xv[16];
        { const bf16x8 a = *(const bf16x8*)(XB + (size_t)m * D + lane * 16), b = *(const bf16x8*)(XB + (size_t)m * D + lane * 16 + 8);
#pragma unroll
          for (int j = 0; j < 8; ++j) { xv[j] = bf2f((bf16)a[j]); xv[8 + j] = bf2f((bf16)b[j]); } }
        const float rs = rstd1[m];
        float mine = 0.f;
        for (int j = 0; j < 24; ++j) {
            const bf16x8 a = *(const bf16x8*)(Wg + (size_t)j * D + lane * 16), b = *(const bf16x8*)(Wg + (size_t)j * D + lane * 16 + 8);
            float s = 0.f;
#pragma unroll
            for (int q = 0; q < 8; ++q) { s += xv[q] * bf2f((bf16)a[q]); s += xv[8 + q] * bf2f((bf16)b[q]); }
            s = wave_sum(s);
            if (lane == j) mine = s;
        }
        if (lane < 24) gates[(size_t)m * 24 + lane] = sigmoidf_(mine * rs);
    }
}
__device__ __forceinline__ void p2_rwkv_prep_naive(Frame& F) {
    LAS float* L = (LAS float*)(F.lds + RING_OFF);
    const bf16* PB = (const bf16*)(F.ws + WS_PB);
    const float* mu = F.in[3]; const float* w0 = F.in[4]; const float* w2 = F.in[5]; const float* a0 = F.in[6]; const float* a2 = F.in[7]; const float* g2 = F.in[8];
    float* wdec = F.out; float* asig = F.out + (size_t)M * 512; float* gg = (float*)(F.ws + WS_G);
    const int c = F.tid;
    for (int it = F.vcu; it < M / 16; it += F.G) {
        const int r0 = it * 16;
        for (int idx = F.tid; idx < 16 * 256; idx += NWAVES * 64) {
            const int tok = idx >> 8, j = idx & 255; const int row = r0 + tok; const int col = C_DW + j;
            const float p = bf2f(PB[(size_t)row * NMAIN + col]);
            const float pp = ((row % T) == 0) ? 0.f : bf2f(PB[(size_t)(row - 1) * NMAIN + col]);
            const float ps = p + mu[col] * (pp - p);
            L[tok * 256 + j] = (j < 64) ? tanhf(ps) : (j < 128 ? ps : sigmoidf_(ps));
        }
        __syncthreads();
        float aw[16], aa[16], ag[16];
#pragma unroll
        for (int k = 0; k < 16; ++k) { aw[k] = 0.f; aa[k] = 0.f; ag[k] = 0.f; }
        for (int j = 0; j < 64; ++j) { const float w = w2[j * 512 + c], a = a2[j * 512 + c];
#pragma unroll
            for (int k = 0; k < 16; ++k) { aw[k] += L[k * 256 + j] * w; aa[k] += L[k * 256 + 64 + j] * a; } }
        for (int j = 0; j < 128; ++j) { const float g = g2[j * 512 + c];
#pragma unroll
            for (int k = 0; k < 16; ++k) ag[k] += L[k * 256 + 128 + j] * g; }
        const float w0c = w0[c], a0c = a0[c];
#pragma unroll
        for (int k = 0; k < 16; ++k) { const size_t o = (size_t)(r0 + k) * 512 + c;
            const float wl = -softplusf_(-(w0c + aw[k])) - 0.5f;
            wdec[o] = expf(-expf(wl)); asig[o] = sigmoidf_(a0c + aa[k]); gg[o] = ag[k]; }
        __syncthreads();
    }
}
__device__ __forceinline__ void p2_compress_naive(Frame& F) {
    LAS float* X = (LAS float*)(F.lds + RING_OFF);
    LAS float* PE = X + 144 * 64;
    LAS float* HID = PE + 2048;
    const bf16* PB = (const bf16*)(F.ws + WS_PB);
    for (int it = F.vcu; it < 2 * 2 * 2 * 64; it += F.G) {
        const int kv = it >> 8, b = (it >> 7) & 1, hk = (it >> 6) & 1, c0 = (it & 63) * 8;
        const float* pe = kv ? F.in[15] : F.in[14]; const float* W1 = kv ? F.in[18] : F.in[16]; const float* W2 = kv ? F.in[19] : F.in[17];
        const int col = (kv ? C_VC : C_KC) + hk * 64;
        for (int idx = F.tid; idx < 144 * 64; idx += NWAVES * 64) { const int tok = idx >> 6, d = idx & 63; const int t = 16 * c0 + tok;
            X[idx] = (t < T) ? bf2f(PB[(size_t)(b * T + t) * NMAIN + col + d]) : 0.f; }
        for (int idx = F.tid; idx < 2048; idx += NWAVES * 64) PE[idx] = pe[idx];
        __syncthreads();
        { const int n = F.tid & 255, half = F.tid >> 8; float acc[4] = {0.f, 0.f, 0.f, 0.f};
          for (int k = 0; k < 2048; ++k) { const float w = W1[(size_t)k * 256 + n]; const int l = k >> 6, d = k & 63; const float pev = PE[k];
#pragma unroll
              for (int jj = 0; jj < 4; ++jj) acc[jj] += (X[((4 * half + jj) * 16 + l) * 64 + d] + pev) * w; }
#pragma unroll
          for (int jj = 0; jj < 4; ++jj) HID[(4 * half + jj) * 256 + n] = gelu_tanhf_(acc[jj]); }
        __syncthreads();
        { const int blk = F.tid >> 6, j = F.tid & 63; float s = 0.f;
          for (int n = 0; n < 256; ++n) s += HID[blk * 256 + n] * W2[n * 64 + j];
          const int c = c0 + blk; const int bhk = b * 2 + hk; const bf16 ov = (c < NCMP) ? (bf16)f2bf(s) : (bf16)0; const int pc = (c & ~15) | (((c >> 2) & 1) << 3) | (((c >> 3) & 1) << 2) | (c & 3);
          if (kv == 0) ((bf16*)(F.ws + WS_CMP))[((size_t)bhk * NCMPP + c) * 64 + j] = ov; else ((bf16*)(F.ws + WS_CMP + 262144))[((size_t)bhk * 64 + j) * NCMPP + pc] = ov; }
        __syncthreads();
    }
}
__device__ __forceinline__ void p3_rwkv_scan_naive(Frame& F, int b, int h) {
    const bf16* PB = (const bf16*)(F.ws + WS_PB); const float* wdec = F.out; const float* asig = F.out + (size_t)M * 512; float* yraw = (float*)(F.ws + WS_HB);
    const float* mu = F.in[3]; const float* k_k = F.in[9]; const float* k_a = F.in[10];
    const int lane = F.lane, vl = lane >> 3, kq = lane & 7, v = F.wave * 8 + vl, ch0 = h * 64 + kq * 8;
    float S[8], mur[8], muk[8], kkp[8], kap[8], pr[8], pk[8];
#pragma unroll
    for (int j = 0; j < 8; ++j) { S[j] = 0.f; mur[j] = mu[C_R + ch0 + j]; muk[j] = mu[C_K + ch0 + j]; kkp[j] = k_k[ch0 + j]; kap[j] = k_a[ch0 + j]; pr[j] = 0.f; pk[j] = 0.f; }
    const float muv = mu[C_V + h * 64 + v]; float pv = 0.f;
    const size_t row0 = (size_t)b * T;
    bf16x8 nr = *(const bf16x8*)(PB + row0 * NMAIN + C_R + ch0), nk = *(const bf16x8*)(PB + row0 * NMAIN + C_K + ch0);
    bf16 nv = PB[row0 * NMAIN + C_V + h * 64 + v];
    f32x4 nw0 = *(const f32x4*)(wdec + row0 * 512 + ch0), nw1 = *(const f32x4*)(wdec + row0 * 512 + ch0 + 4);
    f32x4 na0 = *(const f32x4*)(asig + row0 * 512 + ch0), na1 = *(const f32x4*)(asig + row0 * 512 + ch0 + 4);
    for (int t = 0; t < T; ++t) {
        const size_t row = row0 + t;
        const bf16x8 cr8 = nr, ck8 = nk; const bf16 cvb = nv; const f32x4 w0 = nw0, w1 = nw1, a0 = na0, a1 = na1;
        if (t + 1 < T) { const size_t rn = row + 1;
            nr = *(const bf16x8*)(PB + rn * NMAIN + C_R + ch0); nk = *(const bf16x8*)(PB + rn * NMAIN + C_K + ch0); nv = PB[rn * NMAIN + C_V + h * 64 + v];
            nw0 = *(const f32x4*)(wdec + rn * 512 + ch0); nw1 = *(const f32x4*)(wdec + rn * 512 + ch0 + 4);
            na0 = *(const f32x4*)(asig + rn * 512 + ch0); na1 = *(const f32x4*)(asig + rn * 512 + ch0 + 4); }
        float r[8], k[8], kk[8], wd[8], as[8];
        float ss = 0.f;
#pragma unroll
        for (int j = 0; j < 8; ++j) { const float cr = bf2f((bf16)cr8[j]), ck = bf2f((bf16)ck8[j]);
            r[j] = cr + mur[j] * (pr[j] - cr); k[j] = ck + muk[j] * (pk[j] - ck); pr[j] = cr; pk[j] = ck;
            wd[j] = j < 4 ? w0[j] : w1[j - 4]; as[j] = j < 4 ? a0[j] : a1[j - 4];
            kk[j] = k[j] * kkp[j]; ss += kk[j] * kk[j]; }
        const float cv = bf2f(cvb); const float vv = cv + muv * (pv - cv); pv = cv;
        ss += __shfl_xor(ss, 1); ss += __shfl_xor(ss, 2); ss += __shfl_xor(ss, 4);
        const float inv = 1.0f / fmaxf(sqrtf(ss), 1e-12f);
        float sa = 0.f;
#pragma unroll
        for (int j = 0; j < 8; ++j) { kk[j] *= inv; sa += S[j] * (-kk[j]); }
        sa += __shfl_xor(sa, 1); sa += __shfl_xor(sa, 2); sa += __shfl_xor(sa, 4);
        float y = 0.f;
#pragma unroll
        for (int j = 0; j < 8; ++j) { const float km = k[j] * (1.0f + (as[j] - 1.0f) * kap[j]);
            S[j] = S[j] * wd[j] + sa * (kk[j] * as[j]) + vv * km; y += S[j] * r[j]; }
        y += __shfl_xor(y, 1); y += __shfl_xor(y, 2); y += __shfl_xor(y, 4);
        if (kq == 0) yraw[row * 512 + h * 64 + v] = y;
    }
}
__device__ __forceinline__ void p3b_rwkv_out_naive(Frame& F) {
    const int gw = F.vcu * NWAVES + F.wave, NGW = F.G * NWAVES, lane = F.lane;
    const bf16* PB = (const bf16*)(F.ws + WS_PB); const float* asig = F.out + (size_t)M * 512; const float* yraw = (const float*)(F.ws + WS_HB); const float* gg = (const float*)(F.ws + WS_G);
    bf16* Y = (bf16*)(F.ws + WS_XB);
    const float* mu = F.in[3]; const float* k_a = F.in[10]; const float* r_k = F.in[11]; const float* lnw = F.in[12]; const float* lnb = F.in[13];
    for (int it = gw; it < M * 8; it += NGW) {
        const int row = it >> 3, h = it & 7, ch = h * 64 + lane;
        const float yv = yraw[(size_t)row * 512 + ch];
        const float mean = wave_sum(yv) * (1.0f / 64.0f); const float d = yv - mean; const float var = wave_sum(d * d) * (1.0f / 64.0f);
        const float yn = d * (1.0f / sqrtf(var + GN_EPS)) * lnw[ch] + lnb[ch];
        const bool first = (row % T) == 0;
        const float cr = bf2f(PB[(size_t)row * NMAIN + C_R + ch]), ck = bf2f(PB[(size_t)row * NMAIN + C_K + ch]), cv = bf2f(PB[(size_t)row * NMAIN + C_V + ch]);
        const float qr = first ? 0.f : bf2f(PB[(size_t)(row - 1) * NMAIN + C_R + ch]), qk = first ? 0.f : bf2f(PB[(size_t)(row - 1) * NMAIN + C_K + ch]), qv = first ? 0.f : bf2f(PB[(size_t)(row - 1) * NMAIN + C_V + ch]);
        const float r = cr + mu[C_R + ch] * (qr - cr), k = ck + mu[C_K + ch] * (qk - ck), vv = cv + mu[C_V + ch] * (qv - cv);
        const float as = asig[(size_t)row * 512 + ch]; const float km = k * (1.0f + (as - 1.0f) * k_a[ch]);
        const float bonus = wave_sum(r * km * r_k[ch]) * vv;
        const float o = (yn + bonus) * gg[(size_t)row * 512 + ch];
        Y[(size_t)row * D + ch] = (bf16)f2bf(o);
    }
}
__device__ __forceinline__ float dot64_lds_bf16row(const LAS float* qs, const bf16* krow) {
    float s = 0.f;
#pragma unroll
    for (int i = 0; i < 8; ++i) { const bf16x8 kv = *(const bf16x8*)(krow + 8 * i); const f32x4 q0 = *(const LAS f32x4*)(qs + 8 * i), q1 = *(const LAS f32x4*)(qs + 8 * i + 4);
        s += q0[0] * bf2f((bf16)kv[0]) + q0[1] * bf2f((bf16)kv[1]) + q0[2] * bf2f((bf16)kv[2]) + q0[3] * bf2f((bf16)kv[3]);
        s += q1[0] * bf2f((bf16)kv[4]) + q1[1] * bf2f((bf16)kv[5]) + q1[2] * bf2f((bf16)kv[6]) + q1[3] * bf2f((bf16)kv[7]); }
    return s;
}
__device__ __forceinline__ float dot64_lds_f32row(const LAS float* qs, const float* krow) {
    float s = 0.f;
#pragma unroll
    for (int i = 0; i < 16; ++i) { const f32x4 kv = *(const f32x4*)(krow + 4 * i); const f32x4 q = *(const LAS f32x4*)(qs + 4 * i); s += q[0] * kv[0] + q[1] * kv[1] + q[2] * kv[2] + q[3] * kv[3]; }
    return s;
}
#define WAVE_LDS_FENCE() asm volatile("s_waitcnt lgkmcnt(0)" ::: "memory")
__device__ __forceinline__ void nsa_token_naive(Frame& F, int b, int hk, int t, LAS float* wl) {
    LAS float* qs = wl; LAS float* pbuf = wl + 64; LAS float* ocb = wl + 64 + 1024; LAS int* seli = (LAS int*)(wl + 64 + 1024 + 256);
    const int lane = F.lane; const size_t row = (size_t)b * T + t; const int cur = t >> 6;
    const bf16* PB = (const bf16*)(F.ws + WS_PB); const float* CMPK = (const float*)(F.ws + WS_CMP) + (size_t)((0 * 2 + b) * 2 + hk) * NCMPP * 64;
    const float* CMPV = (const float*)(F.ws + WS_CMP) + (size_t)((1 * 2 + b) * 2 + hk) * NCMPP * 64;
    const float* gates = (const float*)(F.ws + WS_GATES); bf16* Y = (bf16*)(F.ws + WS_XB);
    const int nvc = t >= 31 ? ((t - 31) >> 4) + 1 : 0;
    float imp0 = 0.f, imp1 = 0.f;
    for (int g = 0; g < 4; ++g) {
        const int h = hk * 4 + g; const float slope = exp2f(-(float)(h + 1));
        WAVE_LDS_FENCE();
        qs[lane] = bf2f(PB[row * NMAIN + C_Q + h * 64 + lane]) * 0.125f;
        WAVE_LDS_FENCE();
        float o = 0.f;
        if (nvc > 0) {
            float m = -INFINITY;
            for (int c = lane; c < nvc; c += 64) { const float s = dot64_lds_f32row(qs, CMPK + (size_t)c * 64) - slope * (float)(t - (16 * c + 31)); pbuf[c] = s; m = fmaxf(m, s); }
            m = wave_max(m); float l = 0.f;
            for (int c = lane; c < nvc; c += 64) { const float e = expf(pbuf[c] - m); pbuf[c] = e; l += e; }
            l = wave_sum(l); const float inv = 1.0f / l;
            for (int c = lane; c < nvc; c += 64) pbuf[c] *= inv;
            WAVE_LDS_FENCE();
#pragma unroll
            for (int hh = 0; hh < 2; ++hh) { const int n = lane + 64 * hh; float s = 0.f;
#pragma unroll
                for (int j = -1; j < 4; ++j) { const int c = 4 * n + j; if (c >= 0 && c < nvc) s += pbuf[c] * ((j == -1 || j == 3) ? 1.f : 2.f); }
                if (hh == 0) imp0 += s; else imp1 += s; }
            for (int c = 0; c < nvc; ++c) o += pbuf[c] * CMPV[(size_t)c * 64 + lane];
        }
        ocb[g * 64 + lane] = o;
    }
    {
        float v0 = (lane > cur) ? NEGV : ((lane == 0 || lane == cur || lane == cur - 1) ? BIGV : imp0);
        const int n1 = lane + 64;
        float v1 = (n1 > cur) ? NEGV : ((n1 == cur || n1 == cur - 1) ? BIGV : imp1);
        for (int it = 0; it < 16; ++it) {
            const float m = wave_max(fmaxf(v0, v1));
            const unsigned long long b0 = __ballot(v0 == m);
            int idx;
            if (b0) { idx = __builtin_ctzll(b0); if (lane == idx) v0 = -INFINITY; }
            else { const unsigned long long b1 = __ballot(v1 == m); idx = 64 + __builtin_ctzll(b1); if (lane == idx - 64) v1 = -INFINITY; }
            if (lane == 0) seli[it] = (m > 0.5f * NEGV) ? idx : -1;
        }
        WAVE_LDS_FENCE();
    }
    for (int g = 0; g < 4; ++g) {
        const int h = hk * 4 + g; const float slope = exp2f(-(float)(h + 1));
        WAVE_LDS_FENCE();
        qs[lane] = bf2f(PB[row * NMAIN + C_Q + h * 64 + lane]) * 0.125f;
        WAVE_LDS_FENCE();
        float os = 0.f;
        {
            float m = -INFINITY;
            for (int sl = 0; sl < 16; ++sl) { const int idx = seli[sl]; float s = -INFINITY;
                if (idx >= 0) { const int pos = idx * 64 + lane; if (pos <= t) s = dot64_lds_bf16row(qs, PB + ((size_t)b * T + pos) * NMAIN + C_KS + hk * 64) - slope * (float)(t - pos); }
                pbuf[sl * 64 + lane] = s; m = fmaxf(m, s); }
            m = wave_max(m); float l = 0.f;
            for (int sl = 0; sl < 16; ++sl) { const float e = expf(pbuf[sl * 64 + lane] - m); pbuf[sl * 64 + lane] = e; l += e; }
            l = wave_sum(l); const float inv = 1.0f / l;
            WAVE_LDS_FENCE();
            for (int sl = 0; sl < 16; ++sl) { const int idx = seli[sl]; if (idx < 0) continue;
                for (int j = 0; j < 64; ++j) { const int pos = idx * 64 + j; if (pos > t) break; os += pbuf[sl * 64 + j] * bf2f(PB[((size_t)b * T + pos) * NMAIN + C_VS + hk * 64 + lane]); } }
            os *= inv;
        }
        WAVE_LDS_FENCE();
        float ow = 0.f;
        {
            float m = -INFINITY;
            for (int i = lane; i < 512; i += 64) { const int pos = t - 511 + i; float s = -INFINITY;
                if (pos >= 0) s = dot64_lds_bf16row(qs, PB + ((size_t)b * T + pos) * NMAIN + C_KW + hk * 64) - slope * (float)(t - pos);
                pbuf[i] = s; m = fmaxf(m, s); }
            m = wave_max(m); float l = 0.f;
            for (int i = lane; i < 512; i += 64) { const float e = expf(pbuf[i] - m); pbuf[i] = e; l += e; }
            l = wave_sum(l); const float inv = 1.0f / l;
            WAVE_LDS_FENCE();
            for (int i = 0; i < 512; ++i) { const int pos = t - 511 + i; if (pos < 0) continue; ow += pbuf[i] * bf2f(PB[((size_t)b * T + pos) * NMAIN + C_VW + hk * 64 + lane]); }
            ow *= inv;
        }
        const float g0 = gates[row * 24 + h * 3 + 0], g1 = gates[row * 24 + h * 3 + 1], g2 = gates[row * 24 + h * 3 + 2];
        Y[row * D + 512 + h * 64 + lane] = (bf16)f2bf(g0 * ocb[g * 64 + lane] + g1 * os + g2 * ow);
    }
}
__device__ __forceinline__ void p3_nsa_naive(Frame& F, int first_wg, int nwg) {
    LAS float* wl = (LAS float*)(F.lds + RING_OFF) + F.wave * 2048;
    const int me = (int)blockIdx.x - first_wg; if (me < 0) return;
    for (int it = me; it < 4 * (T / 8); it += nwg) {
        const int bh = it / (T / 8), tg = it % (T / 8); const int b = bh >> 1, hk = bh & 1;
        nsa_token_naive(F, b, hk, tg * 8 + F.wave, wl);
    }
}
__device__ __forceinline__ void p7_final_norm(Frame& F) {
    const int gw = F.vcu * NWAVES + F.wave, NGW = F.G * NWAVES;
    const float* ssq3 = (const float*)(F.ctl + CW_SSQ3); const float* gf = F.in[25];
    f32x4 gv[4];
#pragma unroll
    for (int j = 0; j < 4; ++j) gv[j] = *((const f32x4*)gf + F.lane + 64 * j);
    for (int m = gw; m < M; m += NGW) {
        const float rs = 1.0f / sqrtf(ssq3[m] * (1.0f / D) + NORM_EPS);
        f32x4* xr = (f32x4*)(F.out + (size_t)m * D) + F.lane;
#pragma unroll
        for (int j = 0; j < 4; ++j) { f32x4 v = xr[64 * j]; v = v * rs * gv[j]; xr[64 * j] = v; }
    }
}

typedef float f32x16 __attribute__((ext_vector_type(16)));
typedef float f32x2_t __attribute__((ext_vector_type(2))); typedef __bf16 bf16x2_t __attribute__((ext_vector_type(2)));
__device__ __forceinline__ unsigned cvtpk(float lo, float hi) { f32x2_t v = {lo, hi}; bf16x2_t b = __builtin_convertvector(v, bf16x2_t); return __builtin_bit_cast(unsigned, b); }
typedef unsigned u32x2 __attribute__((ext_vector_type(2)));
constexpr int XTRA_OFF = RING_BYTES + 1024;
#define RSLOT(i) (L + (i) * 8192)
__device__ __forceinline__ bf16x8 rfrag(const LAS unsigned char* S, int R0, int ks, int lane) {
    const int row = R0 + (lane & 15), ch = 4 * ks + (lane >> 4);
    return *(const LAS bf16x8*)(S + row * 128 + ((ch ^ (row & 7)) << 4));
}
__device__ __forceinline__ void mm64(f32x4 (&acc)[2], const LAS unsigned char* X, const LAS unsigned char* Y, int wave, int lane) {
#pragma unroll
    for (int ks = 0; ks < 2; ++ks) { const bf16x8 a = rfrag(X, 16 * (wave >> 1), ks, lane);
#pragma unroll
        for (int j = 0; j < 2; ++j) { const bf16x8 b = rfrag(Y, 16 * (2 * (wave & 1) + j), ks, lane); acc[j] = __builtin_amdgcn_mfma_f32_16x16x32_bf16(a, b, acc[j], 0, 0, 0); } }
}
__device__ __forceinline__ void st_row(LAS unsigned char* O, const f32x4 v, int m0, int n) {
    u32x2 w; w.x = cvtpk(v[0], v[1]); w.y = cvtpk(v[2], v[3]);
    *(LAS u32x2*)(O + n * 128 + ((((m0 >> 3) ^ (n & 7)) << 4) | ((m0 & 7) << 1))) = w;
}
__device__ __forceinline__ void st_tr(LAS unsigned char* O, const f32x4 v, int m0, int n) {
#pragma unroll
    for (int r = 0; r < 4; ++r) { const int m = m0 + r; *(LAS unsigned short*)(O + m * 128 + ((((n >> 3) ^ (m & 7)) << 4) | ((n & 7) << 1))) = (unsigned short)f2bf(v[r]); }
}
__device__ __forceinline__ f32x4 ld_row(const LAS unsigned char* O, int m0, int n) {
    const u32x2 w = *(const LAS u32x2*)(O + n * 128 + ((((m0 >> 3) ^ (n & 7)) << 4) | ((m0 & 7) << 1)));
    f32x4 v; v[0] = __builtin_bit_cast(float, w.x << 16); v[1] = __builtin_bit_cast(float, w.x & 0xffff0000u); v[2] = __builtin_bit_cast(float, w.y << 16); v[3] = __builtin_bit_cast(float, w.y & 0xffff0000u); return v;
}
__device__ __forceinline__ void st_fragmajor(unsigned char* G, const f32x4 v, int m0, int R) {
    const int kk = m0 & 31, s = kk >> 4, jj = (kk >> 3) & 1, hh = (kk >> 2) & 1, lanep = (R & 31) + 32 * hh;
    u32x2 w; w.x = cvtpk(v[0], v[1]); w.y = cvtpk(v[2], v[3]);
    *(u32x2*)(G + ((((R >> 5) * 2 + (m0 >> 5)) * 2 + s) * 64 + lanep) * 16 + jj * 8) = w;
}
__device__ __forceinline__ void st_clayout(unsigned char* G, const f32x4 v, int m0, int n) {
    const int mm = m0 & 31, g = mm >> 3, hh = (mm >> 2) & 1, lanep = (n & 31) + 32 * hh;
    u32x2 w; w.x = cvtpk(v[0], v[1]); w.y = cvtpk(v[2], v[3]);
    *(u32x2*)(G + (((m0 >> 5) * 2 + (n >> 5)) * 64 + lanep) * 32 + g * 8) = w;
}
__device__ __forceinline__ void ld8f(float (&o)[8], const float* p) { const f32x4 a = *(const f32x4*)p, b = *(const f32x4*)(p + 4); o[0] = a[0]; o[1] = a[1]; o[2] = a[2]; o[3] = a[3]; o[4] = b[0]; o[5] = b[1]; o[6] = b[2]; o[7] = b[3]; }
__device__ __forceinline__ void ld8bf(float (&o)[8], const bf16* p) { const bf16x8 a = *(const bf16x8*)p;
#pragma unroll
    for (int j = 0; j < 8; ++j) o[j] = bf2f((bf16)a[j]); }
__device__ __forceinline__ v4u pack8(const float (&x)[8]) { v4u o; o.x = cvtpk(x[0], x[1]); o.y = cvtpk(x[2], x[3]); o.z = cvtpk(x[4], x[5]); o.w = cvtpk(x[6], x[7]); return o; }

__device__ __forceinline__ void p2_rwkv_chunk(Frame& F) {
    LAS unsigned char* L = F.lds + RING_OFF;
    LAS float* WPRE = (LAS float*)RSLOT(12); LAS float* APRE = (LAS float*)RSLOT(14);
    LAS float* SEG = (LAS float*)(F.lds + XTRA_OFF); LAS float* LWC = SEG + 512;
    const int tid = F.tid, lane = F.lane, wave = F.wave;
    const int t = tid >> 3, kq = tid & 7;
    const int mt = wave >> 1, ntb = 2 * (wave & 1), q = lane >> 4, l15 = lane & 15;
    const bf16* PB = (const bf16*)(F.ws + WS_PB);
    const bf16* W2T = (const bf16*)(F.ws + WS_LORA); const bf16* A2T = W2T + 512 * 64; const bf16* G2T = A2T + 512 * 64;
    const float* mu = F.in[3];
    float* GG = (float*)(F.ws + WS_G); bf16* VS = (bf16*)(F.ws + WS_VS); float* BON = (float*)(F.ws + WS_BONUS);
    for (int it = F.vcu; it < BATCH * 8 * (T / 64); it += F.G) {
        const int chunk = it & 127, h = (it >> 7) & 7, b = it >> 10;
        const int row0 = b * T + chunk * 64;
        for (int idx = tid; idx < 64 * 32; idx += NWAVES * 64) {
            const int tok = idx >> 5, c8 = idx & 31; const int row = row0 + tok; const int col = C_DW + 8 * c8;
            float p[8], pp[8], m8[8], o[8]; ld8bf(p, PB + (size_t)row * NMAIN + col); ld8f(m8, mu + col);
            if ((row % T) != 0) ld8bf(pp, PB + (size_t)(row - 1) * NMAIN + col); else {
#pragma unroll
                for (int j = 0; j < 8; ++j) pp[j] = 0.f; }
#pragma unroll
            for (int j = 0; j < 8; ++j) { const float ps = p[j] + m8[j] * (pp[j] - p[j]); o[j] = (c8 < 8) ? ftanh_(ps) : (c8 < 16 ? ps : fsigmoid_(ps)); }
            *(LAS v4u*)(RSLOT(8 + (c8 >> 3)) + tok * 128 + (((c8 & 7) ^ (tok & 7)) << 4)) = pack8(o);
        }
        __syncthreads();
        {
            f32x4 accw[2], acca[2], accg[2];
#pragma unroll
            for (int j = 0; j < 2; ++j) { accw[j] = (f32x4){0.f, 0.f, 0.f, 0.f}; acca[j] = accw[j]; accg[j] = accw[j]; }
            const int mr = h * 64 + 16 * mt + l15;
#pragma unroll
            for (int ks = 0; ks < 2; ++ks) { const bf16x8 aw = *(const bf16x8*)(W2T + (size_t)mr * 64 + 32 * ks + 8 * q), aa = *(const bf16x8*)(A2T + (size_t)mr * 64 + 32 * ks + 8 * q);
#pragma unroll
                for (int j = 0; j < 2; ++j) { const bf16x8 b1 = rfrag(RSLOT(8), 16 * (ntb + j), ks, lane), b2 = rfrag(RSLOT(9), 16 * (ntb + j), ks, lane);
                    accw[j] = __builtin_amdgcn_mfma_f32_16x16x32_bf16(aw, b1, accw[j], 0, 0, 0); acca[j] = __builtin_amdgcn_mfma_f32_16x16x32_bf16(aa, b2, acca[j], 0, 0, 0); } }
#pragma unroll
            for (int ks = 0; ks < 4; ++ks) { const bf16x8 ag = *(const bf16x8*)(G2T + (size_t)mr * 128 + 32 * ks + 8 * q);
#pragma unroll
                for (int j = 0; j < 2; ++j) { const bf16x8 b3 = rfrag(RSLOT(10 + (ks >> 1)), 16 * (ntb + j), ks & 1, lane); accg[j] = __builtin_amdgcn_mfma_f32_16x16x32_bf16(ag, b3, accg[j], 0, 0, 0); } }
            const int m0 = 16 * mt + 4 * q;
#pragma unroll
            for (int j = 0; j < 2; ++j) { const int n = 16 * (ntb + j) + l15;
                *(LAS f32x4*)(WPRE + n * 64 + m0) = accw[j]; *(LAS f32x4*)(APRE + n * 64 + m0) = acca[j];
                *(f32x4*)(GG + (size_t)(row0 + n) * 512 + h * 64 + m0) = accg[j]; }
        }
        __syncthreads();
        float r8[8], km8[8], v8[8], a8[8], b8[8], lg8[8];
        {
            const int row = row0 + t, ch = h * 64 + 8 * kq; const bool first = (row % T) == 0;
            const bf16* prow = PB + (size_t)row * NMAIN; const bf16* qrow = PB + (size_t)(first ? row : row - 1) * NMAIN;
            { float c[8], p[8], m[8]; ld8bf(c, prow + C_R + ch); ld8bf(p, qrow + C_R + ch); ld8f(m, mu + C_R + ch);
#pragma unroll
              for (int j = 0; j < 8; ++j) { const float pj = first ? 0.f : p[j]; r8[j] = c[j] + m[j] * (pj - c[j]); } }
            asm volatile("" ::: "memory");
            { float c[8], p[8], m[8]; ld8bf(c, prow + C_V + ch); ld8bf(p, qrow + C_V + ch); ld8f(m, mu + C_V + ch);
#pragma unroll
              for (int j = 0; j < 8; ++j) { const float pj = first ? 0.f : p[j]; v8[j] = c[j] + m[j] * (pj - c[j]); }
              *(v4u*)(VS + (size_t)row * 512 + ch) = pack8(v8); }
            asm volatile("" ::: "memory");
            float kr[8];
            { float c[8], p[8], m[8]; ld8bf(c, prow + C_K + ch); ld8bf(p, qrow + C_K + ch); ld8f(m, mu + C_K + ch);
#pragma unroll
              for (int j = 0; j < 8; ++j) { const float pj = first ? 0.f : p[j]; kr[j] = c[j] + m[j] * (pj - c[j]); } }
            asm volatile("" ::: "memory");
            { float w0v[8]; ld8f(w0v, F.in[4] + ch); const f32x4 x0 = *(const LAS f32x4*)(WPRE + t * 64 + 8 * kq), x1 = *(const LAS f32x4*)(WPRE + t * 64 + 8 * kq + 4);
#pragma unroll
              for (int j = 0; j < 8; ++j) { const float wp = j < 4 ? x0[j & 3] : x1[j & 3]; const float wl = -fsoftplus_(-(w0v[j] + wp)) - 0.5f; lg8[j] = -fexp_(wl); }
              *(LAS f32x4*)(WPRE + t * 64 + 8 * kq) = (f32x4){lg8[0], lg8[1], lg8[2], lg8[3]}; *(LAS f32x4*)(WPRE + t * 64 + 8 * kq + 4) = (f32x4){lg8[4], lg8[5], lg8[6], lg8[7]}; }
            asm volatile("" ::: "memory");
            float as8[8];
            { float a0v[8]; ld8f(a0v, F.in[6] + ch); const f32x4 y0 = *(const LAS f32x4*)(APRE + t * 64 + 8 * kq), y1 = *(const LAS f32x4*)(APRE + t * 64 + 8 * kq + 4);
#pragma unroll
              for (int j = 0; j < 8; ++j) { const float ap = j < 4 ? y0[j & 3] : y1[j & 3]; as8[j] = fsigmoid_(a0v[j] + ap); } }
            asm volatile("" ::: "memory");
            float kk[8], ss = 0.f;
            { float kkp[8]; ld8f(kkp, F.in[9] + ch);
#pragma unroll
              for (int j = 0; j < 8; ++j) { kk[j] = kr[j] * kkp[j]; ss += kk[j] * kk[j]; } }
            ss += __shfl_xor(ss, 1); ss += __shfl_xor(ss, 2); ss += __shfl_xor(ss, 4);
            const float inv = frcp_(fmaxf(__builtin_amdgcn_sqrtf(ss), 1e-12f)); float bon = 0.f;
            { float kap[8], rkp[8]; ld8f(kap, F.in[10] + ch); ld8f(rkp, F.in[11] + ch);
#pragma unroll
              for (int j = 0; j < 8; ++j) { kk[j] *= inv; km8[j] = kr[j] * (1.0f + (as8[j] - 1.0f) * kap[j]); a8[j] = -kk[j]; b8[j] = kk[j] * as8[j]; bon += r8[j] * km8[j] * rkp[j]; } }
            bon += __shfl_xor(bon, 1); bon += __shfl_xor(bon, 2); bon += __shfl_xor(bon, 4);
            if (kq == 0) BON[(size_t)row * 8 + h] = bon;
        }
        __syncthreads();
        {
            const int k = tid & 63, seg = tid >> 6; float c[8], run = 0.f;
#pragma unroll
            for (int i = 0; i < 8; ++i) { run += WPRE[(8 * seg + i) * 64 + k]; c[i] = run; }
            SEG[seg * 64 + k] = run;
            __syncthreads();
            float pre = 0.f;
            for (int s2 = 0; s2 < seg; ++s2) pre += SEG[s2 * 64 + k];
#pragma unroll
            for (int i = 0; i < 8; ++i) WPRE[(8 * seg + i) * 64 + k] = pre + c[i];
            if (seg == 7) LWC[k] = pre + c[7];
        }
        __syncthreads();
        {
            float lw[8], At[8], Bt[8], Kt[8], Rt[8], Bh[8], Kh[8];
            { const f32x4 x0 = *(const LAS f32x4*)(WPRE + t * 64 + 8 * kq), x1 = *(const LAS f32x4*)(WPRE + t * 64 + 8 * kq + 4);
#pragma unroll
              for (int j = 0; j < 4; ++j) { lw[j] = x0[j]; lw[4 + j] = x1[j]; } }
#pragma unroll
            for (int j = 0; j < 8; ++j) { const float lc = LWC[8 * kq + j]; const float eA = fexp_(lw[j] - lg8[j]), eN = fexp_(-lw[j]), eP = fexp_(lw[j]), eC = fexp_(lc - lw[j]);
                At[j] = a8[j] * eA; Bt[j] = b8[j] * eN; Kt[j] = km8[j] * eN; Rt[j] = r8[j] * eP; Bh[j] = b8[j] * eC; Kh[j] = km8[j] * eC; }
            const int o16 = t * 128 + ((kq ^ (t & 7)) << 4);
            *(LAS v4u*)(RSLOT(0) + o16) = pack8(At); *(LAS v4u*)(RSLOT(1) + o16) = pack8(Bt); *(LAS v4u*)(RSLOT(2) + o16) = pack8(Kt); *(LAS v4u*)(RSLOT(3) + o16) = pack8(Rt);
#pragma unroll
            for (int j = 0; j < 8; ++j) { const int kch = 8 * kq + j; const int o2 = kch * 128 + ((((t >> 3) ^ j) << 4) | ((t & 7) << 1));
                *(LAS unsigned short*)(RSLOT(4) + o2) = (unsigned short)f2bf(At[j]); *(LAS unsigned short*)(RSLOT(5) + o2) = (unsigned short)f2bf(v8[j]);
                *(LAS unsigned short*)(RSLOT(6) + o2) = (unsigned short)f2bf(Bh[j]); *(LAS unsigned short*)(RSLOT(7) + o2) = (unsigned short)f2bf(Kh[j]); }
        }
        __syncthreads();
        const int m0 = 16 * mt + 4 * q;
        {
            f32x4 aN[2], aKa[2], aBr[2], aKr[2];
#pragma unroll
            for (int j = 0; j < 2; ++j) { aN[j] = (f32x4){0.f, 0.f, 0.f, 0.f}; aKa[j] = aN[j]; aBr[j] = aN[j]; aKr[j] = aN[j]; }
#pragma unroll
            for (int ks = 0; ks < 2; ++ks) { const bf16x8 xa = rfrag(RSLOT(0), 16 * mt, ks, lane), xb = rfrag(RSLOT(1), 16 * mt, ks, lane), xk = rfrag(RSLOT(2), 16 * mt, ks, lane);
#pragma unroll
                for (int j = 0; j < 2; ++j) { const bf16x8 yb = rfrag(RSLOT(1), 16 * (ntb + j), ks, lane), yk = rfrag(RSLOT(2), 16 * (ntb + j), ks, lane), yr = rfrag(RSLOT(3), 16 * (ntb + j), ks, lane);
                    aN[j] = __builtin_amdgcn_mfma_f32_16x16x32_bf16(xa, yb, aN[j], 0, 0, 0); aKa[j] = __builtin_amdgcn_mfma_f32_16x16x32_bf16(xa, yk, aKa[j], 0, 0, 0);
                    aBr[j] = __builtin_amdgcn_mfma_f32_16x16x32_bf16(xb, yr, aBr[j], 0, 0, 0); aKr[j] = __builtin_amdgcn_mfma_f32_16x16x32_bf16(xk, yr, aKr[j], 0, 0, 0); } }
#pragma unroll
            for (int j = 0; j < 2; ++j) { const int n = 16 * (ntb + j) + l15; f32x4 vN, vT, vKa, vBr, vKr;
#pragma unroll
                for (int r = 0; r < 4; ++r) { const int m = m0 + r; vN[r] = (n < m) ? aN[j][r] : 0.f; vT[r] = vN[r] + ((n == m) ? 1.f : 0.f); vKa[r] = (n < m) ? aKa[j][r] : 0.f;
                    vBr[r] = (m <= n) ? aBr[j][r] : 0.f; vKr[r] = (m <= n) ? aKr[j][r] : 0.f; }
                st_row(RSLOT(8), vN, m0, n); st_tr(RSLOT(9), vN, m0, n); st_row(RSLOT(10), vT, m0, n); st_row(RSLOT(11), vKa, m0, n); st_row(RSLOT(12), vBr, m0, n); st_row(RSLOT(13), vKr, m0, n); }
        }
        __syncthreads();
#define SQUARE(XS, YS, OROW, OTR) { f32x4 ac[2] = {(f32x4){0.f, 0.f, 0.f, 0.f}, (f32x4){0.f, 0.f, 0.f, 0.f}}; mm64(ac, RSLOT(XS), RSLOT(YS), wave, lane); \
            _Pragma("unroll") for (int j = 0; j < 2; ++j) { const int n = 16 * (ntb + j) + l15; if (OROW >= 0) st_row(RSLOT(OROW < 0 ? 0 : OROW), ac[j], m0, n); st_tr(RSLOT(OTR), ac[j], m0, n); } }
#define TUPD(XS, YS, OUT, TRANSP) { f32x4 ac[2]; _Pragma("unroll") for (int j = 0; j < 2; ++j) ac[j] = ld_row(RSLOT(YS), m0, 16 * (ntb + j) + l15); mm64(ac, RSLOT(XS), RSLOT(YS), wave, lane); \
            _Pragma("unroll") for (int j = 0; j < 2; ++j) { const int n = 16 * (ntb + j) + l15; if (TRANSP) st_tr(RSLOT(OUT), ac[j], m0, n); else st_row(RSLOT(OUT), ac[j], m0, n); } }
        SQUARE(9, 8, 0, 1);
        __syncthreads();
        TUPD(1, 10, 14, false); SQUARE(1, 0, 8, 9);
        __syncthreads();
        TUPD(9, 14, 10, false); SQUARE(9, 8, 0, 1);
        __syncthreads();
        TUPD(1, 10, 14, false); SQUARE(1, 0, 8, 9);
        __syncthreads();
        TUPD(9, 14, 10, false); SQUARE(9, 8, -1, 1);
        __syncthreads();
        TUPD(1, 10, 14, true);
        __syncthreads();
        { f32x4 ac[2] = {(f32x4){0.f, 0.f, 0.f, 0.f}, (f32x4){0.f, 0.f, 0.f, 0.f}}, ad[2] = {(f32x4){0.f, 0.f, 0.f, 0.f}, (f32x4){0.f, 0.f, 0.f, 0.f}};
          mm64(ac, RSLOT(14), RSLOT(4), wave, lane); mm64(ad, RSLOT(11), RSLOT(14), wave, lane);
#pragma unroll
          for (int j = 0; j < 2; ++j) { const int n = 16 * (ntb + j) + l15; st_row(RSLOT(0), ac[j], m0, n); st_row(RSLOT(2), ad[j], m0, n); } }
        __syncthreads();
        { f32x4 ac[2] = {(f32x4){0.f, 0.f, 0.f, 0.f}, (f32x4){0.f, 0.f, 0.f, 0.f}};
          mm64(ac, RSLOT(2), RSLOT(5), wave, lane);
#pragma unroll
          for (int j = 0; j < 2; ++j) st_row(RSLOT(8), ac[j], m0, 16 * (ntb + j) + l15); }
        __syncthreads();
        {
            unsigned char* rec = (unsigned char*)F.out + (size_t)it * 32768;
            f32x4 aP[2], aQ[2], aG[2], aH[2];
#pragma unroll
            for (int j = 0; j < 2; ++j) { aP[j] = (f32x4){0.f, 0.f, 0.f, 0.f}; aQ[j] = aP[j]; aH[j] = aP[j]; aG[j] = ld_row(RSLOT(3), m0, 16 * (ntb + j) + l15); }
            mm64(aP, RSLOT(0), RSLOT(6), wave, lane);
            mm64(aQ, RSLOT(6), RSLOT(8), wave, lane); mm64(aQ, RSLOT(7), RSLOT(5), wave, lane);
            mm64(aG, RSLOT(0), RSLOT(12), wave, lane);
            mm64(aH, RSLOT(8), RSLOT(12), wave, lane); mm64(aH, RSLOT(5), RSLOT(13), wave, lane);
#pragma unroll
            for (int j = 0; j < 2; ++j) { const int n = 16 * (ntb + j) + l15;
#pragma unroll
                for (int r = 0; r < 4; ++r) if (m0 + r == n) aP[j][r] += fexp_(LWC[n]);
                st_fragmajor(rec, aP[j], m0, n); st_clayout(rec + 8192, aQ[j], m0, n); st_fragmajor(rec + 16384, aG[j], m0, n); st_clayout(rec + 24576, aH[j], m0, n); }
        }
        __syncthreads();
    }
}
__device__ __forceinline__ void p3_rwkv_scan_mfma(Frame& F, int bh, int ntile) {
    const int lane = F.lane;
    const unsigned char* recs = (const unsigned char*)F.out + (size_t)bh * 128 * 32768;
    unsigned char* stash = F.ws + WS_HB + (size_t)bh * 128 * 8192 + ntile * 4096;
    f32x16 z[2];
#pragma unroll
    for (int i = 0; i < 16; ++i) { z[0][i] = 0.f; z[1][i] = 0.f; }
    bf16x8 pa[2][4]; v4u qc[2][2];
    { const unsigned char* rec = recs;
#pragma unroll
      for (int mtile = 0; mtile < 2; ++mtile) {
#pragma unroll
          for (int ks = 0; ks < 4; ++ks) pa[mtile][ks] = *(const bf16x8*)(rec + ((mtile * 4 + ks) * 64 + lane) * 16);
          qc[mtile][0] = *(const v4u*)(rec + 8192 + ((mtile * 2 + ntile) * 64 + lane) * 32); qc[mtile][1] = *(const v4u*)(rec + 8192 + ((mtile * 2 + ntile) * 64 + lane) * 32 + 16); } }
    for (int c = 0; c < T / 64; ++c) {
        bf16x8 zf[4];
#pragma unroll
        for (int kt = 0; kt < 2; ++kt)
#pragma unroll
            for (int s = 0; s < 2; ++s) { v4u w; w.x = cvtpk(z[kt][8 * s + 0], z[kt][8 * s + 1]); w.y = cvtpk(z[kt][8 * s + 2], z[kt][8 * s + 3]); w.z = cvtpk(z[kt][8 * s + 4], z[kt][8 * s + 5]); w.w = cvtpk(z[kt][8 * s + 6], z[kt][8 * s + 7]);
                zf[kt * 2 + s] = __builtin_bit_cast(bf16x8, w); *(v4u*)(stash + (size_t)c * 8192 + ((kt * 2 + s) * 64 + lane) * 16) = w; }
        if (c == T / 64 - 1) break;
        bf16x8 ca[2][4]; v4u cq[2][2];
#pragma unroll
        for (int mtile = 0; mtile < 2; ++mtile) {
#pragma unroll
            for (int ks = 0; ks < 4; ++ks) ca[mtile][ks] = pa[mtile][ks];
            cq[mtile][0] = qc[mtile][0]; cq[mtile][1] = qc[mtile][1]; }
        if (c + 2 < T / 64) { const unsigned char* rec = recs + (size_t)(c + 1) * 32768;
#pragma unroll
            for (int mtile = 0; mtile < 2; ++mtile) {
#pragma unroll
                for (int ks = 0; ks < 4; ++ks) pa[mtile][ks] = *(const bf16x8*)(rec + ((mtile * 4 + ks) * 64 + lane) * 16);
                qc[mtile][0] = *(const v4u*)(rec + 8192 + ((mtile * 2 + ntile) * 64 + lane) * 32); qc[mtile][1] = *(const v4u*)(rec + 8192 + ((mtile * 2 + ntile) * 64 + lane) * 32 + 16); } }
#pragma unroll
        for (int mtile = 0; mtile < 2; ++mtile) {
            f32x16 acc;
#pragma unroll
            for (int i = 0; i < 4; ++i) { const unsigned w0 = cq[mtile][0][i], w1 = cq[mtile][1][i];
                acc[2 * i] = __builtin_bit_cast(float, w0 << 16); acc[2 * i + 1] = __builtin_bit_cast(float, w0 & 0xffff0000u);
                acc[8 + 2 * i] = __builtin_bit_cast(float, w1 << 16); acc[8 + 2 * i + 1] = __builtin_bit_cast(float, w1 & 0xffff0000u); }
#pragma unroll
            for (int ks = 0; ks < 4; ++ks) acc = __builtin_amdgcn_mfma_f32_32x32x16_bf16(ca[mtile][ks], zf[ks], acc, 0, 0, 0);
            z[mtile] = acc;
        }
    }
}
__device__ __forceinline__ void p3b_rwkv_out_mfma(Frame& F) {
    const int gw = F.vcu * NWAVES + F.wave, NGW = F.G * NWAVES, lane = F.lane, hh = lane >> 5, tl = lane & 31;
    bf16* Y = (bf16*)(F.ws + WS_XB); const float* GG = (const float*)(F.ws + WS_G); const bf16* VS = (const bf16*)(F.ws + WS_VS); const float* BON = (const float*)(F.ws + WS_BONUS);
    const float* lnw = F.in[12]; const float* lnb = F.in[13];
    for (int it = gw; it < BATCH * 8 * (T / 64); it += NGW) {
        const int chunk = it & 127, h = (it >> 7) & 7, b = it >> 10; const int row0 = b * T + chunk * 64;
        const unsigned char* rec = (const unsigned char*)F.out + (size_t)it * 32768;
        const unsigned char* stash = F.ws + WS_HB + (size_t)it * 8192;
        bf16x8 zf[2][4], gf[2][4];
#pragma unroll
        for (int a = 0; a < 2; ++a)
#pragma unroll
            for (int ks = 0; ks < 4; ++ks) { zf[a][ks] = *(const bf16x8*)(stash + a * 4096 + (ks * 64 + lane) * 16); gf[a][ks] = *(const bf16x8*)(rec + 16384 + ((a * 4 + ks) * 64 + lane) * 16); }
        f32x16 y[2][2];
#pragma unroll
        for (int vt = 0; vt < 2; ++vt)
#pragma unroll
            for (int tt = 0; tt < 2; ++tt) { const v4u c0 = *(const v4u*)(rec + 24576 + ((vt * 2 + tt) * 64 + lane) * 32), c1 = *(const v4u*)(rec + 24576 + ((vt * 2 + tt) * 64 + lane) * 32 + 16);
                f32x16 acc;
#pragma unroll
                for (int i = 0; i < 4; ++i) { acc[2 * i] = __builtin_bit_cast(float, c0[i] << 16); acc[2 * i + 1] = __builtin_bit_cast(float, c0[i] & 0xffff0000u);
                    acc[8 + 2 * i] = __builtin_bit_cast(float, c1[i] << 16); acc[8 + 2 * i + 1] = __builtin_bit_cast(float, c1[i] & 0xffff0000u); }
#pragma unroll
                for (int ks = 0; ks < 4; ++ks) acc = __builtin_amdgcn_mfma_f32_32x32x16_bf16(zf[vt][ks], gf[tt][ks], acc, 0, 0, 0);
                y[vt][tt] = acc; }
#pragma unroll
        for (int tt = 0; tt < 2; ++tt) {
            float s = 0.f;
#pragma unroll
            for (int vt = 0; vt < 2; ++vt)
#pragma unroll
                for (int i = 0; i < 16; ++i) s += y[vt][tt][i];
            s += __shfl_xor(s, 32); const float mean = s * (1.0f / 64.0f); float qv = 0.f;
#pragma unroll
            for (int vt = 0; vt < 2; ++vt)
#pragma unroll
                for (int i = 0; i < 16; ++i) { const float d = y[vt][tt][i] - mean; qv += d * d; }
            qv += __shfl_xor(qv, 32); const float rstd = 1.0f / sqrtf(qv * (1.0f / 64.0f) + GN_EPS);
            const int row = row0 + 32 * tt + tl; const float bon = BON[(size_t)row * 8 + h];
#pragma unroll
            for (int vt = 0; vt < 2; ++vt)
#pragma unroll
                for (int g = 0; g < 4; ++g) { const int v0 = 32 * vt + 8 * g + 4 * hh, ch = h * 64 + v0;
                    const f32x4 gw4 = *(const f32x4*)(GG + (size_t)row * 512 + ch), lw4 = *(const f32x4*)(lnw + ch), lb4 = *(const f32x4*)(lnb + ch);
                    const u32x2 vsw = *(const u32x2*)(VS + (size_t)row * 512 + ch);
                    float vs4[4] = {__builtin_bit_cast(float, vsw.x << 16), __builtin_bit_cast(float, vsw.x & 0xffff0000u), __builtin_bit_cast(float, vsw.y << 16), __builtin_bit_cast(float, vsw.y & 0xffff0000u)};
                    float o[4];
#pragma unroll
                    for (int r = 0; r < 4; ++r) o[r] = ((y[vt][tt][4 * g + r] - mean) * rstd * lw4[r] + lb4[r] + bon * vs4[r]) * gw4[r];
                    u32x2 w; w.x = cvtpk(o[0], o[1]); w.y = cvtpk(o[2], o[3]);
                    *(u32x2*)(Y + (size_t)row * D + ch) = w; }
        }
    }
}

constexpr int NSA_KB = 0, NSA_VB = 16384, NSA_IMP = 32768, NSA_OUT = 65536, NSA_SELM = RING_BYTES + 1024, NSA_LIST = RING_BYTES + 2048, NSA_MISC = RING_BYTES + 3072;
static_assert(NSA_OUT + 8 * 8192 <= RING_BYTES && NSA_MISC + 1024 <= LDS_BYTES, "nsa lds map");
constexpr float LOG2E = 1.4426950408889634f;
constexpr float NEGB = -1e30f;
__device__ __forceinline__ int perm16(int c) { return (c & ~15) | (((c >> 2) & 1) << 3) | (((c >> 3) & 1) << 2) | (c & 3); }

__device__ __forceinline__ void p2_vtrans(Frame& F) {
    LAS unsigned short* TL = (LAS unsigned short*)(F.lds + RING_OFF);
    const bf16* PB = (const bf16*)(F.ws + WS_PB); bf16* VT = (bf16*)(F.ws + WS_VT);
    const int tid = F.tid;
    for (int it = F.vcu; it < 2 * 4 * (T / 64); it += F.G) {
        const int n = it & 127, bhk = (it >> 7) & 3, kind = it >> 9; const int b = bhk >> 1, hk = bhk & 1;
        const int col = (kind ? C_VW : C_VS) + hk * 64;
        { const int tok = tid >> 3, ch = tid & 7; const bf16x8 v = *(const bf16x8*)(PB + (size_t)(b * T + 64 * n + tok) * NMAIN + col + 8 * ch);
#pragma unroll
          for (int j = 0; j < 8; ++j) TL[tok * 66 + 8 * ch + j] = (unsigned short)v[j]; }
        __syncthreads();
        { const int d = tid >> 3, ch = tid & 7; bf16x8 o;
#pragma unroll
          for (int j = 0; j < 8; ++j) { const int key = perm16(8 * ch + j); o[j] = (short)TL[key * 66 + d]; }
          *(bf16x8*)(VT + ((size_t)(kind * 4 + bhk) * 64 + d) * T + 64 * n + 8 * ch) = o; }
        __syncthreads();
    }
}
struct NsaCtx { const bf16* kc; const bf16* vct; const bf16* ks; const bf16* vst; const bf16* kw; const bf16* vwt; };
__device__ __forceinline__ void nsa_load(const NsaCtx& C, int desc, int tid, v4u& kr, v4u& vr) {
    const int kind = desc >> 8, n = desc & 255, row = tid >> 3, ch = tid & 7;
    const bf16* kp; const bf16* vp;
    if (kind == 0) { kp = C.kc + (size_t)(64 * n + row) * 64 + 8 * ch; vp = C.vct + (size_t)row * NCMPP + 64 * n + 8 * ch; }
    else if (kind == 1) { kp = C.ks + (size_t)(64 * n + row) * NMAIN + 8 * ch; vp = C.vst + (size_t)row * T + 64 * n + 8 * ch; }
    else { kp = C.kw + (size_t)(64 * n + row) * NMAIN + 8 * ch; vp = C.vwt + (size_t)row * T + 64 * n + 8 * ch; }
    kr = *(const v4u*)kp; vr = *(const v4u*)vp;
}
__device__ __forceinline__ void nsa_store(LAS unsigned char* L, int buf, int tid, const v4u kr, const v4u vr) {
    const int row = tid >> 3, ch = tid & 7; const int o = row * 128 + ((ch ^ (row & 7)) << 4);
    *(LAS v4u*)(L + NSA_KB + buf * 8192 + o) = kr; *(LAS v4u*)(L + NSA_VB + buf * 8192 + o) = vr;
}
template <int MODE>
__device__ __forceinline__ void nsa_block(const LAS unsigned char* KB, const LAS unsigned char* VB, const bf16x8 (&qf)[4], f32x16 (&o)[2], float& m, float& l,
                                          float ck, float cb, int lo, int hi, bool masked, float invl, LAS float* impw, int nbase, int lane) {
    const int r32 = lane & 31, hh = lane >> 5;
    f32x16 s0, s1;
    { const float cbh = cb + ck * (float)(4 * hh);
#pragma unroll
      for (int i = 0; i < 16; ++i) { const float c = (float)((i & 3) + 8 * (i >> 2)); s0[i] = __builtin_fmaf(ck, c, cbh); s1[i] = __builtin_fmaf(ck, c + 32.f, cbh); } }
    { const LAS unsigned char* kp = KB + r32 * 128; const int sw = r32 & 7;
#pragma unroll
      for (int ks = 0; ks < 4; ++ks) { const bf16x8 a0 = *(const LAS bf16x8*)(kp + (((2 * ks + hh) ^ sw) << 4)), a1 = *(const LAS bf16x8*)(kp + 4096 + (((2 * ks + hh) ^ sw) << 4));
          s0 = __builtin_amdgcn_mfma_f32_32x32x16_bf16(a0, qf[ks], s0, 0, 0, 0); s1 = __builtin_amdgcn_mfma_f32_32x32x16_bf16(a1, qf[ks], s1, 0, 0, 0); } }
    if (masked) { const int lo2 = lo - 4 * hh, hi2 = hi - 4 * hh;
#pragma unroll
        for (int i = 0; i < 16; ++i) { const int c = (i & 3) + 8 * (i >> 2); if (c < lo2 || c > hi2) s0[i] = NEGB; if (c + 32 < lo2 || c + 32 > hi2) s1[i] = NEGB; } }
    if (MODE != 2) {
        float bm = fmaxf(s0[0], s1[0]);
#pragma unroll
        for (int i = 1; i < 16; ++i) bm = fmaxf(bm, fmaxf(s0[i], s1[i]));
        bm = fmaxf(bm, __shfl_xor(bm, 32));
        const float mn = fmaxf(m, bm);
        if (__any(mn > m)) { const float alpha = __builtin_amdgcn_exp2f(m - mn); l *= alpha;
            if (MODE == 0) {
#pragma unroll
                for (int i = 0; i < 16; ++i) { o[0][i] *= alpha; o[1][i] *= alpha; } } }
        m = mn;
    }
    float ls = 0.f;
#pragma unroll
    for (int i = 0; i < 16; ++i) { s0[i] = __builtin_amdgcn_exp2f(s0[i] - m); s1[i] = __builtin_amdgcn_exp2f(s1[i] - m); ls += s0[i] + s1[i]; }
    if (MODE != 2) l += ls;
    if (MODE == 1) return;
    if (MODE == 2) {
#pragma unroll
        for (int i = 0; i < 16; ++i) { s0[i] *= invl; s1[i] *= invl; }
        const int tok = r32 >> 2;
#pragma unroll
        for (int kt = 0; kt < 2; ++kt)
#pragma unroll
            for (int gi = 0; gi < 4; ++gi) { const f32x16& s = kt ? s1 : s0;
                float a = 2.f * (s[4 * gi] + s[4 * gi + 1] + s[4 * gi + 2]) + s[4 * gi + 3], bq = s[4 * gi + 3];
                a += __shfl_xor(a, 1); a += __shfl_xor(a, 2); bq += __shfl_xor(bq, 1); bq += __shfl_xor(bq, 2);
                const int n = nbase + 8 * kt + 2 * gi + hh;
                if ((lane & 3) == 0) { impw[tok * 128 + n] += a; }
                asm volatile("" ::: "memory");
                if ((lane & 3) == 0 && n + 1 < 128) { impw[tok * 128 + n + 1] += bq; }
                asm volatile("" ::: "memory"); }
    }
    bf16x8 pf[4];
#pragma unroll
    for (int kt = 0; kt < 2; ++kt)
#pragma unroll
        for (int s = 0; s < 2; ++s) { const f32x16& sv = kt ? s1 : s0; v4u w; w.x = cvtpk(sv[8 * s + 0], sv[8 * s + 1]); w.y = cvtpk(sv[8 * s + 2], sv[8 * s + 3]); w.z = cvtpk(sv[8 * s + 4], sv[8 * s + 5]); w.w = cvtpk(sv[8 * s + 6], sv[8 * s + 7]);
            pf[kt * 2 + s] = __builtin_bit_cast(bf16x8, w); }
    { const LAS unsigned char* vp = VB + r32 * 128; const int sw = r32 & 7;
#pragma unroll
      for (int sp = 0; sp < 4; ++sp) { const bf16x8 a0 = *(const LAS bf16x8*)(vp + (((2 * sp + hh) ^ sw) << 4)), a1 = *(const LAS bf16x8*)(vp + 4096 + (((2 * sp + hh) ^ sw) << 4));
          o[0] = __builtin_amdgcn_mfma_f32_32x32x16_bf16(a0, pf[sp], o[0], 0, 0, 0); o[1] = __builtin_amdgcn_mfma_f32_32x32x16_bf16(a1, pf[sp], o[1], 0, 0, 0); } }
}
__device__ __forceinline__ void nsa_item(Frame& F, int b, int hk, int cur) {
    LAS unsigned char* L = F.lds + RING_OFF;
    const int tid = F.tid, lane = F.lane, wave = F.wave, r32 = lane & 31, hh = lane >> 5, tok = r32 >> 2, g = r32 & 3;
    const int t0 = 64 * cur, t = t0 + 8 * wave + tok, head = hk * 4 + g, bhk = b * 2 + hk;
    const size_t row = (size_t)b * T + t;
    const bf16* PB = (const bf16*)(F.ws + WS_PB);
    NsaCtx C;
    C.kc = (const bf16*)(F.ws + WS_CMP) + (size_t)bhk * NCMPP * 64; C.vct = (const bf16*)(F.ws + WS_CMP + 262144) + (size_t)bhk * 64 * NCMPP;
    C.ks = PB + (size_t)b * T * NMAIN + C_KS + hk * 64; C.kw = PB + (size_t)b * T * NMAIN + C_KW + hk * 64;
    C.vst = (const bf16*)(F.ws + WS_VT) + (size_t)(0 * 4 + bhk) * 64 * T; C.vwt = (const bf16*)(F.ws + WS_VT) + (size_t)(1 * 4 + bhk) * 64 * T;
    LAS float* impw = (LAS float*)(L + NSA_IMP) + wave * 1024;
    LAS unsigned* SELM = (LAS unsigned*)(L + NSA_SELM); LAS int* LIST = (LAS int*)(L + NSA_LIST); LAS int* MISC = (LAS int*)(L + NSA_MISC);
    const float slope2 = exp2f(-(float)(head + 1)) * LOG2E;
    bf16x8 qf[4];
#pragma unroll
    for (int ks = 0; ks < 4; ++ks) { float q8[8]; ld8bf(q8, PB + row * NMAIN + C_Q + head * 64 + 16 * ks + 8 * hh);
#pragma unroll
        for (int j = 0; j < 8; ++j) q8[j] *= 0.125f * LOG2E;
        qf[ks] = __builtin_bit_cast(bf16x8, pack8(q8)); }
#pragma unroll
    for (int i = 0; i < 16; ++i) impw[i * 64 + lane] = 0.f;
    const float* gates = (const float*)(F.ws + WS_GATES) + row * 24 + head * 3;
    const float gt0 = gates[0], gt1 = gates[1], gt2 = gates[2];
    LAS float* outp = (LAS float*)(L + NSA_OUT) + wave * 2048 + lane;
    f32x16 o[2];
#pragma unroll
    for (int i = 0; i < 16; ++i) { o[0][i] = 0.f; o[1][i] = 0.f; }
    float m = NEGB, l = 0.f, invl = 0.f;
    v4u kr, vr;
    const int nbc = (4 * cur + 3 + 63) >> 6; const int nA = 2 * nbc;
    const int tmin = t0 + 8 * wave;
    nsa_load(C, 0, tid, kr, vr); nsa_store(L, 0, tid, kr, vr);
    __syncthreads();
    for (int i = 0; i < nA; ++i) {
        const int n = (i < nbc) ? i : i - nbc;
        if (i + 1 < nA) nsa_load(C, (i + 1 < nbc) ? i + 1 : i + 1 - nbc, tid, kr, vr);
        if (i == nbc) { const float lt = l + __shfl_xor(l, 32); invl = (t >= 31) ? 1.0f / lt : 0.f; }
        if (1024 * n + 31 <= tmin + 7) {
            const float ck = 16.f * slope2, cb = slope2 * (float)(1024 * n + 31 - t);
            const int hi = (t >= 31) ? ((t - 31) >> 4) - 64 * n : -1;
            const bool masked = (16 * (64 * n + 63) + 31 > tmin);
            const LAS unsigned char* KB = L + NSA_KB + (i & 1) * 8192; const LAS unsigned char* VB = L + NSA_VB + (i & 1) * 8192;
            if (i < nbc) nsa_block<1>(KB, VB, qf, o, m, l, ck, cb, 0, hi, masked, 0.f, impw, 0, lane);
            else nsa_block<2>(KB, VB, qf, o, m, l, ck, cb, 0, hi, masked, invl, impw, 16 * n, lane);
        }
        if (i + 1 < nA) nsa_store(L, (i + 1) & 1, tid, kr, vr);
        __syncthreads();
    }
#pragma unroll
    for (int i = 0; i < 16; ++i) { outp[64 * i] = gt0 * o[0][i]; outp[64 * (16 + i)] = gt0 * o[1][i]; o[0][i] = 0.f; o[1][i] = 0.f; }
    asm volatile("s_waitcnt lgkmcnt(0)" ::: "memory");
    {
        unsigned long long mlo[8], mhi[8];
        if (cur < 16) {
#pragma unroll
            for (int tk = 0; tk < 8; ++tk) { mlo[tk] = (1ull << (cur + 1)) - 1ull; mhi[tk] = 0ull; }
        } else {
            float v0[8], v1[8];
#pragma unroll
            for (int tk = 0; tk < 8; ++tk) { const float i0 = impw[tk * 128 + lane], i1 = impw[tk * 128 + 64 + lane]; const int n1 = lane + 64;
                v0[tk] = (lane > cur) ? NEGV : ((lane == 0 || lane == cur || lane == cur - 1) ? BIGV : i0);
                v1[tk] = (n1 > cur) ? NEGV : ((n1 == cur || n1 == cur - 1) ? BIGV : i1); mlo[tk] = 0ull; mhi[tk] = 0ull; }
            for (int itr = 0; itr < 16; ++itr) {
#pragma unroll
                for (int tk = 0; tk < 8; ++tk) {
                    const float mx = wave_max(fmaxf(v0[tk], v1[tk]));
                    const unsigned long long b0 = __ballot(v0[tk] == mx);
                    if (b0) { const int idx = __builtin_ctzll(b0); if (lane == idx) v0[tk] = -INFINITY; if (mx > 0.5f * NEGV) mlo[tk] |= 1ull << idx; }
                    else { const unsigned long long b1 = __ballot(v1[tk] == mx); const int idx = __builtin_ctzll(b1); if (lane == idx) v1[tk] = -INFINITY; if (mx > 0.5f * NEGV) mhi[tk] |= 1ull << idx; }
                }
            }
        }
        if (lane == 0) {
#pragma unroll
            for (int tk = 0; tk < 8; ++tk) { LAS unsigned* p = SELM + (8 * wave + tk) * 4; p[0] = (unsigned)mlo[tk]; p[1] = (unsigned)(mlo[tk] >> 32); p[2] = (unsigned)mhi[tk]; p[3] = (unsigned)(mhi[tk] >> 32); }
        }
    }
    __syncthreads();
    if (wave == 0) {
        unsigned u0 = SELM[lane * 4 + 0], u1 = SELM[lane * 4 + 1], u2 = SELM[lane * 4 + 2], u3 = SELM[lane * 4 + 3];
#pragma unroll
        for (int ofs = 1; ofs < 64; ofs <<= 1) { u0 |= __shfl_xor(u0, ofs); u1 |= __shfl_xor(u1, ofs); u2 |= __shfl_xor(u2, ofs); u3 |= __shfl_xor(u3, ofs); }
        if (lane == 0) {
            int cnt = 0;
            for (int w4 = 0; w4 < 4; ++w4) { unsigned u = (w4 == 0) ? u0 : (w4 == 1) ? u1 : (w4 == 2) ? u2 : u3; while (u) { const int bit = __builtin_ctz(u); u &= u - 1; LIST[cnt++] = (1 << 8) | (32 * w4 + bit); } }
            MISC[0] = cnt;
            for (int n = (cur >= 8 ? cur - 8 : 0); n <= cur; ++n) LIST[cnt++] = (2 << 8) | n;
            MISC[1] = cnt;
        }
    }
    __syncthreads();
    const int nS = MISC[0], nB = MISC[1];
    m = NEGB; l = 0.f;
    nsa_load(C, LIST[0], tid, kr, vr); nsa_store(L, 0, tid, kr, vr);
    __syncthreads();
    for (int i = 0; i < nB; ++i) {
        const int desc = LIST[i]; const int kind = desc >> 8, n = desc & 255;
        if (i + 1 < nB) nsa_load(C, LIST[i + 1], tid, kr, vr);
        if (i == nS) {
            const float lt = l + __shfl_xor(l, 32); const float f = gt1 / lt;
#pragma unroll
            for (int k = 0; k < 16; ++k) { outp[64 * k] += f * o[0][k]; outp[64 * (16 + k)] += f * o[1][k]; o[0][k] = 0.f; o[1][k] = 0.f; }
            m = NEGB; l = 0.f;
        }
        const LAS unsigned char* KB = L + NSA_KB + (i & 1) * 8192; const LAS unsigned char* VB = L + NSA_VB + (i & 1) * 8192;
        const float cb = slope2 * (float)(64 * n - t);
        if (kind == 1) {
            const unsigned bit = (SELM[(8 * wave + tok) * 4 + (n >> 5)] >> (n & 31)) & 1u;
            if (__any((int)bit)) {
                const bool masked = (n == cur) || !__all((int)bit);
                const int hi = bit ? (t - 64 * n) : -1;
                nsa_block<0>(KB, VB, qf, o, m, l, slope2, cb, 0, hi, masked, 0.f, impw, 0, lane);
            }
        } else {
            const bool masked = (n == cur) || (n == cur - 8);
            nsa_block<0>(KB, VB, qf, o, m, l, slope2, cb, t - 511 - 64 * n, t - 64 * n, masked, 0.f, impw, 0, lane);
        }
        if (i + 1 < nB) nsa_store(L, (i + 1) & 1, tid, kr, vr);
        __syncthreads();
    }
    { const float lt = l + __shfl_xor(l, 32); const float f = gt2 / lt;
#pragma unroll
      for (int k = 0; k < 16; ++k) { o[0][k] = outp[64 * k] + f * o[0][k]; o[1][k] = outp[64 * (16 + k)] + f * o[1][k]; } }
    bf16* Y = (bf16*)(F.ws + WS_XB) + row * D + 512 + head * 64;
#pragma unroll
    for (int dt = 0; dt < 2; ++dt)
#pragma unroll
        for (int gi = 0; gi < 4; ++gi) { u32x2 w; w.x = cvtpk(o[dt][4 * gi], o[dt][4 * gi + 1]); w.y = cvtpk(o[dt][4 * gi + 2], o[dt][4 * gi + 3]);
            *(u32x2*)(Y + 32 * dt + 8 * gi + 4 * hh) = w; }
}
__device__ __forceinline__ void p3_nsa_mfma(Frame& F) {
    LAS int* QS = (LAS int*)(F.lds + RING_OFF + NSA_MISC + 64);
    for (;;) {
        if (F.tid == 0) QS[0] = (int)__hip_atomic_fetch_add((unsigned*)(F.ctl + CW_QUEUE), 1u, __ATOMIC_RELAXED, __HIP_MEMORY_SCOPE_AGENT);
        __syncthreads();
        const int q = QS[0];
        __syncthreads();
        if (q >= 4 * (T / 64)) break;
        const int cur = 127 - (q >> 2), bhk = q & 3;
        nsa_item(F, bhk >> 1, bhk & 1, cur);
    }
}

__device__ __forceinline__ void p2_gates_mfma(Frame& F) {
    const int gw = F.vcu * NWAVES + F.wave, NGW = F.G * NWAVES, lane = F.lane, l15 = lane & 15, q = lane >> 4;
    const bf16* XB = (const bf16*)(F.ws + WS_XB); const bf16* Wg = (const bf16*)(F.ws + WS_WIN) + (size_t)C_GL * D; const float* rstd1 = (const float*)(F.ws + WS_RSTD1);
    float* gates = (float*)(F.ws + WS_GATES);
    for (int it = gw; it < M / 16; it += NGW) {
        const int r0 = 16 * it;
        f32x4 acc[2] = {(f32x4){0.f, 0.f, 0.f, 0.f}, (f32x4){0.f, 0.f, 0.f, 0.f}};
        const bf16* xp = XB + (size_t)(r0 + l15) * D + 8 * q; const bf16* wp0 = Wg + (size_t)l15 * D + 8 * q; const bf16* wp1 = Wg + (size_t)(16 + l15) * D + 8 * q;
#pragma unroll 8
        for (int ks = 0; ks < 32; ++ks) { const bf16x8 bx = *(const bf16x8*)(xp + 32 * ks), a0 = *(const bf16x8*)(wp0 + 32 * ks), a1 = *(const bf16x8*)(wp1 + 32 * ks);
            acc[0] = __builtin_amdgcn_mfma_f32_16x16x32_bf16(a0, bx, acc[0], 0, 0, 0); acc[1] = __builtin_amdgcn_mfma_f32_16x16x32_bf16(a1, bx, acc[1], 0, 0, 0); }
        const float rs = rstd1[r0 + l15]; float* gp = gates + (size_t)(r0 + l15) * 24;
        { f32x4 o; o[0] = fsigmoid_(acc[0][0] * rs); o[1] = fsigmoid_(acc[0][1] * rs); o[2] = fsigmoid_(acc[0][2] * rs); o[3] = fsigmoid_(acc[0][3] * rs); *(f32x4*)(gp + 4 * q) = o; }
        if (q < 2) { f32x4 o; o[0] = fsigmoid_(acc[1][0] * rs); o[1] = fsigmoid_(acc[1][1] * rs); o[2] = fsigmoid_(acc[1][2] * rs); o[3] = fsigmoid_(acc[1][3] * rs); *(f32x4*)(gp + 16 + 4 * q) = o; }
    }
}
constexpr int CMP_H_OFF = 36864, CMP_H_STRIDE = 528;
__device__ __forceinline__ void p2_compress_mfma(Frame& F) {
    LAS unsigned char* L = F.lds + RING_OFF;
    const int tid = F.tid, lane = F.lane, wave = F.wave, l15 = lane & 15, q = lane >> 4;
    const bf16* PB = (const bf16*)(F.ws + WS_PB);
    const float* bias1 = (const float*)(F.ctl + CW_BIAS1);
    for (int it = F.vcu; it < 256; it += F.G) {
        const int kv = it >> 7, bhk = (it >> 5) & 3, c0 = (it & 31) * 16; const int b = bhk >> 1, hk = bhk & 1;
        const int col = (kv ? C_VC : C_KC) + hk * 64;
        for (int idx = tid; idx < 272 * 8; idx += NWAVES * 64) { const int tok = idx >> 3, ch = idx & 7; const int t = 16 * c0 + tok;
            v4u v = (v4u){0u, 0u, 0u, 0u}; if (t < T) v = *(const v4u*)(PB + (size_t)(b * T + t) * NMAIN + col + 8 * ch);
            const int e = tok * 64 + ch * 8; *(LAS v4u*)(L + 2 * e + (e >> 10) * 16) = v; }
        __syncthreads();
        {
            f32x4 acc[2] = {(f32x4){0.f, 0.f, 0.f, 0.f}, (f32x4){0.f, 0.f, 0.f, 0.f}};
            const bf16* W1T = (const bf16*)(F.ws + WS_CW1T) + (size_t)kv * 256 * 2048;
            const bf16* ap0 = W1T + (size_t)(32 * wave + l15) * 2048 + 8 * q; const bf16* ap1 = ap0 + (size_t)16 * 2048;
#pragma unroll 8
            for (int ks = 0; ks < 64; ++ks) { const int e = 1024 * l15 + 32 * ks + 8 * q; const bf16x8 bx = *(const LAS bf16x8*)(L + 2 * e + (e >> 10) * 16);
                const bf16x8 a0 = *(const bf16x8*)(ap0 + 32 * ks), a1 = *(const bf16x8*)(ap1 + 32 * ks);
                acc[0] = __builtin_amdgcn_mfma_f32_16x16x32_bf16(a0, bx, acc[0], 0, 0, 0); acc[1] = __builtin_amdgcn_mfma_f32_16x16x32_bf16(a1, bx, acc[1], 0, 0, 0); }
#pragma unroll
            for (int j = 0; j < 2; ++j) { const int n0 = 32 * wave + 16 * j + 4 * q; const f32x4 bv = *(const f32x4*)(bias1 + kv * 256 + n0);
                u32x2 w; w.x = cvtpk(fgelu_tanh_(acc[j][0] + bv[0]), fgelu_tanh_(acc[j][1] + bv[1])); w.y = cvtpk(fgelu_tanh_(acc[j][2] + bv[2]), fgelu_tanh_(acc[j][3] + bv[3]));
                *(LAS u32x2*)(L + CMP_H_OFF + l15 * CMP_H_STRIDE + n0 * 2) = w; }
        }
        __syncthreads();
        if (wave < 4) {
            f32x4 acc = (f32x4){0.f, 0.f, 0.f, 0.f};
            const bf16* W2T = (const bf16*)(F.ws + WS_CW2T) + (size_t)kv * 64 * 256 + (size_t)(16 * wave + l15) * 256 + 8 * q;
#pragma unroll
            for (int ks = 0; ks < 8; ++ks) { const bf16x8 a = *(const bf16x8*)(W2T + 32 * ks), bx = *(const LAS bf16x8*)(L + CMP_H_OFF + l15 * CMP_H_STRIDE + (32 * ks + 8 * q) * 2);
                acc = __builtin_amdgcn_mfma_f32_16x16x32_bf16(a, bx, acc, 0, 0, 0); }
            const int c = c0 + l15, j0 = 16 * wave + 4 * q; const bool ok = c < NCMP;
            if (kv == 0) { u32x2 w; w.x = ok ? cvtpk(acc[0], acc[1]) : 0u; w.y = ok ? cvtpk(acc[2], acc[3]) : 0u; *(u32x2*)((bf16*)(F.ws + WS_CMP) + ((size_t)bhk * NCMPP + c) * 64 + j0) = w; }
            else { const int pc = perm16(c);
#pragma unroll
                for (int r = 0; r < 4; ++r) ((bf16*)(F.ws + WS_CMP + 262144))[((size_t)bhk * 64 + j0 + r) * NCMPP + pc] = ok ? (bf16)f2bf(acc[r]) : (bf16)0; }
        }
        __syncthreads();
    }
}

struct Args { const float* in[26]; float* out; unsigned char* ws; };
__global__ void __launch_bounds__(NWAVES * 64, 2) hybrid_fwd(Args args) {
    extern __shared__ __attribute__((aligned(16))) unsigned char lds[];
    Frame F;
    F.lds = (LAS unsigned char*)lds;
    F.MISC = (volatile LAS unsigned*)(F.lds + MISC_OFF);
    F.tid = threadIdx.x; F.lane = F.tid & 63; F.wave = __builtin_amdgcn_readfirstlane(F.tid >> 6);
    F.G = gridDim.x; { const int bx = blockIdx.x; F.vcu = (F.G % 8 == 0) ? (bx % 8) * (F.G / 8) + bx / 8 : bx; }
    F.ws = args.ws; F.out = args.out; F.ctl = (gu32*)(args.ws + WS_CTL);
#pragma unroll
    for (int i = 0; i < 26; ++i) F.in[i] = args.in[i];
    for (int u = F.tid; u < (LDS_BYTES - LDSCTL_OFF) / 4; u += NWAVES * 64) ((LAS unsigned*)(F.lds + LDSCTL_OFF))[u] = 0u;
    __syncthreads();
    XcdBarrier bar = xcd_barrier_post((unsigned*)(F.ctl + CW_BAR), F.MISC + 8);
#define GRID_BAR() xcd_barrier(bar)
#ifdef PROBE_SEL
    volatile LAS unsigned long long* TSL = (volatile LAS unsigned long long*)(F.lds + RING_BYTES + 8192);
#define STAMP(i) do { if (blockIdx.x == 0 && F.tid == 0) TSL[i] = __builtin_amdgcn_s_memrealtime(); } while (0)
#else
#define STAMP(i) do {} while (0)
#endif
    STAMP(0);

    bf16* Win_t = (bf16*)(F.ws + WS_WIN); bf16* Wout_t = (bf16*)(F.ws + WS_WOUT); bf16* Wgu_t = (bf16*)(F.ws + WS_WGU); bf16* Wd_t = (bf16*)(F.ws + WS_WD);
    bf16* XB = (bf16*)(F.ws + WS_XB); bf16* PB = (bf16*)(F.ws + WS_PB); bf16* HB = (bf16*)(F.ws + WS_HB); bf16* ACT = (bf16*)(F.ws + WS_PB);
    float* rstd1 = (float*)(F.ws + WS_RSTD1); float* ssq2 = (float*)(F.ctl + CW_SSQ2); float* ssq3 = (float*)(F.ctl + CW_SSQ3);

    p0_prologue(F);
    GRID_BAR(); STAMP(1);
    {
        pg8::Gemm g{XB, Win_t, M, NMAIN, D}; pg8::StaticOrder S; S.init(M, NMAIN, F.G, (int)blockIdx.x);
        pg8::EpiRowScaleBf16 E{PB, NMAIN, rstd1};
        pg8::gemm_phase<pg8::EpiRowScaleBf16, pg8::StaticOrder, true, true>(F.lds + RING_OFF, g, S, E);
    }
    GRID_BAR(); STAMP(2);
    p2_gates_mfma(F); STAMP(10);
    p2_rwkv_chunk(F); STAMP(11);
    p2_compress_mfma(F); STAMP(12);
    p2_vtrans(F); STAMP(13);
    GRID_BAR(); STAMP(3);
    if (blockIdx.x < 4) p3_rwkv_scan_mfma(F, 4 * (int)blockIdx.x + (F.wave >> 1), F.wave & 1);
    STAMP(14);
    p3_nsa_mfma(F); STAMP(15);
    GRID_BAR(); STAMP(4);
    p3b_rwkv_out_mfma(F);
    GRID_BAR(); STAMP(5);
    {
        pg8::Gemm g{XB, Wout_t, M, D, D}; pg8::StaticOrder S; S.init(M, D, F.G, (int)blockIdx.x);
        pg8::EpiResid E{F.in[0], F.out, HB, ssq2, D};
        pg8::gemm_phase<pg8::EpiResid, pg8::StaticOrder, true, true>(F.lds + RING_OFF, g, S, E);
    }
    GRID_BAR(); STAMP(6);
    {
        pg8::Gemm g{HB, Wgu_t, M, NGU, D}; pg8::StaticOrder S; S.init(M, NGU, F.G, (int)blockIdx.x);
        pg8::EpiSwiGLU E{ACT, DFF, ssq2, NORM_EPS};
        pg8::gemm_phase<pg8::EpiSwiGLU, pg8::StaticOrder, true, true>(F.lds + RING_OFF, g, S, E);
    }
    GRID_BAR(); STAMP(7);
    {
        pg8::Gemm g{ACT, Wd_t, M, D, DFF}; pg8::StaticOrder S; S.init(M, D, F.G, (int)blockIdx.x);
        pg8::EpiResid E{F.out, F.out, nullptr, ssq3, D};
        pg8::gemm_phase<pg8::EpiResid, pg8::StaticOrder, true, true>(F.lds + RING_OFF, g, S, E);
    }
    GRID_BAR(); STAMP(8);
    p7_final_norm(F); STAMP(9);
#ifdef PROBE_SEL
    if (blockIdx.x == 0 && F.tid == 0) {
        constexpr int PA[6][3][2] = {{{0,1},{1,2},{2,3}}, {{3,4},{4,5},{5,6}}, {{6,7},{7,8},{8,9}}, {{2,10},{10,11},{11,12}}, {{12,13},{3,14},{14,15}}, {{15,4},{0,9},{0,9}}};
        unsigned long long f = 0;
        for (int k = 0; k < 3; ++k) { const unsigned long long d = (TSL[PA[PROBE_SEL][k][1]] - TSL[PA[PROBE_SEL][k][0]]) / 1000ull; f = f * 100ull + (d > 99ull ? 99ull : d); }
        const unsigned long long t0 = __builtin_amdgcn_s_memrealtime();
        while (__builtin_amdgcn_s_memrealtime() - t0 < f * 100ull) __builtin_amdgcn_s_sleep(32);
    }
#endif
#undef GRID_BAR
}

extern "C" void kernel_launch(void* const* d_in, const int* in_sizes, int n_in, void* d_out, int out_size, void* d_ws, size_t ws_size, hipStream_t stream) {
    static int grid = 0;
    if (grid == 0) {
        if (n_in != 26 || in_sizes[0] != M * D || out_size != M * D || ws_size < WS_END) { fprintf(stderr, "kernel_launch: unexpected shapes (n_in %d, in0 %d, out %d, ws %zu); nothing launched\n", n_in, n_in > 0 ? in_sizes[0] : -1, out_size, ws_size); grid = -1; return; }
        int dev = 0, cus = 0, per_cu = 0;
        if (hipGetDevice(&dev) != hipSuccess || hipDeviceGetAttribute(&cus, hipDeviceAttributeMultiprocessorCount, dev) != hipSuccess) { fprintf(stderr, "kernel_launch: device query failed\n"); grid = -1; return; }
        if (hipFuncSetAttribute((const void*)hybrid_fwd, hipFuncAttributeMaxDynamicSharedMemorySize, LDS_BYTES) != hipSuccess) { fprintf(stderr, "kernel_launch: hipFuncSetAttribute failed\n"); grid = -1; return; }
        if (hipOccupancyMaxActiveBlocksPerMultiprocessor(&per_cu, (const void*)hybrid_fwd, NWAVES * 64, LDS_BYTES) != hipSuccess || per_cu < 1)
            fprintf(stderr, "kernel_launch: note: occupancy query reports %d workgroups per CU\n", per_cu);
        (void)hipGetLastError();
        grid = cus;
    }
    if (grid < 0) return;
    if (hipMemsetAsync((char*)d_ws + WS_CTL, 0, CTL_ZERO_BYTES, stream) != hipSuccess) { fprintf(stderr, "kernel_launch: hipMemsetAsync failed\n"); return; }
    Args a{};
    for (int i = 0; i < 26; ++i) a.in[i] = (const float*)d_in[i];
    a.out = (float*)d_out; a.ws = (unsigned char*)d_ws;
    hipLaunchKernelGGL(hybrid_fwd, dim3(grid), dim3(NWAVES * 64), LDS_BYTES, stream, a);
    const hipError_t le = hipPeekAtLastError();
    if (le != hipSuccess) fprintf(stderr, "kernel_launch: launch failed: %s\n", hipGetErrorName(le));
}
```

```cpp
#include <hip/hip_runtime.h>
#include <cstdio>
#include <cstdint>
namespace pg8 {
#define PG8_LAS __attribute__((address_space(3)))
typedef unsigned short bf16_t;
typedef short bf16x8 __attribute__((ext_vector_type(8)));
typedef float f32x4 __attribute__((ext_vector_type(4)));
typedef unsigned u32x4 __attribute__((ext_vector_type(4)));
constexpr int BM = 256, BK = 64, HALF = 128, HTB = HALF * BK * 2  , STAGE_BYTES = 8 * HTB, NXCD = 8, WGM = 8;

__host__ __device__ __forceinline__ int lds_byte(int r, int c) { const int st = (r >> 4) * 2 + (c >> 5), rr = r & 15, cc = c & 31, ob = rr * 64 + cc * 2; return st * 1024 + (ob ^ (((ob >> 9) & 1) << 5)); }
__host__ __device__ __forceinline__ void stage_rc(int b, int& R, int& C) { const int st = b / 1024, sb = b % 1024, swz = sb ^ (((sb >> 9) & 1) << 5); R = (st >> 1) * 16 + swz / 64; C = (st & 1) * 32 + (swz % 64) / 2; }
__host__ __device__ __forceinline__ int perm32(int rho) { const int n = rho >> 4, i = rho & 15; return 8 * (i >> 2) + 4 * n + (i & 3); }

struct Unit { int pm, pn; };
struct Gemm { const bf16_t* A; const bf16_t* Bt; int M, N, K; };

struct StaticOrder {
    int nM, nN, nwg, G, c;
    __host__ __device__ void init(int M, int N, int G_, int c_) { nM = M / BM; nN = N / BM; nwg = nM * nN; G = G_; c = c_; }
    __host__ __device__ bool next(int i, Unit& u) const {
        const long L = (long)i * G + c; if (L >= nwg) return false;
        int wgid = (int)L; { const int q = nwg / NXCD, r = nwg % NXCD, xcd = wgid % NXCD, off = wgid / NXCD; wgid = (xcd < r ? xcd * (q + 1) : r * (q + 1) + (xcd - r) * q) + off; }
        const int nig = WGM * nN, gid = wgid / nig, fm = gid * WGM, gsz = (nM - fm) < WGM ? (nM - fm) : WGM;
        u.pm = fm + ((wgid % nig) % gsz); u.pn = (wgid % nig) / gsz; return true;
    }
    __device__ __forceinline__ void a_ready(const Unit&) const {}
    __device__ __forceinline__ void done(const Unit&) const {}
};

__device__ __forceinline__ unsigned cvt_pk_bf16(float lo, float hi) { unsigned r; asm volatile("v_cvt_pk_bf16_f32 %0, %1, %2" : "=v"(r) : "v"(lo), "v"(hi)); return r; }
typedef float f32x2 __attribute__((ext_vector_type(2)));
__device__ __forceinline__ f32x2 gelu_pk(f32x2 v) {
    const f32x2 av = __builtin_elementwise_abs(v), d = av * 0.2316418882f + 1.0f;
    f32x2 t; t.x = __builtin_amdgcn_rcpf(d.x); t.y = __builtin_amdgcn_rcpf(d.y);
    f32x2 q = t * 0.5307027145f + (-0.7265760135f); q = q * t + 0.7107068705f; q = q * t + (-0.142248368f); q = q * t + 0.127414796f; q = q * t;
    const f32x2 s = (v * v) * (-0.72134752044f);
    f32x2 e; e.x = __builtin_amdgcn_exp2f(s.x); e.y = __builtin_amdgcn_exp2f(s.y);
    const f32x2 m = v * (q * e), r = v - m;
    f32x2 o; o.x = v.x < 0.f ? m.x : r.x; o.y = v.y < 0.f ? m.y : r.y; return o;
}

template <int ACT  > struct EpiBf16 {
    static constexpr bool PERM = true, AFTER_DRAIN = false; static_assert(ACT == 0 || ACT == 1, "EpiBf16: ACT is 0 (none) or 1 (gelu_pk)");
    bf16_t* O; int ldc; const float* bias; int split_cols; size_t split_stride; float scale0;
    __device__ __forceinline__ void operator()(const f32x4 (&acc)[2][2][4][2], const Unit& u, int wr, int wc, int fr, int fq) const {
        const int row0 = u.pm * BM + wr * 64 + fr; int colt = u.pn * BM; bf16_t* base = O;
        float sc = 1.f; if (split_cols) { const int t = colt / split_cols; base += (size_t)t * split_stride; colt -= t * split_cols; if (t == 0) sc = scale0; }
        const int col0 = colt + wc * 32 + 8 * fq, bcol0 = u.pn * BM + wc * 32 + 8 * fq;
        f32x4 bv[2][2];
#pragma unroll
        for (int bj = 0; bj < 2; ++bj)
#pragma unroll
            for (int n = 0; n < 2; ++n) bv[bj][n] = bias ? *(const f32x4*)(bias + bcol0 + bj * HALF + 4 * n) : (f32x4){0.f, 0.f, 0.f, 0.f};
#pragma unroll
        for (int ai = 0; ai < 2; ++ai)
#pragma unroll
            for (int m = 0; m < 4; ++m) { bf16_t* rowp = base + (size_t)(row0 + ai * HALF + m * 16) * ldc + col0;
#pragma unroll
                for (int bj = 0; bj < 2; ++bj) { f32x4 v0 = acc[ai][bj][m][0] + bv[bj][0], v1 = acc[ai][bj][m][1] + bv[bj][1];
                    if (ACT == 1) { f32x2 a = gelu_pk((f32x2){v0[0], v0[1]}), b = gelu_pk((f32x2){v0[2], v0[3]}), c = gelu_pk((f32x2){v1[0], v1[1]}), d = gelu_pk((f32x2){v1[2], v1[3]});
                        v0 = (f32x4){a.x, a.y, b.x, b.y}; v1 = (f32x4){c.x, c.y, d.x, d.y}; }
                    v0 = v0 * sc; v1 = v1 * sc; u32x4 w; w.x = cvt_pk_bf16(v0[0], v0[1]); w.y = cvt_pk_bf16(v0[2], v0[3]); w.z = cvt_pk_bf16(v1[0], v1[1]); w.w = cvt_pk_bf16(v1[2], v1[3]);
                    *(u32x4*)(rowp + bj * HALF) = w; } }
    }
};

struct EpiRowScaleBf16 {
    static constexpr bool PERM = true, AFTER_DRAIN = false;
    bf16_t* O; int ldc; const float* rs;
    __device__ __forceinline__ void operator()(const f32x4 (&acc)[2][2][4][2], const Unit& u, int wr, int wc, int fr, int fq) const {
        const int row0 = u.pm * BM + wr * 64 + fr; const int col0 = u.pn * BM + wc * 32 + 8 * fq;
#pragma unroll
        for (int ai = 0; ai < 2; ++ai)
#pragma unroll
            for (int m = 0; m < 4; ++m) { const int row = row0 + ai * HALF + m * 16; const float s = rs[row]; bf16_t* rowp = O + (size_t)row * ldc + col0;
#pragma unroll
                for (int bj = 0; bj < 2; ++bj) { const f32x4 v0 = acc[ai][bj][m][0] * s, v1 = acc[ai][bj][m][1] * s;
                    u32x4 w; w.x = cvt_pk_bf16(v0[0], v0[1]); w.y = cvt_pk_bf16(v0[2], v0[3]); w.z = cvt_pk_bf16(v1[0], v1[1]); w.w = cvt_pk_bf16(v1[2], v1[3]);
                    *(u32x4*)(rowp + bj * HALF) = w; } }
    }
};
struct EpiResid {
    static constexpr bool PERM = true, AFTER_DRAIN = false;
    const float* base; float* out; bf16_t* ob; float* ssq; int ldc;
    __device__ __forceinline__ void operator()(const f32x4 (&acc)[2][2][4][2], const Unit& u, int wr, int wc, int fr, int fq) const {
        const int row0 = u.pm * BM + wr * 64 + fr; const int col0 = u.pn * BM + wc * 32 + 8 * fq;
#pragma unroll
        for (int ai = 0; ai < 2; ++ai)
#pragma unroll
            for (int m = 0; m < 4; ++m) { const int row = row0 + ai * HALF + m * 16; const size_t off = (size_t)row * ldc + col0; float ss = 0.f;
#pragma unroll
                for (int bj = 0; bj < 2; ++bj) {
                    const f32x4 b0 = *(const f32x4*)(base + off + bj * HALF), b1 = *(const f32x4*)(base + off + bj * HALF + 4);
                    const f32x4 v0 = acc[ai][bj][m][0] + b0, v1 = acc[ai][bj][m][1] + b1;
                    *(f32x4*)(out + off + bj * HALF) = v0; *(f32x4*)(out + off + bj * HALF + 4) = v1;
                    ss += (v0[0] * v0[0] + v0[1] * v0[1]) + (v0[2] * v0[2] + v0[3] * v0[3]) + (v1[0] * v1[0] + v1[1] * v1[1]) + (v1[2] * v1[2] + v1[3] * v1[3]);
                    if (ob) { u32x4 w; w.x = cvt_pk_bf16(v0[0], v0[1]); w.y = cvt_pk_bf16(v0[2], v0[3]); w.z = cvt_pk_bf16(v1[0], v1[1]); w.w = cvt_pk_bf16(v1[2], v1[3]);
                        *(u32x4*)(ob + off + bj * HALF) = w; } }
                ss += __shfl_xor(ss, 16); ss += __shfl_xor(ss, 32);
                if (fq == 0) atomicAdd(ssq + row, ss); }
    }
};
struct EpiSwiGLU {
    static constexpr bool PERM = true, AFTER_DRAIN = false;
    bf16_t* O; int ldc; const float* ssq; float eps;
    __device__ __forceinline__ void operator()(const f32x4 (&acc)[2][2][4][2], const Unit& u, int wr, int wc, int fr, int fq) const {
        const int row0 = u.pm * BM + wr * 64 + fr; const int col0 = u.pn * HALF + wc * 32 + 8 * fq;
#pragma unroll
        for (int ai = 0; ai < 2; ++ai)
#pragma unroll
            for (int m = 0; m < 4; ++m) { const int row = row0 + ai * HALF + m * 16; const float s = 1.0f / sqrtf(ssq[row] * (1.0f / 1024.0f) + eps);
                float a[8];
#pragma unroll
                for (int n = 0; n < 2; ++n)
#pragma unroll
                    for (int j = 0; j < 4; ++j) { const float g = acc[ai][0][m][n][j] * s, up = acc[ai][1][m][n][j] * s; a[n * 4 + j] = g / (1.0f + __expf(-g)) * up; }
                u32x4 w; w.x = cvt_pk_bf16(a[0], a[1]); w.y = cvt_pk_bf16(a[2], a[3]); w.z = cvt_pk_bf16(a[4], a[5]); w.w = cvt_pk_bf16(a[6], a[7]);
                *(u32x4*)(O + (size_t)row * ldc + col0) = w; }
    }
};
template <class Epi, class Sched, bool ALIGN_EPI = false, bool SP2 = false>
__device__ __forceinline__ void gemm_phase(PG8_LAS unsigned char* lds, const Gemm g, const Sched& S, const Epi& E) {
    const int tid = threadIdx.x, wid = __builtin_amdgcn_readfirstlane(tid >> 6), lane = tid & 63, wr = wid >> 2, wc = wid & 3, fr = lane & 15, fq = lane >> 4;
    const int K = g.K, nt = K / BK;
    unsigned voffA[2], voffB[2];
#pragma unroll
    for (int i = 0; i < 2; ++i) { int R, C; stage_rc(tid * 16 + i * 8192, R, C); const int Rb = Epi::PERM ? ((R & ~31) + perm32(R & 31)) : R;
        voffA[i] = (unsigned)(R * K + C) * 2u; voffB[i] = (unsigned)(Rb * K + C) * 2u; }
    const size_t kstep = (size_t)(BK * 2);
    const size_t hstep = (size_t)HALF * K * 2;
    const size_t tstep = 2 * hstep;
    const unsigned ldsw = (unsigned)wid * 1024u;
    const int aoff = lds_byte(wr * 64 + fr, fq * 8), boff = lds_byte(wc * 32 + fr, fq * 8);
#define PG8_SA(b, h) (((b) * 2 + (h)) * HTB)
#define PG8_SB(b, h) ((4 + (b) * 2 + (h)) * HTB)
#define PG8_STAGE(bufoff, gbase, voff) do { _Pragma("unroll") for (int _i = 0; _i < 2; ++_i) \
        __builtin_amdgcn_global_load_lds((const unsigned*)((const char*)(gbase) + (voff)[_i]), (PG8_LAS unsigned*)(lds + (bufoff) + ldsw + _i * 8192), 16, 0, 0); } while (0)
#define PG8_LDA(dst, b, h) do { _Pragma("unroll") for (int m = 0; m < 4; ++m) _Pragma("unroll") for (int k = 0; k < 2; ++k) dst[m][k] = *(const PG8_LAS bf16x8*)(lds + PG8_SA(b, h) + aoff + m * 2048 + k * 1024); } while (0)
#define PG8_LDB(dst, b, h) do { _Pragma("unroll") for (int n = 0; n < 2; ++n) _Pragma("unroll") for (int k = 0; k < 2; ++k) dst[n][k] = *(const PG8_LAS bf16x8*)(lds + PG8_SB(b, h) + boff + n * 2048 + k * 1024); } while (0)
#define PG8_MMA(ai, bj, At, Bt) do { __builtin_amdgcn_s_setprio(1); _Pragma("unroll") for (int m = 0; m < 4; ++m) _Pragma("unroll") for (int n = 0; n < 2; ++n) _Pragma("unroll") for (int k = 0; k < 2; ++k) \
        acc[ai][bj][m][n] = __builtin_amdgcn_mfma_f32_16x16x32_bf16(Bt[n][k], At[m][k], acc[ai][bj][m][n], 0, 0, 0); __builtin_amdgcn_s_setprio(0); } while (0)
#define PG8_WAIT_V(n) asm volatile("s_waitcnt vmcnt(" #n ")" ::: "memory")
#define PG8_WAIT_L(n) asm volatile("s_waitcnt lgkmcnt(" #n ")" ::: "memory")
#define PG8_BAR __builtin_amdgcn_s_barrier()
#define PG8_SCHED __builtin_amdgcn_sched_barrier(0)
    Unit cur, nxt; int ui = 0;
    if (!S.next(0, cur)) return;
    f32x4 acc[2][2][4][2];
#pragma unroll
    for (int a = 0; a < 2; ++a)
#pragma unroll
        for (int b = 0; b < 2; ++b)
#pragma unroll
            for (int m = 0; m < 4; ++m)
#pragma unroll
                for (int n = 0; n < 2; ++n) acc[a][b][m][n] = (f32x4){0.f, 0.f, 0.f, 0.f};
    bf16x8 At[4][2], B0[2][2], B1[2][2];
    const char* cA = (const char*)g.A + (size_t)cur.pm * tstep; const char* cB = (const char*)g.Bt + (size_t)cur.pn * tstep;
    S.a_ready(cur);
    if constexpr (SP2) {
        PG8_STAGE(PG8_SB(0, 0), cB, voffB); PG8_STAGE(PG8_SB(0, 1), cB + hstep, voffB); PG8_STAGE(PG8_SA(0, 0), cA, voffA); PG8_STAGE(PG8_SA(0, 1), cA + hstep, voffA);
        if (wr == 1) PG8_BAR;
        PG8_WAIT_V(2); PG8_BAR;
        PG8_STAGE(PG8_SB(1, 0), cB + kstep, voffB); PG8_STAGE(PG8_SA(1, 0), cA + kstep, voffA); PG8_STAGE(PG8_SB(1, 1), cB + hstep + kstep, voffB);
        PG8_WAIT_V(6); PG8_BAR;
    } else {
        PG8_STAGE(PG8_SB(0, 0), cB, voffB); PG8_STAGE(PG8_SA(0, 0), cA, voffA); PG8_STAGE(PG8_SB(0, 1), cB + hstep, voffB); PG8_STAGE(PG8_SA(0, 1), cA + hstep, voffA);
        if (wr == 1) PG8_BAR;
        PG8_WAIT_V(4); PG8_BAR;
        PG8_STAGE(PG8_SB(1, 0), cB + kstep, voffB); PG8_STAGE(PG8_SA(1, 0), cA + kstep, voffA); PG8_STAGE(PG8_SB(1, 1), cB + hstep + kstep, voffB);
        PG8_WAIT_V(6); PG8_BAR;
    }
    for (;;) {
        const bool has_next = S.next(ui + 1, nxt);
        const char* nA = has_next ? (const char*)g.A + (size_t)nxt.pm * tstep : cA; const char* nB = has_next ? (const char*)g.Bt + (size_t)nxt.pn * tstep : cB;
        for (int t = 0; t < nt; t += 2) {
            const bool last = (t == nt - 2);
            const char* a1 = cA + (size_t)(t + 1) * kstep;
            const char* a2 = last ? nA : cA + (size_t)(t + 2) * kstep; const char* b2 = last ? nB : cB + (size_t)(t + 2) * kstep;
            const char* a3 = a2 + kstep; const char* b3 = b2 + kstep;
            if (last && has_next) S.a_ready(nxt);
            if constexpr (SP2) {
            PG8_LDB(B0, 0, 0); PG8_LDB(B1, 0, 1); PG8_SCHED; PG8_LDA(At, 0, 0); PG8_STAGE(PG8_SA(1, 1), a1 + hstep, voffA);
            PG8_WAIT_V(8); PG8_WAIT_L(0); PG8_BAR; PG8_MMA(0, 0, At, B0); PG8_MMA(0, 1, At, B1); PG8_BAR; PG8_SCHED;
            PG8_LDA(At, 0, 1); PG8_STAGE(PG8_SB(0, 0), b2, voffB); PG8_STAGE(PG8_SB(0, 1), b2 + hstep, voffB); PG8_STAGE(PG8_SA(0, 0), a2, voffA);
            PG8_WAIT_V(8); PG8_WAIT_L(0); PG8_BAR; PG8_MMA(1, 0, At, B0); PG8_MMA(1, 1, At, B1); PG8_BAR; PG8_SCHED;
            PG8_LDB(B0, 1, 0); PG8_LDB(B1, 1, 1); PG8_SCHED; PG8_LDA(At, 1, 0); PG8_STAGE(PG8_SA(0, 1), a2 + hstep, voffA);
            PG8_WAIT_V(8); PG8_WAIT_L(0); PG8_BAR; PG8_MMA(0, 0, At, B0); PG8_MMA(0, 1, At, B1); PG8_BAR; PG8_SCHED;
            PG8_LDA(At, 1, 1); PG8_STAGE(PG8_SB(1, 0), b3, voffB); PG8_STAGE(PG8_SB(1, 1), b3 + hstep, voffB); PG8_STAGE(PG8_SA(1, 0), a3, voffA);
            PG8_WAIT_V(8); PG8_WAIT_L(0); PG8_BAR; PG8_MMA(1, 0, At, B0); PG8_MMA(1, 1, At, B1); PG8_BAR; PG8_SCHED;
            } else {
            PG8_LDB(B0, 0, 0); PG8_SCHED; PG8_LDA(At, 0, 0); PG8_STAGE(PG8_SA(1, 1), a1 + hstep, voffA);
            PG8_WAIT_L(8); PG8_BAR; PG8_WAIT_L(0); PG8_MMA(0, 0, At, B0); PG8_BAR; PG8_SCHED;
            PG8_LDB(B1, 0, 1); PG8_STAGE(PG8_SB(0, 0), b2, voffB);
            PG8_BAR; PG8_WAIT_L(0); PG8_MMA(0, 1, At, B1); PG8_BAR;
            PG8_LDA(At, 0, 1); PG8_STAGE(PG8_SA(0, 0), a2, voffA);
            PG8_BAR; PG8_WAIT_L(0); PG8_MMA(1, 0, At, B0); PG8_BAR; PG8_SCHED;
            PG8_STAGE(PG8_SB(0, 1), b2 + hstep, voffB);
            PG8_WAIT_V(6); PG8_BAR; PG8_MMA(1, 1, At, B1); PG8_BAR;
            PG8_LDB(B0, 1, 0); PG8_SCHED; PG8_LDA(At, 1, 0); PG8_STAGE(PG8_SA(0, 1), a2 + hstep, voffA);
            PG8_WAIT_L(8); PG8_BAR; PG8_WAIT_L(0); PG8_MMA(0, 0, At, B0); PG8_BAR; PG8_SCHED;
            PG8_LDB(B1, 1, 1); PG8_STAGE(PG8_SB(1, 0), b3, voffB);
            PG8_BAR; PG8_WAIT_L(0); PG8_MMA(0, 1, At, B1); PG8_BAR;
            PG8_LDA(At, 1, 1); PG8_STAGE(PG8_SA(1, 0), a3, voffA);
            PG8_BAR; PG8_WAIT_L(0); PG8_MMA(1, 0, At, B0); PG8_BAR; PG8_SCHED;
            PG8_STAGE(PG8_SB(1, 1), b3 + hstep, voffB);
            PG8_WAIT_V(6); PG8_BAR; PG8_MMA(1, 1, At, B1); PG8_BAR;
            }
        }
        if constexpr (ALIGN_EPI) { if (wr == 0) PG8_BAR; }
        if constexpr (!Epi::AFTER_DRAIN) { E(acc, cur, wr, wc, fr, fq); S.done(cur); }
        if (!has_next) break;
#pragma unroll
        for (int a = 0; a < 2; ++a)
#pragma unroll
            for (int b = 0; b < 2; ++b)
#pragma unroll
                for (int m = 0; m < 4; ++m)
#pragma unroll
                    for (int n = 0; n < 2; ++n) acc[a][b][m][n] = (f32x4){0.f, 0.f, 0.f, 0.f};
        cur = nxt; cA = nA; cB = nB; ++ui;
        if constexpr (ALIGN_EPI) { if (wr == 1) PG8_BAR; }
    }
    PG8_WAIT_V(0);
    if constexpr (!ALIGN_EPI) { if (wr == 0) PG8_BAR; }
    PG8_BAR;
    if constexpr (Epi::AFTER_DRAIN) { E.fused(acc, cur, wr, wc, fr, fq, lds, wid, lane); S.done(cur); }
#undef PG8_SA
#undef PG8_SB
#undef PG8_STAGE
#undef PG8_LDA
#undef PG8_LDB
#undef PG8_MMA
#undef PG8_WAIT_V
#undef PG8_WAIT_L
#undef PG8_BAR
#undef PG8_SCHED
}
}

#ifndef PG8_SP2
#define PG8_SP2 true
#endif
#ifndef PG8_ALIGN
#define PG8_ALIGN true
#endif

constexpr int NWAVES = 8;
constexpr int BATCH = 2, T = 8192, D = 1024, M = BATCH * T;
constexpr int NIN = 3096, NMAIN = 3072, DFF = 2816, NGU = 2 * DFF;
constexpr int C_R = 0, C_K = 512, C_V = 1024, C_DW = 1536, C_DA = 1600, C_DG = 1664, C_Q = 1792, C_KC = 2304, C_VC = 2432, C_KS = 2560, C_VS = 2688, C_KW = 2816, C_VW = 2944, C_GL = 3072;
constexpr int NCMP = 511, NCMPP = 512;
constexpr float NORM_EPS = 1e-6f, GN_EPS = 64e-5f, NEGV = -1e30f, BIGV = 1e30f;

constexpr size_t MiB = 1u << 20;
constexpr size_t WS_CTL = 0, CTL_ZERO_BYTES = 1 * MiB;
constexpr size_t WS_WIN = 2 * MiB;
constexpr size_t WS_WOUT = 9 * MiB;
constexpr size_t WS_WGU = 11 * MiB;
constexpr size_t WS_WD = 22 * MiB;
constexpr size_t WS_RSTD1 = 28 * MiB;
constexpr size_t WS_GATES = 28 * MiB + 256 * 1024;
constexpr size_t WS_CMP = 30 * MiB;
constexpr size_t WS_LORA = 31 * MiB;
constexpr size_t WS_XB = 32 * MiB;
constexpr size_t WS_PB = 64 * MiB;
constexpr size_t WS_HB = 160 * MiB;
constexpr size_t WS_G = 192 * MiB;
constexpr size_t WS_VS = 224 * MiB;
constexpr size_t WS_BONUS = 240 * MiB;
constexpr size_t WS_VT = 242 * MiB;
constexpr size_t WS_CW1T = 250 * MiB;
constexpr size_t WS_CW2T = 252 * MiB;
constexpr size_t WS_END = 256 * MiB;
constexpr int CW_BAR = 4096;
constexpr int CW_SSQ2 = 65536;
constexpr int CW_SSQ3 = 65536 + 16384;
constexpr int CW_QUEUE = 2048;
constexpr int CW_BIAS1 = 3072;
static_assert((CW_SSQ3 + 16384) * 4 <= (int)CTL_ZERO_BYTES, "ctl");

constexpr int RING_OFF = 0, RING_BYTES = 131072;
constexpr int LDSCTL_OFF = RING_BYTES, MISC_OFF = LDSCTL_OFF + 320;
constexpr int LDS_BYTES = 147456;
#define GAS __attribute__((address_space(1)))
#define LAS __attribute__((address_space(3)))
typedef unsigned short bf16;
typedef unsigned v4u __attribute__((ext_vector_type(4)));
typedef float f32x4 __attribute__((ext_vector_type(4)));
typedef short bf16x8 __attribute__((ext_vector_type(8)));
typedef GAS unsigned gu32;
typedef GAS unsigned long long gu64;
#define RLX_AGENT __ATOMIC_RELAXED, __HIP_MEMORY_SCOPE_AGENT
#define LDS_WAIT() asm volatile("s_waitcnt lgkmcnt(0)" ::: "memory")
#define VM_WAIT() asm volatile("s_waitcnt vmcnt(0)" ::: "memory")
__device__ __forceinline__ unsigned long long rt() { return __builtin_amdgcn_s_memrealtime(); }
__device__ __forceinline__ unsigned f2bf(float f) { unsigned u = __builtin_bit_cast(unsigned, f); return (u + 0x7fffu + ((u >> 16) & 1u)) >> 16; }
__device__ __forceinline__ unsigned pk2(float lo, float hi) { return f2bf(lo) | (f2bf(hi) << 16); }

#define XB_TMO      128
#define XB_XCNT(j)  (256  + 64 * (j))
#define XB_XSUB(j)  (1280 + 64 * (j))
#define XB_XGEN(j)  (2304 + 64 * (j))
#define XB_TOP      3328
#define XB_TOPGEN   3392
#define XCD_BAR_WORDS 3456
#define XB_SPIN_CAP (1u << 18)

__device__ __forceinline__ unsigned xb_ld(unsigned* p)              { return __hip_atomic_load(p, __ATOMIC_RELAXED, __HIP_MEMORY_SCOPE_AGENT); }
__device__ __forceinline__ unsigned xb_add(unsigned* p, unsigned v) { return __hip_atomic_fetch_add(p, v, __ATOMIC_RELAXED, __HIP_MEMORY_SCOPE_AGENT); }
__device__ __forceinline__ unsigned xb_xcc_id() { return (unsigned)__builtin_amdgcn_s_getreg((3 << 11) | 20) & 0xFu; }
#define XB_SPIN(cond, bar) do { unsigned _sp = 0; while (cond) { __builtin_amdgcn_s_sleep(1); \
    if ((++_sp & 255u) == 0u) { if (xb_ld(&(bar)[XB_TMO])) break; if (_sp > XB_SPIN_CAP) { atomicAdd(&(bar)[XB_TMO], 1u); break; } } } } while (0)

struct XcdBarrier {
    unsigned* bar; unsigned x;
    volatile LAS unsigned* st;
};

__device__ __forceinline__ XcdBarrier xcd_barrier_post(unsigned* bar, volatile LAS unsigned* st) {
    XcdBarrier b; b.bar = bar; b.x = xb_xcc_id(); b.st = st;
    if (threadIdx.x == 0) (void)xb_add(&bar[XB_XCNT(b.x)], 1u);
    return b;
}
__device__ __forceinline__ void xcd_barrier_complete(unsigned* bar, unsigned x, unsigned& nloc, unsigned& nx) {
    const unsigned G = gridDim.x * gridDim.y * gridDim.z;
    unsigned sum, cnt, mine, sp = 0u;
    for (;;) {
        sum = 0u; cnt = 0u; mine = 0u;
#pragma unroll
        for (unsigned j = 0; j < 16; ++j) { const unsigned c = xb_ld(&bar[XB_XCNT(j)]); sum += c; cnt += (c > 0u) ? 1u : 0u; mine = (j == x) ? c : mine; }
        if (sum == G) break;
        __builtin_amdgcn_s_sleep(1);
        if ((++sp & 255u) == 0u) { if (xb_ld(&bar[XB_TMO])) break; if (sp > XB_SPIN_CAP) { atomicAdd(&bar[XB_TMO], 1u); break; } }
    }
    nloc = mine > 0u ? mine : 1u; nx = cnt > 0u ? cnt : 1u;
}

__device__ __forceinline__ void xcd_barrier(const XcdBarrier& b) {
    asm volatile("s_waitcnt vmcnt(0)" ::: "memory");
    __syncthreads();
    if (threadIdx.x == 0) {
        unsigned* bar = b.bar;
        __builtin_amdgcn_s_waitcnt(0);
        unsigned nloc = b.st[0], nx = b.st[1];
        if (nloc == 0u) { xcd_barrier_complete(bar, b.x, nloc, nx); b.st[0] = nloc; b.st[1] = nx; }
        const unsigned old = xb_add(&bar[XB_XSUB(b.x)], 1u);
        const unsigned gen = old / nloc;
        if (old + 1u == (gen + 1u) * nloc) {
            __builtin_amdgcn_fence(__ATOMIC_RELEASE, "agent");
            asm volatile("s_waitcnt vmcnt(0)" ::: "memory");
            const unsigned og = xb_add(&bar[XB_TOP], 1u);
            const unsigned tg = og / nx;
            if (og + 1u == (tg + 1u) * nx) xb_add(&bar[XB_TOPGEN], 1u);
            else XB_SPIN(xb_ld(&bar[XB_TOPGEN]) == tg, bar);
            __builtin_amdgcn_fence(__ATOMIC_ACQUIRE, "agent");
            xb_add(&bar[XB_XGEN(b.x)], 1u);
            asm volatile("s_waitcnt vmcnt(0)" ::: "memory");
        } else {
            XB_SPIN(xb_ld(&bar[XB_XGEN(b.x)]) == gen, bar);
            __builtin_amdgcn_fence(__ATOMIC_ACQUIRE, "agent");
            asm volatile("s_waitcnt vmcnt(0)" ::: "memory");
        }
    }
    __syncthreads();
}


struct Frame {
    LAS unsigned char* lds;
    volatile LAS unsigned* MISC;
    gu32* ctl;
    int tid, lane, wave;
    int vcu, G;
    const float* in[26];
    float* out; unsigned char* ws;
};
__device__ __forceinline__ float wave_sum(float v) {
#pragma unroll
    for (int o = 1; o < 64; o <<= 1) v += __shfl_xor(v, o);
    return v;
}
__device__ __forceinline__ float wave_max(float v) {
#pragma unroll
    for (int o = 1; o < 64; o <<= 1) v = fmaxf(v, __shfl_xor(v, o));
    return v;
}
__device__ __forceinline__ float bf2f(bf16 b) { return __builtin_bit_cast(float, (unsigned)b << 16); }
__device__ __forceinline__ float sigmoidf_(float x) { return 1.0f / (1.0f + expf(-x)); }
__device__ __forceinline__ float softplusf_(float z) { return z > 20.f ? z : log1pf(expf(z)); }
__device__ __forceinline__ float fexp_(float x) { return __builtin_amdgcn_exp2f(x * 1.4426950408889634f); }
__device__ __forceinline__ float frcp_(float x) { return __builtin_amdgcn_rcpf(x); }
__device__ __forceinline__ float fsigmoid_(float x) { return frcp_(1.0f + fexp_(-x)); }
__device__ __forceinline__ float ftanh_(float x) { return 1.0f - 2.0f * frcp_(1.0f + fexp_(2.0f * x)); }
__device__ __forceinline__ float fsoftplus_(float z) { return z > 15.f ? z : __builtin_amdgcn_logf(1.0f + fexp_(z)) * 0.6931471805599453f; }
__device__ __forceinline__ float fgelu_tanh_(float x) { const float u = 0.7978845608028654f * (x + 0.044715f * x * x * x); return 0.5f * x * (1.0f + ftanh_(u)); }
__device__ __forceinline__ float gelu_tanhf_(float x) { const float u = 0.7978845608028654f * (x + 0.044715f * x * x * x); return 0.5f * x * (1.0f + tanhf(u)); }

template <int MODE  >
__device__ __forceinline__ void p0_transpose_item(const float* W, int K, int N, const float* gain, bf16* WT, LAS float* scr, int item, int lane) {
    const int nblk = (N + 31) / 32, kb = item / nblk, nb = item % nblk, k0 = 64 * kb, n0 = 32 * nb;
#pragma unroll 8
    for (int i = 0; i < 32; ++i) { const int kk = 2 * i + (lane >> 5); const int n = n0 + (lane & 31);
        float v = 0.f; if (n < N) { v = W[(size_t)(k0 + kk) * N + n]; if (gain) v *= gain[k0 + kk]; }
        scr[kk * 33 + (lane & 31)] = v; }
    LDS_WAIT(); asm volatile("" ::: "memory");
    const int c = lane & 7;
    int rb = n0; if (MODE == 1) rb = 256 * (n0 / 128) + (n0 % 128); if (MODE == 2) rb = 256 * (n0 / 128) + 128 + (n0 % 128);
#pragma unroll
    for (int j = 0; j < 4; ++j) { const int n = (lane >> 3) + 8 * j; const LAS float* s = scr + (8 * c) * 33 + n;
        v4u o; o.x = pk2(s[0 * 33], s[1 * 33]); o.y = pk2(s[2 * 33], s[3 * 33]); o.z = pk2(s[4 * 33], s[5 * 33]); o.w = pk2(s[6 * 33], s[7 * 33]);
        *(GAS v4u*)(WT + (size_t)(rb + n) * K + k0 + 8 * c) = o; }
    LDS_WAIT(); asm volatile("" ::: "memory");
}
__device__ __forceinline__ void p0_prologue(Frame& F) {
    LAS float* scr = (LAS float*)(F.lds + RING_OFF + F.wave * 16384);
    const int gw = F.vcu * NWAVES + F.wave, NGW = F.G * NWAVES;
    constexpr int I_IN = (D / 64) * ((NIN + 31) / 32), I_OUT = (D / 64) * (D / 32), I_G = (D / 64) * (DFF / 32), I_D = (DFF / 64) * (D / 32);
    constexpr int I_L = 16, I_LG = 32;
    constexpr int I_C1 = (2048 / 64) * (256 / 32), I_C2 = (256 / 64) * (64 / 32), I_B1 = 64;
    constexpr int NITEMS = I_IN + I_OUT + 2 * I_G + I_D + 2 * I_L + I_LG + 2 * I_C1 + 2 * I_C2 + I_B1;
    bf16* CW1T = (bf16*)(F.ws + WS_CW1T); bf16* CW2T = (bf16*)(F.ws + WS_CW2T);
    bf16* W2T = (bf16*)(F.ws + WS_LORA); bf16* A2T = W2T + 512 * 64; bf16* G2T = A2T + 512 * 64;
    bf16* Win_t = (bf16*)(F.ws + WS_WIN); bf16* Wout_t = (bf16*)(F.ws + WS_WOUT); bf16* Wgu_t = (bf16*)(F.ws + WS_WGU); bf16* Wd_t = (bf16*)(F.ws + WS_WD);
    for (int it = gw; it < NITEMS; it += NGW) {
        int r = it;
        if (r < I_IN) { p0_transpose_item<0>(F.in[2], D, NIN, F.in[1], Win_t, scr, r, F.lane); continue; } r -= I_IN;
        if (r < I_OUT) { p0_transpose_item<0>(F.in[20], D, D, nullptr, Wout_t, scr, r, F.lane); continue; } r -= I_OUT;
        if (r < I_G) { p0_transpose_item<1>(F.in[22], D, DFF, F.in[21], Wgu_t, scr, r, F.lane); continue; } r -= I_G;
        if (r < I_G) { p0_transpose_item<2>(F.in[23], D, DFF, F.in[21], Wgu_t, scr, r, F.lane); continue; } r -= I_G;
        if (r < I_D) { p0_transpose_item<0>(F.in[24], DFF, D, nullptr, Wd_t, scr, r, F.lane); continue; } r -= I_D;
        if (r < I_L) { p0_transpose_item<0>(F.in[5], 64, 512, nullptr, W2T, scr, r, F.lane); continue; } r -= I_L;
        if (r < I_L) { p0_transpose_item<0>(F.in[7], 64, 512, nullptr, A2T, scr, r, F.lane); continue; } r -= I_L;
        if (r < I_LG) { p0_transpose_item<0>(F.in[8], 128, 512, nullptr, G2T, scr, r, F.lane); continue; } r -= I_LG;
        if (r < I_C1) { p0_transpose_item<0>(F.in[16], 2048, 256, nullptr, CW1T, scr, r, F.lane); continue; } r -= I_C1;
        if (r < I_C1) { p0_transpose_item<0>(F.in[18], 2048, 256, nullptr, CW1T + 256 * 2048, scr, r, F.lane); continue; } r -= I_C1;
        if (r < I_C2) { p0_transpose_item<0>(F.in[17], 256, 64, nullptr, CW2T, scr, r, F.lane); continue; } r -= I_C2;
        if (r < I_C2) { p0_transpose_item<0>(F.in[19], 256, 64, nullptr, CW2T + 64 * 256, scr, r, F.lane); continue; } r -= I_C2;
        { const int kv = r >> 5, ng = (r >> 3) & 3, kp = r & 7; const float* pe = kv ? F.in[15] : F.in[14]; const float* W1 = kv ? F.in[18] : F.in[16];
          float a = 0.f; const int n = ng * 64 + F.lane;
#pragma unroll 8
          for (int k = kp * 256; k < kp * 256 + 256; ++k) a += pe[k] * W1[(size_t)k * 256 + n];
          atomicAdd((float*)(F.ctl + CW_BIAS1) + kv * 256 + n, a); }
    }
    bf16* XB = (bf16*)(F.ws + WS_XB); float* rstd1 = (float*)(F.ws + WS_RSTD1);
    for (int m = gw; m < M; m += NGW) {
        const GAS f32x4* xr = (const GAS f32x4*)(F.in[0] + (size_t)m * D) + F.lane;
        f32x4 v[4]; float s = 0.f;
#pragma unroll
        for (int j = 0; j < 4; ++j) { v[j] = xr[64 * j]; s += (v[j].x * v[j].x + v[j].y * v[j].y) + (v[j].z * v[j].z + v[j].w * v[j].w); }
        const float tot = wave_sum(s);
        GAS unsigned long long* o8 = (GAS unsigned long long*)(XB + (size_t)m * D) + F.lane;
#pragma unroll
        for (int j = 0; j < 4; ++j) o8[64 * j] = (unsigned long long)pk2(v[j].x, v[j].y) | ((unsigned long long)pk2(v[j].z, v[j].w) << 32);
        if (F.lane == 0) rstd1[m] = 1.0f / sqrtf(tot * (1.0f / D) + NORM_EPS);
    }
}

__device__ __forceinline__ void p2_gates_naive(Frame& F) {
    const int gw = F.vcu * NWAVES + F.wave, NGW = F.G * NWAVES, lane = F.lane;
    const bf16* XB = (const bf16*)(F.ws + WS_XB); const bf16* Wg = (const bf16*)(F.ws + WS_WIN) + (size_t)C_GL * D; const float* rstd1 = (const float*)(F.ws + WS_RSTD1);
    float* gates = (float*)(F.ws + WS_GATES);
    for (int m = gw; m < M; m += NGW) {
        float xv[16];
        { const bf16x8 a = *(const bf16x8*)(XB + (size_t)m * D + lane * 16), b = *(const bf16x8*)(XB + (size_t)m * D + lane * 16 + 8);
#pragma unroll
          for (int j = 0; j < 8; ++j) { xv[j] = bf2f((bf16)a[j]); xv[8 + j] = bf2f((bf16)b[j]); } }
        const float rs = rstd1[m];
        float mine = 0.f;
        for (int j = 0; j < 24; ++j) {
            const bf16x8 a = *(const bf16x8*)(Wg + (size_t)j * D + lane * 16), b = *(const bf16x8*)(Wg + (size_t)j * D + lane * 16 + 8);
            float s = 0.f;
#pragma unroll
            for (int q = 0; q < 8; ++q) { s += xv[q] * bf2f((bf16)a[q]); s += xv[8 + q] * bf2f((bf16)b[q]); }
            s = wave_sum(s);
            if (lane == j) mine = s;
        }
        if (lane < 24) gates[(size_t)m * 24 + lane] = sigmoidf_(mine * rs);
    }
}
__device__ __forceinline__ void p2_rwkv_prep_naive(Frame& F) {
    LAS float* L = (LAS float*)(F.lds + RING_OFF);
    const bf16* PB = (const bf16*)(F.ws + WS_PB);
    const float* mu = F.in[3]; const float* w0 = F.in[4]; const float* w2 = F.in[5]; const float* a0 = F.in[6]; const float* a2 = F.in[7]; const float* g2 = F.in[8];
    float* wdec = F.out; float* asig = F.out + (size_t)M * 512; float* gg = (float*)(F.ws + WS_G);
    const int c = F.tid;
    for (int it = F.vcu; it < M / 16; it += F.G) {
        const int r0 = it * 16;
        for (int idx = F.tid; idx < 16 * 256; idx += NWAVES * 64) {
            const int tok = idx >> 8, j = idx & 255; const int row = r0 + tok; const int col = C_DW + j;
            const float p = bf2f(PB[(size_t)row * NMAIN + col]);
            const float pp = ((row % T) == 0) ? 0.f : bf2f(PB[(size_t)(row - 1) * NMAIN + col]);
            const float ps = p + mu[col] * (pp - p);
            L[tok * 256 + j] = (j < 64) ? tanhf(ps) : (j < 128 ? ps : sigmoidf_(ps));
        }
        __syncthreads();
        float aw[16], aa[16], ag[16];
#pragma unroll
        for (int k = 0; k < 16; ++k) { aw[k] = 0.f; aa[k] = 0.f; ag[k] = 0.f; }
        for (int j = 0; j < 64; ++j) { const float w = w2[j * 512 + c], a = a2[j * 512 + c];
#pragma unroll
            for (int k = 0; k < 16; ++k) { aw[k] += L[k * 256 + j] * w; aa[k] += L[k * 256 + 64 + j] * a; } }
        for (int j = 0; j < 128; ++j) { const float g = g2[j * 512 + c];
#pragma unroll
            for (int k = 0; k < 16; ++k) ag[k] += L[k * 256 + 128 + j] * g; }
        const float w0c = w0[c], a0c = a0[c];
#pragma unroll
        for (int k = 0; k < 16; ++k) { const size_t o = (size_t)(r0 + k) * 512 + c;
            const float wl = -softplusf_(-(w0c + aw[k])) - 0.5f;
            wdec[o] = expf(-expf(wl)); asig[o] = sigmoidf_(a0c + aa[k]); gg[o] = ag[k]; }
        __syncthreads();
    }
}
__device__ __forceinline__ void p2_compress_naive(Frame& F) {
    LAS float* X = (LAS float*)(F.lds + RING_OFF);
    LAS float* PE = X + 144 * 64;
    LAS float* HID = PE + 2048;
    const bf16* PB = (const bf16*)(F.ws + WS_PB);
    for (int it = F.vcu; it < 2 * 2 * 2 * 64; it += F.G) {
        const int kv = it >> 8, b = (it >> 7) & 1, hk = (it >> 6) & 1, c0 = (it & 63) * 8;
        const float* pe = kv ? F.in[15] : F.in[14]; const float* W1 = kv ? F.in[18] : F.in[16]; const float* W2 = kv ? F.in[19] : F.in[17];
        const int col = (kv ? C_VC : C_KC) + hk * 64;
        for (int idx = F.tid; idx < 144 * 64; idx += NWAVES * 64) { const int tok = idx >> 6, d = idx & 63; const int t = 16 * c0 + tok;
            X[idx] = (t < T) ? bf2f(PB[(size_t)(b * T + t) * NMAIN + col + d]) : 0.f; }
        for (int idx = F.tid; idx < 2048; idx += NWAVES * 64) PE[idx] = pe[idx];
        __syncthreads();
        { const int n = F.tid & 255, half = F.tid >> 8; float acc[4] = {0.f, 0.f, 0.f, 0.f};
          for (int k = 0; k < 2048; ++k) { const float w = W1[(size_t)k * 256 + n]; const int l = k >> 6, d = k & 63; const float pev = PE[k];
#pragma unroll
              for (int jj = 0; jj < 4; ++jj) acc[jj] += (X[((4 * half + jj) * 16 + l) * 64 + d] + pev) * w; }
#pragma unroll
          for (int jj = 0; jj < 4; ++jj) HID[(4 * half + jj) * 256 + n] = gelu_tanhf_(acc[jj]); }
        __syncthreads();
        { const int blk = F.tid >> 6, j = F.tid & 63; float s = 0.f;
          for (int n = 0; n < 256; ++n) s += HID[blk * 256 + n] * W2[n * 64 + j];
          const int c = c0 + blk; const int bhk = b * 2 + hk; const bf16 ov = (c < NCMP) ? (bf16)f2bf(s) : (bf16)0; const int pc = (c & ~15) | (((c >> 2) & 1) << 3) | (((c >> 3) & 1) << 2) | (c & 3);
          if (kv == 0) ((bf16*)(F.ws + WS_CMP))[((size_t)bhk * NCMPP + c) * 64 + j] = ov; else ((bf16*)(F.ws + WS_CMP + 262144))[((size_t)bhk * 64 + j) * NCMPP + pc] = ov; }
        __syncthreads();
    }
}
__device__ __forceinline__ void p3_rwkv_scan_naive(Frame& F, int b, int h) {
    const bf16* PB = (const bf16*)(F.ws + WS_PB); const float* wdec = F.out; const float* asig = F.out + (size_t)M * 512; float* yraw = (float*)(F.ws + WS_HB);
    const float* mu = F.in[3]; const float* k_k = F.in[9]; const float* k_a = F.in[10];
    const int lane = F.lane, vl = lane >> 3, kq = lane & 7, v = F.wave * 8 + vl, ch0 = h * 64 + kq * 8;
    float S[8], mur[8], muk[8], kkp[8], kap[8], pr[8], pk[8];
#pragma unroll
    for (int j = 0; j < 8; ++j) { S[j] = 0.f; mur[j] = mu[C_R + ch0 + j]; muk[j] = mu[C_K + ch0 + j]; kkp[j] = k_k[ch0 + j]; kap[j] = k_a[ch0 + j]; pr[j] = 0.f; pk[j] = 0.f; }
    const float muv = mu[C_V + h * 64 + v]; float pv = 0.f;
    const size_t row0 = (size_t)b * T;
    bf16x8 nr = *(const bf16x8*)(PB + row0 * NMAIN + C_R + ch0), nk = *(const bf16x8*)(PB + row0 * NMAIN + C_K + ch0);
    bf16 nv = PB[row0 * NMAIN + C_V + h * 64 + v];
    f32x4 nw0 = *(const f32x4*)(wdec + row0 * 512 + ch0), nw1 = *(const f32x4*)(wdec + row0 * 512 + ch0 + 4);
    f32x4 na0 = *(const f32x4*)(asig + row0 * 512 + ch0), na1 = *(const f32x4*)(asig + row0 * 512 + ch0 + 4);
    for (int t = 0; t < T; ++t) {
        const size_t row = row0 + t;
        const bf16x8 cr8 = nr, ck8 = nk; const bf16 cvb = nv; const f32x4 w0 = nw0, w1 = nw1, a0 = na0, a1 = na1;
        if (t + 1 < T) { const size_t rn = row + 1;
            nr = *(const bf16x8*)(PB + rn * NMAIN + C_R + ch0); nk = *(const bf16x8*)(PB + rn * NMAIN + C_K + ch0); nv = PB[rn * NMAIN + C_V + h * 64 + v];
            nw0 = *(const f32x4*)(wdec + rn * 512 + ch0); nw1 = *(const f32x4*)(wdec + rn * 512 + ch0 + 4);
            na0 = *(const f32x4*)(asig + rn * 512 + ch0); na1 = *(const f32x4*)(asig + rn * 512 + ch0 + 4); }
        float r[8], k[8], kk[8], wd[8], as[8];
        float ss = 0.f;
#pragma unroll
        for (int j = 0; j < 8; ++j) { const float cr = bf2f((bf16)cr8[j]), ck = bf2f((bf16)ck8[j]);
            r[j] = cr + mur[j] * (pr[j] - cr); k[j] = ck + muk[j] * (pk[j] - ck); pr[j] = cr; pk[j] = ck;
            wd[j] = j < 4 ? w0[j] : w1[j - 4]; as[j] = j < 4 ? a0[j] : a1[j - 4];
            kk[j] = k[j] * kkp[j]; ss += kk[j] * kk[j]; }
        const float cv = bf2f(cvb); const float vv = cv + muv * (pv - cv); pv = cv;
        ss += __shfl_xor(ss, 1); ss += __shfl_xor(ss, 2); ss += __shfl_xor(ss, 4);
        const float inv = 1.0f / fmaxf(sqrtf(ss), 1e-12f);
        float sa = 0.f;
#pragma unroll
        for (int j = 0; j < 8; ++j) { kk[j] *= inv; sa += S[j] * (-kk[j]); }
        sa += __shfl_xor(sa, 1); sa += __shfl_xor(sa, 2); sa += __shfl_xor(sa, 4);
        float y = 0.f;
#pragma unroll
        for (int j = 0; j < 8; ++j) { const float km = k[j] * (1.0f + (as[j] - 1.0f) * kap[j]);
            S[j] = S[j] * wd[j] + sa * (kk[j] * as[j]) + vv * km; y += S[j] * r[j]; }
        y += __shfl_xor(y, 1); y += __shfl_xor(y, 2); y += __shfl_xor(y, 4);
        if (kq == 0) yraw[row * 512 + h * 64 + v] = y;
    }
}
__device__ __forceinline__ void p3b_rwkv_out_naive(Frame& F) {
    const int gw = F.vcu * NWAVES + F.wave, NGW = F.G * NWAVES, lane = F.lane;
    const bf16* PB = (const bf16*)(F.ws + WS_PB); const float* asig = F.out + (size_t)M * 512; const float* yraw = (const float*)(F.ws + WS_HB); const float* gg = (const float*)(F.ws + WS_G);
    bf16* Y = (bf16*)(F.ws + WS_XB);
    const float* mu = F.in[3]; const float* k_a = F.in[10]; const float* r_k = F.in[11]; const float* lnw = F.in[12]; const float* lnb = F.in[13];
    for (int it = gw; it < M * 8; it += NGW) {
        const int row = it >> 3, h = it & 7, ch = h * 64 + lane;
        const float yv = yraw[(size_t)row * 512 + ch];
        const float mean = wave_sum(yv) * (1.0f / 64.0f); const float d = yv - mean; const float var = wave_sum(d * d) * (1.0f / 64.0f);
        const float yn = d * (1.0f / sqrtf(var + GN_EPS)) * lnw[ch] + lnb[ch];
        const bool first = (row % T) == 0;
        const float cr = bf2f(PB[(size_t)row * NMAIN + C_R + ch]), ck = bf2f(PB[(size_t)row * NMAIN + C_K + ch]), cv = bf2f(PB[(size_t)row * NMAIN + C_V + ch]);
        const float qr = first ? 0.f : bf2f(PB[(size_t)(row - 1) * NMAIN + C_R + ch]), qk = first ? 0.f : bf2f(PB[(size_t)(row - 1) * NMAIN + C_K + ch]), qv = first ? 0.f : bf2f(PB[(size_t)(row - 1) * NMAIN + C_V + ch]);
        const float r = cr + mu[C_R + ch] * (qr - cr), k = ck + mu[C_K + ch] * (qk - ck), vv = cv + mu[C_V + ch] * (qv - cv);
        const float as = asig[(size_t)row * 512 + ch]; const float km = k * (1.0f + (as - 1.0f) * k_a[ch]);
        const float bonus = wave_sum(r * km * r_k[ch]) * vv;
        const float o = (yn + bonus) * gg[(size_t)row * 512 + ch];
        Y[(size_t)row * D + ch] = (bf16)f2bf(o);
    }
}
__device__ __forceinline__ float dot64_lds_bf16row(const LAS float* qs, const bf16* krow) {
    float s = 0.f;
#pragma unroll
    for (int i = 0; i < 8; ++i) { const bf16x8 kv = *(const bf16x8*)(krow + 8 * i); const f32x4 q0 = *(const LAS f32x4*)(qs + 8 * i), q1 = *(const LAS f32x4*)(qs + 8 * i + 4);
        s += q0[0] * bf2f((bf16)kv[0]) + q0[1] * bf2f((bf16)kv[1]) + q0[2] * bf2f((bf16)kv[2]) + q0[3] * bf2f((bf16)kv[3]);
        s += q1[0] * bf2f((bf16)kv[4]) + q1[1] * bf2f((bf16)kv[5]) + q1[2] * bf2f((bf16)kv[6]) + q1[3] * bf2f((bf16)kv[7]); }
    return s;
}
__device__ __forceinline__ float dot64_lds_f32row(const LAS float* qs, const float* krow) {
    float s = 0.f;
#pragma unroll
    for (int i = 0; i < 16; ++i) { const f32x4 kv = *(const f32x4*)(krow + 4 * i); const f32x4 q = *(const LAS f32x4*)(qs + 4 * i); s += q[0] * kv[0] + q[1] * kv[1] + q[2] * kv[2] + q[3] * kv[3]; }
    return s;
}
#define WAVE_LDS_FENCE() asm volatile("s_waitcnt lgkmcnt(0)" ::: "memory")
__device__ __forceinline__ void nsa_token_naive(Frame& F, int b, int hk, int t, LAS float* wl) {
    LAS float* qs = wl; LAS float* pbuf = wl + 64; LAS float* ocb = wl + 64 + 1024; LAS int* seli = (LAS int*)(wl + 64 + 1024 + 256);
    const int lane = F.lane; const size_t row = (size_t)b * T + t; const int cur = t >> 6;
    const bf16* PB = (const bf16*)(F.ws + WS_PB); const float* CMPK = (const float*)(F.ws + WS_CMP) + (size_t)((0 * 2 + b) * 2 + hk) * NCMPP * 64;
    const float* CMPV = (const float*)(F.ws + WS_CMP) + (size_t)((1 * 2 + b) * 2 + hk) * NCMPP * 64;
    const float* gates = (const float*)(F.ws + WS_GATES); bf16* Y = (bf16*)(F.ws + WS_XB);
    const int nvc = t >= 31 ? ((t - 31) >> 4) + 1 : 0;
    float imp0 = 0.f, imp1 = 0.f;
    for (int g = 0; g < 4; ++g) {
        const int h = hk * 4 + g; const float slope = exp2f(-(float)(h + 1));
        WAVE_LDS_FENCE();
        qs[lane] = bf2f(PB[row * NMAIN + C_Q + h * 64 + lane]) * 0.125f;
        WAVE_LDS_FENCE();
        float o = 0.f;
        if (nvc > 0) {
            float m = -INFINITY;
            for (int c = lane; c < nvc; c += 64) { const float s = dot64_lds_f32row(qs, CMPK + (size_t)c * 64) - slope * (float)(t - (16 * c + 31)); pbuf[c] = s; m = fmaxf(m, s); }
            m = wave_max(m); float l = 0.f;
            for (int c = lane; c < nvc; c += 64) { const float e = expf(pbuf[c] - m); pbuf[c] = e; l += e; }
            l = wave_sum(l); const float inv = 1.0f / l;
            for (int c = lane; c < nvc; c += 64) pbuf[c] *= inv;
            WAVE_LDS_FENCE();
#pragma unroll
            for (int hh = 0; hh < 2; ++hh) { const int n = lane + 64 * hh; float s = 0.f;
#pragma unroll
                for (int j = -1; j < 4; ++j) { const int c = 4 * n + j; if (c >= 0 && c < nvc) s += pbuf[c] * ((j == -1 || j == 3) ? 1.f : 2.f); }
                if (hh == 0) imp0 += s; else imp1 += s; }
            for (int c = 0; c < nvc; ++c) o += pbuf[c] * CMPV[(size_t)c * 64 + lane];
        }
        ocb[g * 64 + lane] = o;
    }
    {
        float v0 = (lane > cur) ? NEGV : ((lane == 0 || lane == cur || lane == cur - 1) ? BIGV : imp0);
        const int n1 = lane + 64;
        float v1 = (n1 > cur) ? NEGV : ((n1 == cur || n1 == cur - 1) ? BIGV : imp1);
        for (int it = 0; it < 16; ++it) {
            const float m = wave_max(fmaxf(v0, v1));
            const unsigned long long b0 = __ballot(v0 == m);
            int idx;
            if (b0) { idx = __builtin_ctzll(b0); if (lane == idx) v0 = -INFINITY; }
            else { const unsigned long long b1 = __ballot(v1 == m); idx = 64 + __builtin_ctzll(b1); if (lane == idx - 64) v1 = -INFINITY; }
            if (lane == 0) seli[it] = (m > 0.5f * NEGV) ? idx : -1;
        }
        WAVE_LDS_FENCE();
    }
    for (int g = 0; g < 4; ++g) {
        const int h = hk * 4 + g; const float slope = exp2f(-(float)(h + 1));
        WAVE_LDS_FENCE();
        qs[lane] = bf2f(PB[row * NMAIN + C_Q + h * 64 + lane]) * 0.125f;
        WAVE_LDS_FENCE();
        float os = 0.f;
        {
            float m = -INFINITY;
            for (int sl = 0; sl < 16; ++sl) { const int idx = seli[sl]; float s = -INFINITY;
                if (idx >= 0) { const int pos = idx * 64 + lane; if (pos <= t) s = dot64_lds_bf16row(qs, PB + ((size_t)b * T + pos) * NMAIN + C_KS + hk * 64) - slope * (float)(t - pos); }
                pbuf[sl * 64 + lane] = s; m = fmaxf(m, s); }
            m = wave_max(m); float l = 0.f;
            for (int sl = 0; sl < 16; ++sl) { const float e = expf(pbuf[sl * 64 + lane] - m); pbuf[sl * 64 + lane] = e; l += e; }
            l = wave_sum(l); const float inv = 1.0f / l;
            WAVE_LDS_FENCE();
            for (int sl = 0; sl < 16; ++sl) { const int idx = seli[sl]; if (idx < 0) continue;
                for (int j = 0; j < 64; ++j) { const int pos = idx * 64 + j; if (pos > t) break; os += pbuf[sl * 64 + j] * bf2f(PB[((size_t)b * T + pos) * NMAIN + C_VS + hk * 64 + lane]); } }
            os *= inv;
        }
        WAVE_LDS_FENCE();
        float ow = 0.f;
        {
            float m = -INFINITY;
            for (int i = lane; i < 512; i += 64) { const int pos = t - 511 + i; float s = -INFINITY;
                if (pos >= 0) s = dot64_lds_bf16row(qs, PB + ((size_t)b * T + pos) * NMAIN + C_KW + hk * 64) - slope * (float)(t - pos);
                pbuf[i] = s; m = fmaxf(m, s); }
            m = wave_max(m); float l = 0.f;
            for (int i = lane; i < 512; i += 64) { const float e = expf(pbuf[i] - m); pbuf[i] = e; l += e; }
            l = wave_sum(l); const float inv = 1.0f / l;
            WAVE_LDS_FENCE();
            for (int i = 0; i < 512; ++i) { const int pos = t - 511 + i; if (pos < 0) continue; ow += pbuf[i] * bf2f(PB[((size_t)b * T + pos) * NMAIN + C_VW + hk * 64 + lane]); }
            ow *= inv;
        }
        const float g0 = gates[row * 24 + h * 3 + 0], g1 = gates[row * 24 + h * 3 + 1], g2 = gates[row * 24 + h * 3 + 2];
        Y[row * D + 512 + h * 64 + lane] = (bf16)f2bf(g0 * ocb[g * 64 + lane] + g1 * os + g2 * ow);
    }
}
__device__ __forceinline__ void p3_nsa_naive(Frame& F, int first_wg, int nwg) {
    LAS float* wl = (LAS float*)(F.lds + RING_OFF) + F.wave * 2048;
    const int me = (int)blockIdx.x - first_wg; if (me < 0) return;
    for (int it = me; it < 4 * (T / 8); it += nwg) {
        const int bh = it / (T / 8), tg = it % (T / 8); const int b = bh >> 1, hk = bh & 1;
        nsa_token_naive(F, b, hk, tg * 8 + F.wave, wl);
    }
}
__device__ __forceinline__ void p7_final_norm(Frame& F) {
    const int gw = F.vcu * NWAVES + F.wave, NGW = F.G * NWAVES;
    const float* ssq3 = (const float*)(F.ctl + CW_SSQ3); const float* gf = F.in[25];
    f32x4 gv[4];
#pragma unroll
    for (int j = 0; j < 4; ++j) gv[j] = *((const f32x4*)gf + F.lane + 64 * j);
    for (int m = gw; m < M; m += NGW) {
        const float rs = 1.0f / sqrtf(ssq3[m] * (1.0f / D) + NORM_EPS);
        f32x4* xr = (f32x4*)(F.out + (size_t)m * D) + F.lane;
#pragma unroll
        for (int j = 0; j < 4; ++j) { f32x4 v = xr[64 * j]; v = v * rs * gv[j]; xr[64 * j] = v; }
    }
}

typedef float f32x16 __attribute__((ext_vector_type(16)));
typedef float f32x2_t __attribute__((ext_vector_type(2))); typedef __bf16 bf16x2_t __attribute__((ext_vector_type(2)));
__device__ __forceinline__ unsigned cvtpk(float lo, float hi) { f32x2_t v = {lo, hi}; bf16x2_t b = __builtin_convertvector(v, bf16x2_t); return __builtin_bit_cast(unsigned, b); }
typedef unsigned u32x2 __attribute__((ext_vector_type(2)));
constexpr int XTRA_OFF = RING_BYTES + 1024;
#define RSLOT(i) (L + (i) * 8192)
__device__ __forceinline__ bf16x8 rfrag(const LAS unsigned char* S, int R0, int ks, int lane) {
    const int row = R0 + (lane & 15), ch = 4 * ks + (lane >> 4);
    return *(const LAS bf16x8*)(S + row * 128 + ((ch ^ (row & 7)) << 4));
}
__device__ __forceinline__ void mm64(f32x4 (&acc)[2], const LAS unsigned char* X, const LAS unsigned char* Y, int wave, int lane) {
#pragma unroll
    for (int ks = 0; ks < 2; ++ks) { const bf16x8 a = rfrag(X, 16 * (wave >> 1), ks, lane);
#pragma unroll
        for (int j = 0; j < 2; ++j) { const bf16x8 b = rfrag(Y, 16 * (2 * (wave & 1) + j), ks, lane); acc[j] = __builtin_amdgcn_mfma_f32_16x16x32_bf16(a, b, acc[j], 0, 0, 0); } }
}
__device__ __forceinline__ void st_row(LAS unsigned char* O, const f32x4 v, int m0, int n) {
    u32x2 w; w.x = cvtpk(v[0], v[1]); w.y = cvtpk(v[2], v[3]);
    *(LAS u32x2*)(O + n * 128 + ((((m0 >> 3) ^ (n & 7)) << 4) | ((m0 & 7) << 1))) = w;
}
__device__ __forceinline__ void st_tr(LAS unsigned char* O, const f32x4 v, int m0, int n) {
#pragma unroll
    for (int r = 0; r < 4; ++r) { const int m = m0 + r; *(LAS unsigned short*)(O + m * 128 + ((((n >> 3) ^ (m & 7)) << 4) | ((n & 7) << 1))) = (unsigned short)f2bf(v[r]); }
}
__device__ __forceinline__ f32x4 ld_row(const LAS unsigned char* O, int m0, int n) {
    const u32x2 w = *(const LAS u32x2*)(O + n * 128 + ((((m0 >> 3) ^ (n & 7)) << 4) | ((m0 & 7) << 1)));
    f32x4 v; v[0] = __builtin_bit_cast(float, w.x << 16); v[1] = __builtin_bit_cast(float, w.x & 0xffff0000u); v[2] = __builtin_bit_cast(float, w.y << 16); v[3] = __builtin_bit_cast(float, w.y & 0xffff0000u); return v;
}
__device__ __forceinline__ void st_fragmajor(unsigned char* G, const f32x4 v, int m0, int R) {
    const int kk = m0 & 31, s = kk >> 4, jj = (kk >> 3) & 1, hh = (kk >> 2) & 1, lanep = (R & 31) + 32 * hh;
    u32x2 w; w.x = cvtpk(v[0], v[1]); w.y = cvtpk(v[2], v[3]);
    *(u32x2*)(G + ((((R >> 5) * 2 + (m0 >> 5)) * 2 + s) * 64 + lanep) * 16 + jj * 8) = w;
}
__device__ __forceinline__ void st_clayout(unsigned char* G, const f32x4 v, int m0, int n) {
    const int mm = m0 & 31, g = mm >> 3, hh = (mm >> 2) & 1, lanep = (n & 31) + 32 * hh;
    u32x2 w; w.x = cvtpk(v[0], v[1]); w.y = cvtpk(v[2], v[3]);
    *(u32x2*)(G + (((m0 >> 5) * 2 + (n >> 5)) * 64 + lanep) * 32 + g * 8) = w;
}
__device__ __forceinline__ void ld8f(float (&o)[8], const float* p) { const f32x4 a = *(const f32x4*)p, b = *(const f32x4*)(p + 4); o[0] = a[0]; o[1] = a[1]; o[2] = a[2]; o[3] = a[3]; o[4] = b[0]; o[5] = b[1]; o[6] = b[2]; o[7] = b[3]; }
__device__ __forceinline__ void ld8bf(float (&o)[8], const bf16* p) { const bf16x8 a = *(const bf16x8*)p;
#pragma unroll
    for (int j = 0; j < 8; ++j) o[j] = bf2f((bf16)a[j]); }
__device__ __forceinline__ v4u pack8(const float (&x)[8]) { v4u o; o.x = cvtpk(x[0], x[1]); o.y = cvtpk(x[2], x[3]); o.z = cvtpk(x[4], x[5]); o.w = cvtpk(x[6], x[7]); return o; }

__device__ __forceinline__ void p2_rwkv_chunk(Frame& F) {
    LAS unsigned char* L = F.lds + RING_OFF;
    LAS float* WPRE = (LAS float*)RSLOT(12); LAS float* APRE = (LAS float*)RSLOT(14);
    LAS float* SEG = (LAS float*)(F.lds + XTRA_OFF); LAS float* LWC = SEG + 512;
    const int tid = F.tid, lane = F.lane, wave = F.wave;
    const int t = tid >> 3, kq = tid & 7;
    const int mt = wave >> 1, ntb = 2 * (wave & 1), q = lane >> 4, l15 = lane & 15;
    const bf16* PB = (const bf16*)(F.ws + WS_PB);
    const bf16* W2T = (const bf16*)(F.ws + WS_LORA); const bf16* A2T = W2T + 512 * 64; const bf16* G2T = A2T + 512 * 64;
    const float* mu = F.in[3];
    float* GG = (float*)(F.ws + WS_G); bf16* VS = (bf16*)(F.ws + WS_VS); float* BON = (float*)(F.ws + WS_BONUS);
    for (int it = F.vcu; it < BATCH * 8 * (T / 64); it += F.G) {
        const int chunk = it & 127, h = (it >> 7) & 7, b = it >> 10;
        const int row0 = b * T + chunk * 64;
        for (int idx = tid; idx < 64 * 32; idx += NWAVES * 64) {
            const int tok = idx >> 5, c8 = idx & 31; const int row = row0 + tok; const int col = C_DW + 8 * c8;
            float p[8], pp[8], m8[8], o[8]; ld8bf(p, PB + (size_t)row * NMAIN + col); ld8f(m8, mu + col);
            if ((row % T) != 0) ld8bf(pp, PB + (size_t)(row - 1) * NMAIN + col); else {
#pragma unroll
                for (int j = 0; j < 8; ++j) pp[j] = 0.f; }
#pragma unroll
            for (int j = 0; j < 8; ++j) { const float ps = p[j] + m8[j] * (pp[j] - p[j]); o[j] = (c8 < 8) ? ftanh_(ps) : (c8 < 16 ? ps : fsigmoid_(ps)); }
            *(LAS v4u*)(RSLOT(8 + (c8 >> 3)) + tok * 128 + (((c8 & 7) ^ (tok & 7)) << 4)) = pack8(o);
        }
        __syncthreads();
        {
            f32x4 accw[2], acca[2], accg[2];
#pragma unroll
            for (int j = 0; j < 2; ++j) { accw[j] = (f32x4){0.f, 0.f, 0.f, 0.f}; acca[j] = accw[j]; accg[j] = accw[j]; }
            const int mr = h * 64 + 16 * mt + l15;
#pragma unroll
            for (int ks = 0; ks < 2; ++ks) { const bf16x8 aw = *(const bf16x8*)(W2T + (size_t)mr * 64 + 32 * ks + 8 * q), aa = *(const bf16x8*)(A2T + (size_t)mr * 64 + 32 * ks + 8 * q);
#pragma unroll
                for (int j = 0; j < 2; ++j) { const bf16x8 b1 = rfrag(RSLOT(8), 16 * (ntb + j), ks, lane), b2 = rfrag(RSLOT(9), 16 * (ntb + j), ks, lane);
                    accw[j] = __builtin_amdgcn_mfma_f32_16x16x32_bf16(aw, b1, accw[j], 0, 0, 0); acca[j] = __builtin_amdgcn_mfma_f32_16x16x32_bf16(aa, b2, acca[j], 0, 0, 0); } }
#pragma unroll
            for (int ks = 0; ks < 4; ++ks) { const bf16x8 ag = *(const bf16x8*)(G2T + (size_t)mr * 128 + 32 * ks + 8 * q);
#pragma unroll
                for (int j = 0; j < 2; ++j) { const bf16x8 b3 = rfrag(RSLOT(10 + (ks >> 1)), 16 * (ntb + j), ks & 1, lane); accg[j] = __builtin_amdgcn_mfma_f32_16x16x32_bf16(ag, b3, accg[j], 0, 0, 0); } }
            const int m0 = 16 * mt + 4 * q;
#pragma unroll
            for (int j = 0; j < 2; ++j) { const int n = 16 * (ntb + j) + l15;
                *(LAS f32x4*)(WPRE + n * 64 + m0) = accw[j]; *(LAS f32x4*)(APRE + n * 64 + m0) = acca[j];
                *(f32x4*)(GG + (size_t)(row0 + n) * 512 + h * 64 + m0) = accg[j]; }
        }
        __syncthreads();
        float r8[8], km8[8], v8[8], a8[8], b8[8], lg8[8];
        {
            const int row = row0 + t, ch = h * 64 + 8 * kq; const bool first = (row % T) == 0;
            const bf16* prow = PB + (size_t)row * NMAIN; const bf16* qrow = PB + (size_t)(first ? row : row - 1) * NMAIN;
            { float c[8], p[8], m[8]; ld8bf(c, prow + C_R + ch); ld8bf(p, qrow + C_R + ch); ld8f(m, mu + C_R + ch);
#pragma unroll
              for (int j = 0; j < 8; ++j) { const float pj = first ? 0.f : p[j]; r8[j] = c[j] + m[j] * (pj - c[j]); } }
            asm volatile("" ::: "memory");
            { float c[8], p[8], m[8]; ld8bf(c, prow + C_V + ch); ld8bf(p, qrow + C_V + ch); ld8f(m, mu + C_V + ch);
#pragma unroll
              for (int j = 0; j < 8; ++j) { const float pj = first ? 0.f : p[j]; v8[j] = c[j] + m[j] * (pj - c[j]); }
              *(v4u*)(VS + (size_t)row * 512 + ch) = pack8(v8); }
            asm volatile("" ::: "memory");
            float kr[8];
            { float c[8], p[8], m[8]; ld8bf(c, prow + C_K + ch); ld8bf(p, qrow + C_K + ch); ld8f(m, mu + C_K + ch);
#pragma unroll
              for (int j = 0; j < 8; ++j) { const float pj = first ? 0.f : p[j]; kr[j] = c[j] + m[j] * (pj - c[j]); } }
            asm volatile("" ::: "memory");
            { float w0v[8]; ld8f(w0v, F.in[4] + ch); const f32x4 x0 = *(const LAS f32x4*)(WPRE + t * 64 + 8 * kq), x1 = *(const LAS f32x4*)(WPRE + t * 64 + 8 * kq + 4);
#pragma unroll
              for (int j = 0; j < 8; ++j) { const float wp = j < 4 ? x0[j & 3] : x1[j & 3]; const float wl = -fsoftplus_(-(w0v[j] + wp)) - 0.5f; lg8[j] = -fexp_(wl); }
              *(LAS f32x4*)(WPRE + t * 64 + 8 * kq) = (f32x4){lg8[0], lg8[1], lg8[2], lg8[3]}; *(LAS f32x4*)(WPRE + t * 64 + 8 * kq + 4) = (f32x4){lg8[4], lg8[5], lg8[6], lg8[7]}; }
            asm volatile("" ::: "memory");
            float as8[8];
            { float a0v[8]; ld8f(a0v, F.in[6] + ch); const f32x4 y0 = *(const LAS f32x4*)(APRE + t * 64 + 8 * kq), y1 = *(const LAS f32x4*)(APRE + t * 64 + 8 * kq + 4);
#pragma unroll
              for (int j = 0; j < 8; ++j) { const float ap = j < 4 ? y0[j & 3] : y1[j & 3]; as8[j] = fsigmoid_(a0v[j] + ap); } }
            asm volatile("" ::: "memory");
            float kk[8], ss = 0.f;
            { float kkp[8]; ld8f(kkp, F.in[9] + ch);
#pragma unroll
              for (int j = 0; j < 8; ++j) { kk[j] = kr[j] * kkp[j]; ss += kk[j] * kk[j]; } }
            ss += __shfl_xor(ss, 1); ss += __shfl_xor(ss, 2); ss += __shfl_xor(ss, 4);
            const float inv = frcp_(fmaxf(__builtin_amdgcn_sqrtf(ss), 1e-12f)); float bon = 0.f;
            { float kap[8], rkp[8]; ld8f(kap, F.in[10] + ch); ld8f(rkp, F.in[11] + ch);
#pragma unroll
              for (int j = 0; j < 8; ++j) { kk[j] *= inv; km8[j] = kr[j] * (1.0f + (as8[j] - 1.0f) * kap[j]); a8[j] = -kk[j]; b8[j] = kk[j] * as8[j]; bon += r8[j] * km8[j] * rkp[j]; } }
            bon += __shfl_xor(bon, 1); bon += __shfl_xor(bon, 2); bon += __shfl_xor(bon, 4);
            if (kq == 0) BON[(size_t)row * 8 + h] = bon;
        }
        __syncthreads();
        {
            const int k = tid & 63, seg = tid >> 6; float c[8], run = 0.f;
#pragma unroll
            for (int i = 0; i < 8; ++i) { run += WPRE[(8 * seg + i) * 64 + k]; c[i] = run; }
            SEG[seg * 64 + k] = run;
            __syncthreads();
            float pre = 0.f;
            for (int s2 = 0; s2 < seg; ++s2) pre += SEG[s2 * 64 + k];
#pragma unroll
            for (int i = 0; i < 8; ++i) WPRE[(8 * seg + i) * 64 + k] = pre + c[i];
            if (seg == 7) LWC[k] = pre + c[7];
        }
        __syncthreads();
        {
            float lw[8], At[8], Bt[8], Kt[8], Rt[8], Bh[8], Kh[8];
            { const f32x4 x0 = *(const LAS f32x4*)(WPRE + t * 64 + 8 * kq), x1 = *(const LAS f32x4*)(WPRE + t * 64 + 8 * kq + 4);
#pragma unroll
              for (int j = 0; j < 4; ++j) { lw[j] = x0[j]; lw[4 + j] = x1[j]; } }
#pragma unroll
            for (int j = 0; j < 8; ++j) { const float lc = LWC[8 * kq + j]; const float eA = fexp_(lw[j] - lg8[j]), eN = fexp_(-lw[j]), eP = fexp_(lw[j]), eC = fexp_(lc - lw[j]);
                At[j] = a8[j] * eA; Bt[j] = b8[j] * eN; Kt[j] = km8[j] * eN; Rt[j] = r8[j] * eP; Bh[j] = b8[j] * eC; Kh[j] = km8[j] * eC; }
            const int o16 = t * 128 + ((kq ^ (t & 7)) << 4);
            *(LAS v4u*)(RSLOT(0) + o16) = pack8(At); *(LAS v4u*)(RSLOT(1) + o16) = pack8(Bt); *(LAS v4u*)(RSLOT(2) + o16) = pack8(Kt); *(LAS v4u*)(RSLOT(3) + o16) = pack8(Rt);
#pragma unroll
            for (int j = 0; j < 8; ++j) { const int kch = 8 * kq + j; const int o2 = kch * 128 + ((((t >> 3) ^ j) << 4) | ((t & 7) << 1));
                *(LAS unsigned short*)(RSLOT(4) + o2) = (unsigned short)f2bf(At[j]); *(LAS unsigned short*)(RSLOT(5) + o2) = (unsigned short)f2bf(v8[j]);
                *(LAS unsigned short*)(RSLOT(6) + o2) = (unsigned short)f2bf(Bh[j]); *(LAS unsigned short*)(RSLOT(7) + o2) = (unsigned short)f2bf(Kh[j]); }
        }
        __syncthreads();
        const int m0 = 16 * mt + 4 * q;
        {
            f32x4 aN[2], aKa[2], aBr[2], aKr[2];
#pragma unroll
            for (int j = 0; j < 2; ++j) { aN[j] = (f32x4){0.f, 0.f, 0.f, 0.f}; aKa[j] = aN[j]; aBr[j] = aN[j]; aKr[j] = aN[j]; }
#pragma unroll
            for (int ks = 0; ks < 2; ++ks) { const bf16x8 xa = rfrag(RSLOT(0), 16 * mt, ks, lane), xb = rfrag(RSLOT(1), 16 * mt, ks, lane), xk = rfrag(RSLOT(2), 16 * mt, ks, lane);
#pragma unroll
                for (int j = 0; j < 2; ++j) { const bf16x8 yb = rfrag(RSLOT(1), 16 * (ntb + j), ks, lane), yk = rfrag(RSLOT(2), 16 * (ntb + j), ks, lane), yr = rfrag(RSLOT(3), 16 * (ntb + j), ks, lane);
                    aN[j] = __builtin_amdgcn_mfma_f32_16x16x32_bf16(xa, yb, aN[j], 0, 0, 0); aKa[j] = __builtin_amdgcn_mfma_f32_16x16x32_bf16(xa, yk, aKa[j], 0, 0, 0);
                    aBr[j] = __builtin_amdgcn_mfma_f32_16x16x32_bf16(xb, yr, aBr[j], 0, 0, 0); aKr[j] = __builtin_amdgcn_mfma_f32_16x16x32_bf16(xk, yr, aKr[j], 0, 0, 0); } }
#pragma unroll
            for (int j = 0; j < 2; ++j) { const int n = 16 * (ntb + j) + l15; f32x4 vN, vT, vKa, vBr, vKr;
#pragma unroll
                for (int r = 0; r < 4; ++r) { const int m = m0 + r; vN[r] = (n < m) ? aN[j][r] : 0.f; vT[r] = vN[r] + ((n == m) ? 1.f : 0.f); vKa[r] = (n < m) ? aKa[j][r] : 0.f;
                    vBr[r] = (m <= n) ? aBr[j][r] : 0.f; vKr[r] = (m <= n) ? aKr[j][r] : 0.f; }
                st_row(RSLOT(8), vN, m0, n); st_tr(RSLOT(9), vN, m0, n); st_row(RSLOT(10), vT, m0, n); st_row(RSLOT(11), vKa, m0, n); st_row(RSLOT(12), vBr, m0, n); st_row(RSLOT(13), vKr, m0, n); }
        }
        __syncthreads();
#define SQUARE(XS, YS, OROW, OTR) { f32x4 ac[2] = {(f32x4){0.f, 0.f, 0.f, 0.f}, (f32x4){0.f, 0.f, 0.f, 0.f}}; mm64(ac, RSLOT(XS), RSLOT(YS), wave, lane); \
            _Pragma("unroll") for (int j = 0; j < 2; ++j) { const int n = 16 * (ntb + j) + l15; if (OROW >= 0) st_row(RSLOT(OROW < 0 ? 0 : OROW), ac[j], m0, n); st_tr(RSLOT(OTR), ac[j], m0, n); } }
#define TUPD(XS, YS, OUT, TRANSP) { f32x4 ac[2]; _Pragma("unroll") for (int j = 0; j < 2; ++j) ac[j] = ld_row(RSLOT(YS), m0, 16 * (ntb + j) + l15); mm64(ac, RSLOT(XS), RSLOT(YS), wave, lane); \
            _Pragma("unroll") for (int j = 0; j < 2; ++j) { const int n = 16 * (ntb + j) + l15; if (TRANSP) st_tr(RSLOT(OUT), ac[j], m0, n); else st_row(RSLOT(OUT), ac[j], m0, n); } }
        SQUARE(9, 8, 0, 1);
        __syncthreads();
        TUPD(1, 10, 14, false); SQUARE(1, 0, 8, 9);
        __syncthreads();
        TUPD(9, 14, 10, false); SQUARE(9, 8, 0, 1);
        __syncthreads();
        TUPD(1, 10, 14, false); SQUARE(1, 0, 8, 9);
        __syncthreads();
        TUPD(9, 14, 10, false); SQUARE(9, 8, -1, 1);
        __syncthreads();
        TUPD(1, 10, 14, true);
        __syncthreads();
        { f32x4 ac[2] = {(f32x4){0.f, 0.f, 0.f, 0.f}, (f32x4){0.f, 0.f, 0.f, 0.f}}, ad[2] = {(f32x4){0.f, 0.f, 0.f, 0.f}, (f32x4){0.f, 0.f, 0.f, 0.f}};
          mm64(ac, RSLOT(14), RSLOT(4), wave, lane); mm64(ad, RSLOT(11), RSLOT(14), wave, lane);
#pragma unroll
          for (int j = 0; j < 2; ++j) { const int n = 16 * (ntb + j) + l15; st_row(RSLOT(0), ac[j], m0, n); st_row(RSLOT(2), ad[j], m0, n); } }
        __syncthreads();
        { f32x4 ac[2] = {(f32x4){0.f, 0.f, 0.f, 0.f}, (f32x4){0.f, 0.f, 0.f, 0.f}};
          mm64(ac, RSLOT(2), RSLOT(5), wave, lane);
#pragma unroll
          for (int j = 0; j < 2; ++j) st_row(RSLOT(8), ac[j], m0, 16 * (ntb + j) + l15); }
        __syncthreads();
        {
            unsigned char* rec = (unsigned char*)F.out + (size_t)it * 32768;
            f32x4 aP[2], aQ[2], aG[2], aH[2];
#pragma unroll
            for (int j = 0; j < 2; ++j) { aP[j] = (f32x4){0.f, 0.f, 0.f, 0.f}; aQ[j] = aP[j]; aH[j] = aP[j]; aG[j] = ld_row(RSLOT(3), m0, 16 * (ntb + j) + l15); }
            mm64(aP, RSLOT(0), RSLOT(6), wave, lane);
            mm64(aQ, RSLOT(6), RSLOT(8), wave, lane); mm64(aQ, RSLOT(7), RSLOT(5), wave, lane);
            mm64(aG, RSLOT(0), RSLOT(12), wave, lane);
            mm64(aH, RSLOT(8), RSLOT(12), wave, lane); mm64(aH, RSLOT(5), RSLOT(13), wave, lane);
#pragma unroll
            for (int j = 0; j < 2; ++j) { const int n = 16 * (ntb + j) + l15;
#pragma unroll
                for (int r = 0; r < 4; ++r) if (m0 + r == n) aP[j][r] += fexp_(LWC[n]);
                st_fragmajor(rec, aP[j], m0, n); st_clayout(rec + 8192, aQ[j], m0, n); st_fragmajor(rec + 16384, aG[j], m0, n); st_clayout(rec + 24576, aH[j], m0, n); }
        }
        __syncthreads();
    }
}
struct ScanSlot { bf16x8 pa[2][4]; v4u qc[2][2]; };
__device__ __forceinline__ void scan_load(ScanSlot& S, const unsigned char* rec, int ntile, int lane) {
#pragma unroll
    for (int mtile = 0; mtile < 2; ++mtile) {
#pragma unroll
        for (int ks = 0; ks < 4; ++ks) S.pa[mtile][ks] = *(const bf16x8*)(rec + ((mtile * 4 + ks) * 64 + lane) * 16);
        S.qc[mtile][0] = *(const v4u*)(rec + 8192 + ((mtile * 2 + ntile) * 64 + lane) * 32); S.qc[mtile][1] = *(const v4u*)(rec + 8192 + ((mtile * 2 + ntile) * 64 + lane) * 32 + 16); }
}
__device__ __forceinline__ void scan_pack_stash(const f32x16 (&z)[2], bf16x8 (&zf)[4], unsigned char* st, int lane) {
#pragma unroll
    for (int kt = 0; kt < 2; ++kt)
#pragma unroll
        for (int s = 0; s < 2; ++s) { v4u w; w.x = cvtpk(z[kt][8 * s + 0], z[kt][8 * s + 1]); w.y = cvtpk(z[kt][8 * s + 2], z[kt][8 * s + 3]); w.z = cvtpk(z[kt][8 * s + 4], z[kt][8 * s + 5]); w.w = cvtpk(z[kt][8 * s + 6], z[kt][8 * s + 7]);
            zf[kt * 2 + s] = __builtin_bit_cast(bf16x8, w); *(v4u*)(st + ((kt * 2 + s) * 64 + lane) * 16) = w; }
}
__device__ __forceinline__ void scan_step(f32x16 (&z)[2], const ScanSlot& S, const bf16x8 (&zf)[4]) {
#pragma unroll
    for (int mtile = 0; mtile < 2; ++mtile) {
        f32x16 acc;
#pragma unroll
        for (int i = 0; i < 4; ++i) { const unsigned w0 = S.qc[mtile][0][i], w1 = S.qc[mtile][1][i];
            acc[2 * i] = __builtin_bit_cast(float, w0 << 16); acc[2 * i + 1] = __builtin_bit_cast(float, w0 & 0xffff0000u);
            acc[8 + 2 * i] = __builtin_bit_cast(float, w1 << 16); acc[8 + 2 * i + 1] = __builtin_bit_cast(float, w1 & 0xffff0000u); }
#pragma unroll
        for (int ks = 0; ks < 4; ++ks) acc = __builtin_amdgcn_mfma_f32_32x32x16_bf16(S.pa[mtile][ks], zf[ks], acc, 0, 0, 0);
        z[mtile] = acc;
    }
}
__device__ __forceinline__ void p3_rwkv_scan_mfma(Frame& F, int bh, int ntile) {
    const int lane = F.lane; constexpr int NC = T / 64;
    const unsigned char* recs = (const unsigned char*)F.out + (size_t)bh * NC * 32768;
    unsigned char* stash = F.ws + WS_HB + (size_t)bh * NC * 8192 + ntile * 4096;
    f32x16 z[2];
#pragma unroll
    for (int i = 0; i < 16; ++i) { z[0][i] = 0.f; z[1][i] = 0.f; }
    ScanSlot S0, S1, S2; bf16x8 zf[4];
    scan_load(S0, recs, ntile, lane); scan_load(S1, recs + 32768, ntile, lane); scan_load(S2, recs + 2 * 32768, ntile, lane);
    for (int c = 0; c < NC - 1; c += 3) {
        scan_pack_stash(z, zf, stash + (size_t)c * 8192, lane); scan_step(z, S0, zf);
        if (c + 3 < NC - 1) scan_load(S0, recs + (size_t)(c + 3) * 32768, ntile, lane);
        if (c + 1 < NC - 1) { scan_pack_stash(z, zf, stash + (size_t)(c + 1) * 8192, lane); scan_step(z, S1, zf);
            if (c + 4 < NC - 1) scan_load(S1, recs + (size_t)(c + 4) * 32768, ntile, lane); }
        if (c + 2 < NC - 1) { scan_pack_stash(z, zf, stash + (size_t)(c + 2) * 8192, lane); scan_step(z, S2, zf);
            if (c + 5 < NC - 1) scan_load(S2, recs + (size_t)(c + 5) * 32768, ntile, lane); }
    }
    scan_pack_stash(z, zf, stash + (size_t)(NC - 1) * 8192, lane);
}
__device__ __forceinline__ void p3b_rwkv_out_mfma(Frame& F) {
    const int gw = F.vcu * NWAVES + F.wave, NGW = F.G * NWAVES, lane = F.lane, hh = lane >> 5, tl = lane & 31;
    bf16* Y = (bf16*)(F.ws + WS_XB); const float* GG = (const float*)(F.ws + WS_G); const bf16* VS = (const bf16*)(F.ws + WS_VS); const float* BON = (const float*)(F.ws + WS_BONUS);
    const float* lnw = F.in[12]; const float* lnb = F.in[13];
    for (int it = gw; it < BATCH * 8 * (T / 64); it += NGW) {
        const int chunk = it & 127, h = (it >> 7) & 7, b = it >> 10; const int row0 = b * T + chunk * 64;
        const unsigned char* rec = (const unsigned char*)F.out + (size_t)it * 32768;
        const unsigned char* stash = F.ws + WS_HB + (size_t)it * 8192;
        bf16x8 zf[2][4], gf[2][4];
#pragma unroll
        for (int a = 0; a < 2; ++a)
#pragma unroll
            for (int ks = 0; ks < 4; ++ks) { zf[a][ks] = *(const bf16x8*)(stash + a * 4096 + (ks * 64 + lane) * 16); gf[a][ks] = *(const bf16x8*)(rec + 16384 + ((a * 4 + ks) * 64 + lane) * 16); }
        f32x16 y[2][2];
#pragma unroll
        for (int vt = 0; vt < 2; ++vt)
#pragma unroll
            for (int tt = 0; tt < 2; ++tt) { const v4u c0 = *(const v4u*)(rec + 24576 + ((vt * 2 + tt) * 64 + lane) * 32), c1 = *(const v4u*)(rec + 24576 + ((vt * 2 + tt) * 64 + lane) * 32 + 16);
                f32x16 acc;
#pragma unroll
                for (int i = 0; i < 4; ++i) { acc[2 * i] = __builtin_bit_cast(float, c0[i] << 16); acc[2 * i + 1] = __builtin_bit_cast(float, c0[i] & 0xffff0000u);
                    acc[8 + 2 * i] = __builtin_bit_cast(float, c1[i] << 16); acc[8 + 2 * i + 1] = __builtin_bit_cast(float, c1[i] & 0xffff0000u); }
#pragma unroll
                for (int ks = 0; ks < 4; ++ks) acc = __builtin_amdgcn_mfma_f32_32x32x16_bf16(zf[vt][ks], gf[tt][ks], acc, 0, 0, 0);
                y[vt][tt] = acc; }
#pragma unroll
        for (int tt = 0; tt < 2; ++tt) {
            float s = 0.f;
#pragma unroll
            for (int vt = 0; vt < 2; ++vt)
#pragma unroll
                for (int i = 0; i < 16; ++i) s += y[vt][tt][i];
            s += __shfl_xor(s, 32); const float mean = s * (1.0f / 64.0f); float qv = 0.f;
#pragma unroll
            for (int vt = 0; vt < 2; ++vt)
#pragma unroll
                for (int i = 0; i < 16; ++i) { const float d = y[vt][tt][i] - mean; qv += d * d; }
            qv += __shfl_xor(qv, 32); const float rstd = 1.0f / sqrtf(qv * (1.0f / 64.0f) + GN_EPS);
            const int row = row0 + 32 * tt + tl; const float bon = BON[(size_t)row * 8 + h];
#pragma unroll
            for (int vt = 0; vt < 2; ++vt)
#pragma unroll
                for (int g = 0; g < 4; ++g) { const int v0 = 32 * vt + 8 * g + 4 * hh, ch = h * 64 + v0;
                    const f32x4 gw4 = *(const f32x4*)(GG + (size_t)row * 512 + ch), lw4 = *(const f32x4*)(lnw + ch), lb4 = *(const f32x4*)(lnb + ch);
                    const u32x2 vsw = *(const u32x2*)(VS + (size_t)row * 512 + ch);
                    float vs4[4] = {__builtin_bit_cast(float, vsw.x << 16), __builtin_bit_cast(float, vsw.x & 0xffff0000u), __builtin_bit_cast(float, vsw.y << 16), __builtin_bit_cast(float, vsw.y & 0xffff0000u)};
                    float o[4];
#pragma unroll
                    for (int r = 0; r < 4; ++r) o[r] = ((y[vt][tt][4 * g + r] - mean) * rstd * lw4[r] + lb4[r] + bon * vs4[r]) * gw4[r];
                    u32x2 w; w.x = cvtpk(o[0], o[1]); w.y = cvtpk(o[2], o[3]);
                    *(u32x2*)(Y + (size_t)row * D + ch) = w; }
        }
    }
}

constexpr int NSA_KB = 0, NSA_VB = 16384, NSA_IMP = 32768, NSA_OUT = 65536, NSA_SELM = RING_BYTES + 1024, NSA_LIST = RING_BYTES + 2048, NSA_MISC = RING_BYTES + 3072;
static_assert(NSA_OUT + 8 * 8192 <= RING_BYTES && NSA_MISC + 1024 <= LDS_BYTES, "nsa lds map");
constexpr float LOG2E = 1.4426950408889634f;
constexpr float NEGB = -1e30f;
__device__ __forceinline__ int perm16(int c) { return (c & ~15) | (((c >> 2) & 1) << 3) | (((c >> 3) & 1) << 2) | (c & 3); }

__device__ __forceinline__ void p2_vtrans(Frame& F) {
    LAS unsigned short* TL = (LAS unsigned short*)(F.lds + RING_OFF);
    const bf16* PB = (const bf16*)(F.ws + WS_PB); bf16* VT = (bf16*)(F.ws + WS_VT);
    const int tid = F.tid;
    for (int it = F.vcu; it < 2 * 4 * (T / 64); it += F.G) {
        const int n = it & 127, bhk = (it >> 7) & 3, kind = it >> 9; const int b = bhk >> 1, hk = bhk & 1;
        const int col = (kind ? C_VW : C_VS) + hk * 64;
        { const int tok = tid >> 3, ch = tid & 7; const bf16x8 v = *(const bf16x8*)(PB + (size_t)(b * T + 64 * n + tok) * NMAIN + col + 8 * ch);
#pragma unroll
          for (int j = 0; j < 8; ++j) TL[tok * 66 + 8 * ch + j] = (unsigned short)v[j]; }
        __syncthreads();
        { const int d = tid >> 3, ch = tid & 7; bf16x8 o;
#pragma unroll
          for (int j = 0; j < 8; ++j) { const int key = perm16(8 * ch + j); o[j] = (short)TL[key * 66 + d]; }
          *(bf16x8*)(VT + ((size_t)(kind * 4 + bhk) * 64 + d) * T + 64 * n + 8 * ch) = o; }
        __syncthreads();
    }
}
struct NsaCtx { const bf16* kc; const bf16* vct; const bf16* ks; const bf16* vst; const bf16* kw; const bf16* vwt; };
__device__ __forceinline__ void nsa_load(const NsaCtx& C, int desc, int tid, v4u& kr, v4u& vr) {
    const int kind = desc >> 8, n = desc & 255, row = tid >> 3, ch = tid & 7;
    const bf16* kp; const bf16* vp;
    if (kind == 0) { kp = C.kc + (size_t)(64 * n + row) * 64 + 8 * ch; vp = C.vct + (size_t)row * NCMPP + 64 * n + 8 * ch; }
    else if (kind == 1) { kp = C.ks + (size_t)(64 * n + row) * NMAIN + 8 * ch; vp = C.vst + (size_t)row * T + 64 * n + 8 * ch; }
    else { kp = C.kw + (size_t)(64 * n + row) * NMAIN + 8 * ch; vp = C.vwt + (size_t)row * T + 64 * n + 8 * ch; }
    kr = *(const v4u*)kp; vr = *(const v4u*)vp;
}
__device__ __forceinline__ void nsa_store(LAS unsigned char* L, int buf, int tid, const v4u kr, const v4u vr) {
    const int row = tid >> 3, ch = tid & 7; const int o = row * 128 + ((ch ^ (row & 7)) << 4);
    *(LAS v4u*)(L + NSA_KB + buf * 8192 + o) = kr; *(LAS v4u*)(L + NSA_VB + buf * 8192 + o) = vr;
}
template <int MODE>
__device__ __forceinline__ void nsa_block(const LAS unsigned char* KB, const LAS unsigned char* VB, const bf16x8 (&qf)[4], f32x16 (&o)[2], float& m, float& l,
                                          float ck, float cb, int lo, int hi, bool masked, float invl, LAS float* impw, int nbase, int lane) {
    const int r32 = lane & 31, hh = lane >> 5;
    f32x16 s0, s1;
    { const float cbh = cb + ck * (float)(4 * hh);
#pragma unroll
      for (int i = 0; i < 16; ++i) { const float c = (float)((i & 3) + 8 * (i >> 2)); s0[i] = __builtin_fmaf(ck, c, cbh); s1[i] = __builtin_fmaf(ck, c + 32.f, cbh); } }
    { const LAS unsigned char* kp = KB + r32 * 128; const int sw = r32 & 7;
#pragma unroll
      for (int ks = 0; ks < 4; ++ks) { const bf16x8 a0 = *(const LAS bf16x8*)(kp + (((2 * ks + hh) ^ sw) << 4)), a1 = *(const LAS bf16x8*)(kp + 4096 + (((2 * ks + hh) ^ sw) << 4));
          s0 = __builtin_amdgcn_mfma_f32_32x32x16_bf16(a0, qf[ks], s0, 0, 0, 0); s1 = __builtin_amdgcn_mfma_f32_32x32x16_bf16(a1, qf[ks], s1, 0, 0, 0); } }
    if (masked) { const int lo2 = lo - 4 * hh, hi2 = hi - 4 * hh;
#pragma unroll
        for (int i = 0; i < 16; ++i) { const int c = (i & 3) + 8 * (i >> 2); if (c < lo2 || c > hi2) s0[i] = NEGB; if (c + 32 < lo2 || c + 32 > hi2) s1[i] = NEGB; } }
    if (MODE != 2) {
        float bm = __builtin_fmaxf(__builtin_fmaxf(s0[0], s0[1]), s0[2]), bm2 = __builtin_fmaxf(__builtin_fmaxf(s1[0], s1[1]), s1[2]);
#pragma unroll
        for (int i = 3; i < 15; i += 2) { bm = __builtin_fmaxf(__builtin_fmaxf(bm, s0[i]), s0[i + 1]); bm2 = __builtin_fmaxf(__builtin_fmaxf(bm2, s1[i]), s1[i + 1]); }
        bm = __builtin_fmaxf(__builtin_fmaxf(bm, bm2), __builtin_fmaxf(s0[15], s1[15]));
        bm = fmaxf(bm, __shfl_xor(bm, 32));
        const float mn = fmaxf(m, bm);
        if (__any(mn > m)) { const float alpha = __builtin_amdgcn_exp2f(m - mn); l *= alpha;
            if (MODE == 0) {
#pragma unroll
                for (int i = 0; i < 16; ++i) { o[0][i] *= alpha; o[1][i] *= alpha; } } }
        m = mn;
    }
    float ls = 0.f;
    s0 = s0 - m; s1 = s1 - m;
#pragma unroll
    for (int i = 0; i < 16; ++i) { s0[i] = __builtin_amdgcn_exp2f(s0[i]); s1[i] = __builtin_amdgcn_exp2f(s1[i]); }
    { f32x16 sm = s0 + s1;
#pragma unroll
      for (int i = 0; i < 16; ++i) ls += sm[i]; }
    if (MODE != 2) l += ls;
    if (MODE == 1) return;
    if (MODE == 2) {
#pragma unroll
        for (int i = 0; i < 16; ++i) { s0[i] *= invl; s1[i] *= invl; }
        const int tok = r32 >> 2;
#pragma unroll
        for (int kt = 0; kt < 2; ++kt)
#pragma unroll
            for (int gi = 0; gi < 4; ++gi) { const f32x16& s = kt ? s1 : s0;
                float a = 2.f * (s[4 * gi] + s[4 * gi + 1] + s[4 * gi + 2]) + s[4 * gi + 3], bq = s[4 * gi + 3];
                a += __shfl_xor(a, 1); a += __shfl_xor(a, 2); bq += __shfl_xor(bq, 1); bq += __shfl_xor(bq, 2);
                const int n = nbase + 8 * kt + 2 * gi + hh;
                if ((lane & 3) == 0) { impw[tok * 128 + n] += a; }
                asm volatile("" ::: "memory");
                if ((lane & 3) == 0 && n + 1 < 128) { impw[tok * 128 + n + 1] += bq; }
                asm volatile("" ::: "memory"); }
    }
    bf16x8 pf[4];
#pragma unroll
    for (int kt = 0; kt < 2; ++kt)
#pragma unroll
        for (int s = 0; s < 2; ++s) { const f32x16& sv = kt ? s1 : s0; v4u w; w.x = cvtpk(sv[8 * s + 0], sv[8 * s + 1]); w.y = cvtpk(sv[8 * s + 2], sv[8 * s + 3]); w.z = cvtpk(sv[8 * s + 4], sv[8 * s + 5]); w.w = cvtpk(sv[8 * s + 6], sv[8 * s + 7]);
            pf[kt * 2 + s] = __builtin_bit_cast(bf16x8, w); }
    { const LAS unsigned char* vp = VB + r32 * 128; const int sw = r32 & 7;
#pragma unroll
      for (int sp = 0; sp < 4; ++sp) { const bf16x8 a0 = *(const LAS bf16x8*)(vp + (((2 * sp + hh) ^ sw) << 4)), a1 = *(const LAS bf16x8*)(vp + 4096 + (((2 * sp + hh) ^ sw) << 4));
          o[0] = __builtin_amdgcn_mfma_f32_32x32x16_bf16(a0, pf[sp], o[0], 0, 0, 0); o[1] = __builtin_amdgcn_mfma_f32_32x32x16_bf16(a1, pf[sp], o[1], 0, 0, 0); } }
}
#ifdef PROBE_NSA
#define NP_T0() unsigned long long np_t = __builtin_amdgcn_s_memrealtime()
#define NP_ACC(i) do { if (blockIdx.x == 5 && F.tid == 0) { const unsigned long long np_n = __builtin_amdgcn_s_memrealtime(); ((volatile LAS unsigned long long*)(F.lds + RING_BYTES + 8192))[16 + (i)] += np_n - np_t; np_t = np_n; } } while (0)
#define NP_SYNC() do { unsigned long long np_b = __builtin_amdgcn_s_memrealtime(); __syncthreads(); if (blockIdx.x == 5 && F.tid == 0) ((volatile LAS unsigned long long*)(F.lds + RING_BYTES + 8192))[16 + 3] += __builtin_amdgcn_s_memrealtime() - np_b; } while (0)
#else
#define NP_T0() do {} while (0)
#define NP_ACC(i) do {} while (0)
#define NP_SYNC() __syncthreads()
#endif
__device__ __forceinline__ void nsa_item(Frame& F, int b, int hk, int cur) {
    LAS unsigned char* L = F.lds + RING_OFF;
    const int tid = F.tid, lane = F.lane, wave = F.wave, r32 = lane & 31, hh = lane >> 5, tok = r32 >> 2, g = r32 & 3;
    const int t0 = 64 * cur, t = t0 + 8 * wave + tok, head = hk * 4 + g, bhk = b * 2 + hk;
    const size_t row = (size_t)b * T + t;
    const bf16* PB = (const bf16*)(F.ws + WS_PB);
    NsaCtx C;
    C.kc = (const bf16*)(F.ws + WS_CMP) + (size_t)bhk * NCMPP * 64; C.vct = (const bf16*)(F.ws + WS_CMP + 262144) + (size_t)bhk * 64 * NCMPP;
    C.ks = PB + (size_t)b * T * NMAIN + C_KS + hk * 64; C.kw = PB + (size_t)b * T * NMAIN + C_KW + hk * 64;
    C.vst = (const bf16*)(F.ws + WS_VT) + (size_t)(0 * 4 + bhk) * 64 * T; C.vwt = (const bf16*)(F.ws + WS_VT) + (size_t)(1 * 4 + bhk) * 64 * T;
    LAS float* impw = (LAS float*)(L + NSA_IMP) + wave * 1024;
    LAS unsigned* SELM = (LAS unsigned*)(L + NSA_SELM); LAS int* LIST = (LAS int*)(L + NSA_LIST); LAS int* MISC = (LAS int*)(L + NSA_MISC);
    const float slope2 = exp2f(-(float)(head + 1)) * LOG2E;
    bf16x8 qf[4];
#pragma unroll
    for (int ks = 0; ks < 4; ++ks) { float q8[8]; ld8bf(q8, PB + row * NMAIN + C_Q + head * 64 + 16 * ks + 8 * hh);
#pragma unroll
        for (int j = 0; j < 8; ++j) q8[j] *= 0.125f * LOG2E;
        qf[ks] = __builtin_bit_cast(bf16x8, pack8(q8)); }
#pragma unroll
    for (int i = 0; i < 16; ++i) impw[i * 64 + lane] = 0.f;
    const float* gates = (const float*)(F.ws + WS_GATES) + row * 24 + head * 3;
    const float gt0 = gates[0], gt1 = gates[1], gt2 = gates[2];
    LAS float* outp = (LAS float*)(L + NSA_OUT) + wave * 2048 + lane;
    f32x16 o[2];
#pragma unroll
    for (int i = 0; i < 16; ++i) { o[0][i] = 0.f; o[1][i] = 0.f; }
    float m = NEGB, l = 0.f, invl = 0.f;
    v4u kr, vr;
    const int nbc = (4 * cur + 3 + 63) >> 6; const int nA = 2 * nbc;
    const int tmin = t0 + 8 * wave;
    NP_T0();
    nsa_load(C, 0, tid, kr, vr); nsa_store(L, 0, tid, kr, vr);
    __syncthreads();
    for (int i = 0; i < nA; ++i) {
        const int n = (i < nbc) ? i : i - nbc;
        if (i + 1 < nA) nsa_load(C, (i + 1 < nbc) ? i + 1 : i + 1 - nbc, tid, kr, vr);
        if (i == nbc) { const float lt = l + __shfl_xor(l, 32); invl = (t >= 31) ? 1.0f / lt : 0.f; }
        if (1024 * n + 31 <= tmin + 7) {
            const float ck = 16.f * slope2, cb = slope2 * (float)(1024 * n + 31 - t);
            const int hi = (t >= 31) ? ((t - 31) >> 4) - 64 * n : -1;
            const bool masked = (16 * (64 * n + 63) + 31 > tmin);
            const LAS unsigned char* KB = L + NSA_KB + (i & 1) * 8192; const LAS unsigned char* VB = L + NSA_VB + (i & 1) * 8192;
            if (i < nbc) nsa_block<1>(KB, VB, qf, o, m, l, ck, cb, 0, hi, masked, 0.f, impw, 0, lane);
            else nsa_block<2>(KB, VB, qf, o, m, l, ck, cb, 0, hi, masked, invl, impw, 16 * n, lane);
        }
        if (i + 1 < nA) nsa_store(L, (i + 1) & 1, tid, kr, vr);
        NP_SYNC();
    }
    NP_ACC(0);
#pragma unroll
    for (int i = 0; i < 16; ++i) { outp[64 * i] = gt0 * o[0][i]; outp[64 * (16 + i)] = gt0 * o[1][i]; o[0][i] = 0.f; o[1][i] = 0.f; }
    asm volatile("s_waitcnt lgkmcnt(0)" ::: "memory");
    {
        unsigned long long mlo[8], mhi[8];
        if (cur < 16) {
#pragma unroll
            for (int tk = 0; tk < 8; ++tk) { mlo[tk] = (1ull << (cur + 1)) - 1ull; mhi[tk] = 0ull; }
        } else {
            unsigned k0[8], k1[8], V[8];
#pragma unroll
            for (int tk = 0; tk < 8; ++tk) { const float i0 = impw[tk * 128 + lane], i1 = impw[tk * 128 + 64 + lane];
                k0[tk] = (lane >= 1 && lane <= cur - 2) ? __float_as_uint(i0) + 1u : 0u; k1[tk] = (lane + 64 <= cur - 2) ? __float_as_uint(i1) + 1u : 0u; V[tk] = 0u; }
            for (int bit = 31; bit >= 0; --bit) {
#pragma unroll
                for (int tk = 0; tk < 8; ++tk) { const unsigned tr = V[tk] | (1u << bit);
                    const int cnt = __builtin_popcountll(__ballot(k0[tk] >= tr)) + __builtin_popcountll(__ballot(k1[tk] >= tr));
                    if (cnt >= 13) V[tk] = tr; }
            }
            const unsigned long long f_lo = 1ull | ((cur < 64) ? (1ull << cur) : 0ull) | ((cur - 1 < 64) ? (1ull << (cur - 1)) : 0ull);
            const unsigned long long f_hi = ((cur >= 64) ? (1ull << (cur - 64)) : 0ull) | ((cur - 1 >= 64) ? (1ull << (cur - 65)) : 0ull);
#pragma unroll
            for (int tk = 0; tk < 8; ++tk) {
                const unsigned long long g0 = __ballot(k0[tk] > V[tk]), g1 = __ballot(k1[tk] > V[tk]), e0 = __ballot(k0[tk] == V[tk]), e1 = __ballot(k1[tk] == V[tk]);
                int r = 13 - __builtin_popcountll(g0) - __builtin_popcountll(g1);
                unsigned long long t0 = 0ull, t1 = 0ull, x = e0;
                for (; r > 0 && x; --r) { const unsigned long long bq = x & (0ull - x); t0 |= bq; x ^= bq; }
                x = e1;
                for (; r > 0 && x; --r) { const unsigned long long bq = x & (0ull - x); t1 |= bq; x ^= bq; }
                mlo[tk] = g0 | t0 | f_lo; mhi[tk] = g1 | t1 | f_hi;
            }
        }
        if (lane == 0) {
#pragma unroll
            for (int tk = 0; tk < 8; ++tk) { LAS unsigned* p = SELM + (8 * wave + tk) * 4; p[0] = (unsigned)mlo[tk]; p[1] = (unsigned)(mlo[tk] >> 32); p[2] = (unsigned)mhi[tk]; p[3] = (unsigned)(mhi[tk] >> 32); }
        }
    }
    __syncthreads();
    if (wave == 0) {
        unsigned u0 = SELM[lane * 4 + 0], u1 = SELM[lane * 4 + 1], u2 = SELM[lane * 4 + 2], u3 = SELM[lane * 4 + 3];
#pragma unroll
        for (int ofs = 1; ofs < 64; ofs <<= 1) { u0 |= __shfl_xor(u0, ofs); u1 |= __shfl_xor(u1, ofs); u2 |= __shfl_xor(u2, ofs); u3 |= __shfl_xor(u3, ofs); }
        if (lane == 0) {
            int cnt = 0;
            for (int w4 = 0; w4 < 4; ++w4) { unsigned u = (w4 == 0) ? u0 : (w4 == 1) ? u1 : (w4 == 2) ? u2 : u3; while (u) { const int bit = __builtin_ctz(u); u &= u - 1; LIST[cnt++] = (1 << 8) | (32 * w4 + bit); } }
            MISC[0] = cnt;
            for (int n = (cur >= 8 ? cur - 8 : 0); n <= cur; ++n) LIST[cnt++] = (2 << 8) | n;
            MISC[1] = cnt;
        }
    }
    __syncthreads();
    const int nS = MISC[0], nB = MISC[1];
    NP_ACC(1);
    m = NEGB; l = 0.f;
    nsa_load(C, LIST[0], tid, kr, vr); nsa_store(L, 0, tid, kr, vr);
    __syncthreads();
    for (int i = 0; i < nB; ++i) {
        const int desc = LIST[i]; const int kind = desc >> 8, n = desc & 255;
        if (i + 1 < nB) nsa_load(C, LIST[i + 1], tid, kr, vr);
        if (i == nS) {
            const float lt = l + __shfl_xor(l, 32); const float f = gt1 / lt;
#pragma unroll
            for (int k = 0; k < 16; ++k) { outp[64 * k] += f * o[0][k]; outp[64 * (16 + k)] += f * o[1][k]; o[0][k] = 0.f; o[1][k] = 0.f; }
            m = NEGB; l = 0.f;
        }
        const LAS unsigned char* KB = L + NSA_KB + (i & 1) * 8192; const LAS unsigned char* VB = L + NSA_VB + (i & 1) * 8192;
        const float cb = slope2 * (float)(64 * n - t);
        if (kind == 1) {
            const unsigned bit = (SELM[(8 * wave + tok) * 4 + (n >> 5)] >> (n & 31)) & 1u;
            if (__any((int)bit)) {
                const bool masked = (n == cur) || !__all((int)bit);
                const int hi = bit ? (t - 64 * n) : -1;
                nsa_block<0>(KB, VB, qf, o, m, l, slope2, cb, 0, hi, masked, 0.f, impw, 0, lane);
            }
        } else {
            const bool masked = (n == cur) || (n == cur - 8);
            nsa_block<0>(KB, VB, qf, o, m, l, slope2, cb, t - 511 - 64 * n, t - 64 * n, masked, 0.f, impw, 0, lane);
        }
        if (i + 1 < nB) nsa_store(L, (i + 1) & 1, tid, kr, vr);
        NP_SYNC();
    }
    NP_ACC(2);
    { const float lt = l + __shfl_xor(l, 32); const float f = gt2 / lt;
#pragma unroll
      for (int k = 0; k < 16; ++k) { o[0][k] = outp[64 * k] + f * o[0][k]; o[1][k] = outp[64 * (16 + k)] + f * o[1][k]; } }
    bf16* Y = (bf16*)(F.ws + WS_XB) + row * D + 512 + head * 64;
#pragma unroll
    for (int dt = 0; dt < 2; ++dt)
#pragma unroll
        for (int gi = 0; gi < 4; ++gi) { u32x2 w; w.x = cvtpk(o[dt][4 * gi], o[dt][4 * gi + 1]); w.y = cvtpk(o[dt][4 * gi + 2], o[dt][4 * gi + 3]);
            *(u32x2*)(Y + 32 * dt + 8 * gi + 4 * hh) = w; }
}
__device__ __forceinline__ void p3_nsa_mfma(Frame& F) {
    LAS int* QS = (LAS int*)(F.lds + RING_OFF + NSA_MISC + 64);
    for (;;) {
        if (F.tid == 0) QS[0] = (int)__hip_atomic_fetch_add((unsigned*)(F.ctl + CW_QUEUE), 1u, __ATOMIC_RELAXED, __HIP_MEMORY_SCOPE_AGENT);
        __syncthreads();
        const int q = QS[0];
        __syncthreads();
        if (q >= 4 * (T / 64)) break;
        const int cur = 127 - (q >> 2), bhk = q & 3;
        nsa_item(F, bhk >> 1, bhk & 1, cur);
    }
}

__device__ __forceinline__ void p2_gates_mfma(Frame& F) {
    const int gw = F.vcu * NWAVES + F.wave, NGW = F.G * NWAVES, lane = F.lane, l15 = lane & 15, q = lane >> 4;
    const bf16* XB = (const bf16*)(F.ws + WS_XB); const bf16* Wg = (const bf16*)(F.ws + WS_WIN) + (size_t)C_GL * D; const float* rstd1 = (const float*)(F.ws + WS_RSTD1);
    float* gates = (float*)(F.ws + WS_GATES);
    for (int it = gw; it < M / 16; it += NGW) {
        const int r0 = 16 * it;
        f32x4 acc[2] = {(f32x4){0.f, 0.f, 0.f, 0.f}, (f32x4){0.f, 0.f, 0.f, 0.f}};
        const bf16* xp = XB + (size_t)(r0 + l15) * D + 8 * q; const bf16* wp0 = Wg + (size_t)l15 * D + 8 * q; const bf16* wp1 = Wg + (size_t)(16 + l15) * D + 8 * q;
#pragma unroll 8
        for (int ks = 0; ks < 32; ++ks) { const bf16x8 bx = *(const bf16x8*)(xp + 32 * ks), a0 = *(const bf16x8*)(wp0 + 32 * ks), a1 = *(const bf16x8*)(wp1 + 32 * ks);
            acc[0] = __builtin_amdgcn_mfma_f32_16x16x32_bf16(a0, bx, acc[0], 0, 0, 0); acc[1] = __builtin_amdgcn_mfma_f32_16x16x32_bf16(a1, bx, acc[1], 0, 0, 0); }
        const float rs = rstd1[r0 + l15]; float* gp = gates + (size_t)(r0 + l15) * 24;
        { f32x4 o; o[0] = fsigmoid_(acc[0][0] * rs); o[1] = fsigmoid_(acc[0][1] * rs); o[2] = fsigmoid_(acc[0][2] * rs); o[3] = fsigmoid_(acc[0][3] * rs); *(f32x4*)(gp + 4 * q) = o; }
        if (q < 2) { f32x4 o; o[0] = fsigmoid_(acc[1][0] * rs); o[1] = fsigmoid_(acc[1][1] * rs); o[2] = fsigmoid_(acc[1][2] * rs); o[3] = fsigmoid_(acc[1][3] * rs); *(f32x4*)(gp + 16 + 4 * q) = o; }
    }
}
constexpr int CMP_H_OFF = 36864, CMP_H_STRIDE = 528;
__device__ __forceinline__ void p2_compress_mfma(Frame& F) {
    LAS unsigned char* L = F.lds + RING_OFF;
    const int tid = F.tid, lane = F.lane, wave = F.wave, l15 = lane & 15, q = lane >> 4;
    const bf16* PB = (const bf16*)(F.ws + WS_PB);
    const float* bias1 = (const float*)(F.ctl + CW_BIAS1);
    for (int it = F.vcu; it < 256; it += F.G) {
        const int kv = it >> 7, bhk = (it >> 5) & 3, c0 = (it & 31) * 16; const int b = bhk >> 1, hk = bhk & 1;
        const int col = (kv ? C_VC : C_KC) + hk * 64;
        for (int idx = tid; idx < 272 * 8; idx += NWAVES * 64) { const int tok = idx >> 3, ch = idx & 7; const int t = 16 * c0 + tok;
            v4u v = (v4u){0u, 0u, 0u, 0u}; if (t < T) v = *(const v4u*)(PB + (size_t)(b * T + t) * NMAIN + col + 8 * ch);
            const int e = tok * 64 + ch * 8; *(LAS v4u*)(L + 2 * e + (e >> 10) * 16) = v; }
        __syncthreads();
        {
            f32x4 acc[2] = {(f32x4){0.f, 0.f, 0.f, 0.f}, (f32x4){0.f, 0.f, 0.f, 0.f}};
            const bf16* W1T = (const bf16*)(F.ws + WS_CW1T) + (size_t)kv * 256 * 2048;
            const bf16* ap0 = W1T + (size_t)(32 * wave + l15) * 2048 + 8 * q; const bf16* ap1 = ap0 + (size_t)16 * 2048;
#pragma unroll 8
            for (int ks = 0; ks < 64; ++ks) { const int e = 1024 * l15 + 32 * ks + 8 * q; const bf16x8 bx = *(const LAS bf16x8*)(L + 2 * e + (e >> 10) * 16);
                const bf16x8 a0 = *(const bf16x8*)(ap0 + 32 * ks), a1 = *(const bf16x8*)(ap1 + 32 * ks);
                acc[0] = __builtin_amdgcn_mfma_f32_16x16x32_bf16(a0, bx, acc[0], 0, 0, 0); acc[1] = __builtin_amdgcn_mfma_f32_16x16x32_bf16(a1, bx, acc[1], 0, 0, 0); }
#pragma unroll
            for (int j = 0; j < 2; ++j) { const int n0 = 32 * wave + 16 * j + 4 * q; const f32x4 bv = *(const f32x4*)(bias1 + kv * 256 + n0);
                u32x2 w; w.x = cvtpk(fgelu_tanh_(acc[j][0] + bv[0]), fgelu_tanh_(acc[j][1] + bv[1])); w.y = cvtpk(fgelu_tanh_(acc[j][2] + bv[2]), fgelu_tanh_(acc[j][3] + bv[3]));
                *(LAS u32x2*)(L + CMP_H_OFF + l15 * CMP_H_STRIDE + n0 * 2) = w; }
        }
        __syncthreads();
        if (wave < 4) {
            f32x4 acc = (f32x4){0.f, 0.f, 0.f, 0.f};
            const bf16* W2T = (const bf16*)(F.ws + WS_CW2T) + (size_t)kv * 64 * 256 + (size_t)(16 * wave + l15) * 256 + 8 * q;
#pragma unroll
            for (int ks = 0; ks < 8; ++ks) { const bf16x8 a = *(const bf16x8*)(W2T + 32 * ks), bx = *(const LAS bf16x8*)(L + CMP_H_OFF + l15 * CMP_H_STRIDE + (32 * ks + 8 * q) * 2);
                acc = __builtin_amdgcn_mfma_f32_16x16x32_bf16(a, bx, acc, 0, 0, 0); }
            const int c = c0 + l15, j0 = 16 * wave + 4 * q; const bool ok = c < NCMP;
            if (kv == 0) { u32x2 w; w.x = ok ? cvtpk(acc[0], acc[1]) : 0u; w.y = ok ? cvtpk(acc[2], acc[3]) : 0u; *(u32x2*)((bf16*)(F.ws + WS_CMP) + ((size_t)bhk * NCMPP + c) * 64 + j0) = w; }
            else { const int pc = perm16(c);
#pragma unroll
                for (int r = 0; r < 4; ++r) ((bf16*)(F.ws + WS_CMP + 262144))[((size_t)bhk * 64 + j0 + r) * NCMPP + pc] = ok ? (bf16)f2bf(acc[r]) : (bf16)0; }
        }
        __syncthreads();
    }
}

struct Args { const float* in[26]; float* out; unsigned char* ws; };
__global__ void __launch_bounds__(NWAVES * 64, 2) hybrid_fwd(Args args) {
    extern __shared__ __attribute__((aligned(16))) unsigned char lds[];
    Frame F;
    F.lds = (LAS unsigned char*)lds;
    F.MISC = (volatile LAS unsigned*)(F.lds + MISC_OFF);
    F.tid = threadIdx.x; F.lane = F.tid & 63; F.wave = __builtin_amdgcn_readfirstlane(F.tid >> 6);
    F.G = gridDim.x; { const int bx = blockIdx.x; F.vcu = (F.G % 8 == 0) ? (bx % 8) * (F.G / 8) + bx / 8 : bx; }
    F.ws = args.ws; F.out = args.out; F.ctl = (gu32*)(args.ws + WS_CTL);
#pragma unroll
    for (int i = 0; i < 26; ++i) F.in[i] = args.in[i];
    for (int u = F.tid; u < (LDS_BYTES - LDSCTL_OFF) / 4; u += NWAVES * 64) ((LAS unsigned*)(F.lds + LDSCTL_OFF))[u] = 0u;
    __syncthreads();
    XcdBarrier bar = xcd_barrier_post((unsigned*)(F.ctl + CW_BAR), F.MISC + 8);
#define GRID_BAR() xcd_barrier(bar)
#ifdef PROBE_SEL
    volatile LAS unsigned long long* TSL = (volatile LAS unsigned long long*)(F.lds + RING_BYTES + 8192);
#define STAMP(i) do { if (blockIdx.x == 0 && F.tid == 0) TSL[i] = __builtin_amdgcn_s_memrealtime(); } while (0)
#else
#define STAMP(i) do {} while (0)
#endif
    STAMP(0);

    bf16* Win_t = (bf16*)(F.ws + WS_WIN); bf16* Wout_t = (bf16*)(F.ws + WS_WOUT); bf16* Wgu_t = (bf16*)(F.ws + WS_WGU); bf16* Wd_t = (bf16*)(F.ws + WS_WD);
    bf16* XB = (bf16*)(F.ws + WS_XB); bf16* PB = (bf16*)(F.ws + WS_PB); bf16* HB = (bf16*)(F.ws + WS_HB); bf16* ACT = (bf16*)(F.ws + WS_PB);
    float* rstd1 = (float*)(F.ws + WS_RSTD1); float* ssq2 = (float*)(F.ctl + CW_SSQ2); float* ssq3 = (float*)(F.ctl + CW_SSQ3);

    p0_prologue(F);
    GRID_BAR(); STAMP(1);
    {
        pg8::Gemm g{XB, Win_t, M, NMAIN, D}; pg8::StaticOrder S; S.init(M, NMAIN, F.G, (int)blockIdx.x);
        pg8::EpiRowScaleBf16 E{PB, NMAIN, rstd1};
        pg8::gemm_phase<pg8::EpiRowScaleBf16, pg8::StaticOrder, true, true>(F.lds + RING_OFF, g, S, E);
    }
    GRID_BAR(); STAMP(2);
    p2_gates_mfma(F); STAMP(10);
    p2_rwkv_chunk(F); STAMP(11);
    p2_compress_mfma(F); STAMP(12);
    p2_vtrans(F); STAMP(13);
    GRID_BAR(); STAMP(3);
    if (blockIdx.x < 4) p3_rwkv_scan_mfma(F, 4 * (int)blockIdx.x + (F.wave >> 1), F.wave & 1);
    STAMP(14);
    p3_nsa_mfma(F); STAMP(15);
    GRID_BAR(); STAMP(4);
    p3b_rwkv_out_mfma(F);
    GRID_BAR(); STAMP(5);
    {
        pg8::Gemm g{XB, Wout_t, M, D, D}; pg8::StaticOrder S; S.init(M, D, F.G, (int)blockIdx.x);
        pg8::EpiResid E{F.in[0], F.out, HB, ssq2, D};
        pg8::gemm_phase<pg8::EpiResid, pg8::StaticOrder, true, true>(F.lds + RING_OFF, g, S, E);
    }
    GRID_BAR(); STAMP(6);
    {
        pg8::Gemm g{HB, Wgu_t, M, NGU, D}; pg8::StaticOrder S; S.init(M, NGU, F.G, (int)blockIdx.x);
        pg8::EpiSwiGLU E{ACT, DFF, ssq2, NORM_EPS};
        pg8::gemm_phase<pg8::EpiSwiGLU, pg8::StaticOrder, true, true>(F.lds + RING_OFF, g, S, E);
    }
    GRID_BAR(); STAMP(7);
    {
        pg8::Gemm g{ACT, Wd_t, M, D, DFF}; pg8::StaticOrder S; S.init(M, D, F.G, (int)blockIdx.x);
        pg8::EpiResid E{F.out, F.out, nullptr, ssq3, D};
        pg8::gemm_phase<pg8::EpiResid, pg8::StaticOrder, true, true>(F.lds + RING_OFF, g, S, E);
    }
    GRID_BAR(); STAMP(8);
    p7_final_norm(F); STAMP(9);
#ifdef PROBE_NSA
    if (blockIdx.x == 5 && F.tid == 0) {
        volatile LAS unsigned long long* A = (volatile LAS unsigned long long*)(F.lds + RING_BYTES + 8192) + 16;
        const unsigned long long d0 = (PROBE_NSA == 0 ? A[0] : A[1]) / 1000ull, d1 = (PROBE_NSA == 0 ? A[2] : A[3]) / 1000ull;
        const unsigned long long f = (d0 > 99ull ? 99ull : d0) * 10000ull + (d1 > 99ull ? 99ull : d1) * 100ull;
        const unsigned long long t0 = __builtin_amdgcn_s_memrealtime();
        while (__builtin_amdgcn_s_memrealtime() - t0 < f * 100ull) __builtin_amdgcn_s_sleep(32);
    }
#endif
#ifdef PROBE_SEL
    if (blockIdx.x == 0 && F.tid == 0) {
        constexpr int PA[6][3][2] = {{{0,1},{1,2},{2,3}}, {{3,4},{4,5},{5,6}}, {{6,7},{7,8},{8,9}}, {{2,10},{10,11},{11,12}}, {{12,13},{3,14},{14,15}}, {{15,4},{0,9},{0,9}}};
        unsigned long long f = 0;
        for (int k = 0; k < 3; ++k) { const unsigned long long d = (TSL[PA[PROBE_SEL][k][1]] - TSL[PA[PROBE_SEL][k][0]]) / 1000ull; f = f * 100ull + (d > 99ull ? 99ull : d); }
        const unsigned long long t0 = __builtin_amdgcn_s_memrealtime();
        while (__builtin_amdgcn_s_memrealtime() - t0 < f * 100ull) __builtin_amdgcn_s_sleep(32);
    }
#endif
#undef GRID_BAR
}

extern "C" void kernel_launch(void* const* d_in, const int* in_sizes, int n_in, void* d_out, int out_size, void* d_ws, size_t ws_size, hipStream_t stream) {
    static int grid = 0;
    if (grid == 0) {
        if (n_in != 26 || in_sizes[0] != M * D || out_size != M * D || ws_size < WS_END) { fprintf(stderr, "kernel_launch: unexpected shapes (n_in %d, in0 %d, out %d, ws %zu); nothing launched\n", n_in, n_in > 0 ? in_sizes[0] : -1, out_size, ws_size); grid = -1; return; }
        int dev = 0, cus = 0, per_cu = 0;
        if (hipGetDevice(&dev) != hipSuccess || hipDeviceGetAttribute(&cus, hipDeviceAttributeMultiprocessorCount, dev) != hipSuccess) { fprintf(stderr, "kernel_launch: device query failed\n"); grid = -1; return; }
        if (hipFuncSetAttribute((const void*)hybrid_fwd, hipFuncAttributeMaxDynamicSharedMemorySize, LDS_BYTES) != hipSuccess) { fprintf(stderr, "kernel_launch: hipFuncSetAttribute failed\n"); grid = -1; return; }
        if (hipOccupancyMaxActiveBlocksPerMultiprocessor(&per_cu, (const void*)hybrid_fwd, NWAVES * 64, LDS_BYTES) != hipSuccess || per_cu < 1)
            fprintf(stderr, "kernel_launch: note: occupancy query reports %d workgroups per CU\n", per_cu);
        (void)hipGetLastError();
        grid = cus;
    }
    if (grid < 0) return;
    if (hipMemsetAsync((char*)d_ws + WS_CTL, 0, CTL_ZERO_BYTES, stream) != hipSuccess) { fprintf(stderr, "kernel_launch: hipMemsetAsync failed\n"); return; }
    Args a{};
    for (int i = 0; i < 26; ++i) a.in[i] = (const float*)d_in[i];
    a.out = (float*)d_out; a.ws = (unsigned char*)d_ws;
    hipLaunchKernelGGL(hybrid_fwd, dim3(grid), dim3(NWAVES * 64), LDS_BYTES, stream, a);
    const hipError_t le = hipPeekAtLastError();
    if (le != hipSuccess) fprintf(stderr, "kernel_launch: launch failed: %s\n", hipGetErrorName(le));
}
```
